# Optimizing an MI355X kernel written in HIP

```python
import math
import jax
import jax.numpy as jnp
from jax import lax
import numpy as np

D_MODEL = 1024
BATCH = 8
SEQ = 4096
DEPTH = 4

GRID_W = 64
CTX_LEN = 256
HEAD_DIM = 64
GROUP_HEADS = D_MODEL // (4 * HEAD_DIM)
DIFF_HEADS = GROUP_HEADS
DIFF_DV = HEAD_DIM
DIFF_DQK = HEAD_DIM // 2
GQA_HEADS = GROUP_HEADS
GQA_KV = GROUP_HEADS // 2
NA_HEADS = GROUP_HEADS
NA_WIN_ROWS = 8
NA_WIN_COLS = 16
SWA_HEADS = GROUP_HEADS
SWA_KV = GROUP_HEADS // 2
WINDOW = 128
QBLK = 128
ROPE_THETA = 10000.0
N_EXPERTS = 32
TOP_K = 4
D_FF = D_MODEL
SWIGLU_ALPHA = 1.702
SWIGLU_LIMIT = 7.0
MOE_BLK = 256
NORM_EPS = 1e-6
IN_LAYOUT = (
    (2 * DIFF_HEADS, DIFF_DQK), (2 * DIFF_HEADS, DIFF_DQK), (DIFF_HEADS, DIFF_DV),
    (GQA_HEADS, HEAD_DIM), (GQA_KV, HEAD_DIM), (GQA_KV, HEAD_DIM),
    (NA_HEADS, HEAD_DIM), (NA_HEADS, HEAD_DIM), (NA_HEADS, HEAD_DIM),
    (SWA_HEADS, HEAD_DIM), (SWA_KV, HEAD_DIM), (SWA_KV, HEAD_DIM),
)
IN_WIDTH = sum(n * d for n, d in IN_LAYOUT)
MIX_WIDTH = DIFF_HEADS * DIFF_DV + (GQA_HEADS + NA_HEADS + SWA_HEADS) * HEAD_DIM

kernel_name = 'hybrid_parallel_group_diffusion_block'


def rms_norm(x, g):
    xf = x.astype(jnp.float32)
    y = xf * lax.rsqrt(jnp.mean(xf * xf, axis=-1, keepdims=True) + NORM_EPS)
    return (y * g.astype(jnp.float32)).astype(x.dtype)


def rope_angles(n_tok, dim):
    quarter = dim // 4
    t = jnp.arange(n_tok, dtype=jnp.int32)
    inv = ROPE_THETA ** (-jnp.arange(quarter, dtype=jnp.float32) / quarter)
    ang_r = (t // GRID_W).astype(jnp.float32)[:, None] * inv
    ang_c = (t % GRID_W).astype(jnp.float32)[:, None] * inv
    return ang_r, ang_c


def _rotate(x, ang):
    x1, x2 = jnp.split(x, 2, axis=-1)
    cos = jnp.cos(ang).astype(x.dtype)
    sin = jnp.sin(ang).astype(x.dtype)
    return jnp.concatenate([x1 * cos - x2 * sin, x2 * cos + x1 * sin], axis=-1)


def apply_axial_rope(x, ang_r, ang_c):
    half = x.shape[-1] // 2
    return jnp.concatenate([_rotate(x[..., :half], ang_r), _rotate(x[..., half:], ang_c)], axis=-1)


def project_heads(h, w_in):
    p = h @ w_in
    heads, off = [], 0
    for n, d in IN_LAYOUT:
        heads.append(p[..., off:off + n * d].reshape(p.shape[0], p.shape[1], n, d).swapaxes(1, 2))
        off += n * d
    return heads


def block_softmax_attn(q, k, v, scale, sink=None):
    B, Hq, Sq, dk = q.shape
    Hkv, dv = k.shape[1], v.shape[-1]
    G = Hq // Hkv
    blk = min(QBLK, Sq)
    nb = Sq // blk
    qb = jnp.moveaxis(q.reshape(B, Hkv, G, nb, blk, dk), 3, 0)

    def one(qi):
        s = jnp.einsum('bhgqd,bhkd->bhgqk', qi, k).astype(jnp.float32) * scale
        if sink is not None:
            sk = jnp.broadcast_to(sink.astype(jnp.float32).reshape(1, Hkv, G, 1, 1), s.shape[:-1] + (1,))
            p = jax.nn.softmax(jnp.concatenate([s, sk], axis=-1), axis=-1)[..., :-1]
        else:
            p = jax.nn.softmax(s, axis=-1)
        return jnp.einsum('bhgqk,bhkd->bhgqd', p.astype(v.dtype), v)

    o = lax.map(one, qb)
    return jnp.moveaxis(o, 0, 3).reshape(B, Hq, Sq, dv)


def diff_attn(q1, q2, k1, k2, v, lam, scale):
    B, H, Sq, dk = q1.shape
    dv = v.shape[-1]
    blk = min(QBLK, Sq)
    nb = Sq // blk
    qs = jnp.moveaxis(jnp.stack([q1, q2], axis=0).reshape(2, B, H, nb, blk, dk), 3, 0)

    def one(qb):
        s1 = jnp.einsum('bhqd,bhkd->bhqk', qb[0], k1).astype(jnp.float32) * scale
        s2 = jnp.einsum('bhqd,bhkd->bhqk', qb[1], k2).astype(jnp.float32) * scale
        p = jax.nn.softmax(s1, axis=-1) - lam * jax.nn.softmax(s2, axis=-1)
        return jnp.einsum('bhqk,bhkd->bhqd', p.astype(v.dtype), v)

    o = lax.map(one, qs)
    return jnp.moveaxis(o, 0, 2).reshape(B, H, Sq, dv)


def neighborhood_attn(q, k, v, kc, vc, rpb, scale):
    B, H, S, d = q.shape
    rows = S // GRID_W
    wr = min(NA_WIN_ROWS, rows)
    wc = NA_WIN_COLS
    n_nb = wr * wc
    qg = q.reshape(B, H, rows, GRID_W, d)
    kg = k.reshape(B, H, rows, GRID_W, d)
    vg = v.reshape(B, H, rows, GRID_W, d)
    col = jnp.arange(GRID_W)
    c0 = jnp.clip(col - wc // 2, 0, GRID_W - wc)
    col_idx = c0[:, None] + jnp.arange(wc)[None, :]
    col_bias_idx = col_idx - col[:, None] + NA_WIN_COLS - 1

    def one_row(r):
        r0 = jnp.clip(r - wr // 2, 0, rows - wr)
        kn = jnp.take(lax.dynamic_slice_in_dim(kg, r0, wr, axis=2), col_idx, axis=3)
        vn = jnp.take(lax.dynamic_slice_in_dim(vg, r0, wr, axis=2), col_idx, axis=3)
        qr = lax.dynamic_index_in_dim(qg, r, axis=2, keepdims=False)
        s_nb = jnp.einsum('bhqd,bhrqcd->bhqrc', qr, kn).astype(jnp.float32) * scale
        row_bias_idx = r0 + jnp.arange(wr) - r + NA_WIN_ROWS - 1
        bias = rpb[:, row_bias_idx[None, :, None], col_bias_idx[:, None, :]]
        s_nb = (s_nb + bias.astype(jnp.float32)).reshape(B, H, GRID_W, n_nb)
        s_cx = jnp.einsum('bhqd,bhkd->bhqk', qr, kc).astype(jnp.float32) * scale
        p = jax.nn.softmax(jnp.concatenate([s_nb, s_cx], axis=-1), axis=-1).astype(v.dtype)
        vn = vn.transpose(0, 1, 3, 2, 4, 5).reshape(B, H, GRID_W, n_nb, d)
        return (jnp.einsum('bhqn,bhqnd->bhqd', p[..., :n_nb], vn)
                + jnp.einsum('bhqk,bhkd->bhqd', p[..., n_nb:], vc))

    o = lax.map(one_row, jnp.arange(rows))
    return jnp.moveaxis(o, 0, 2).reshape(B, H, S, d)


def window_attn(q, k, v, kc, vc, sink, scale):
    B, Hq, S, d = q.shape
    Hkv = k.shape[1]
    G = Hq // Hkv
    C = kc.shape[2]
    nb = S // WINDOW
    pad = ((0, 0), (0, 0), (WINDOW, WINDOW), (0, 0))
    kb = jnp.pad(k, pad).reshape(B, Hkv, nb + 2, WINDOW, d)
    vb = jnp.pad(v, pad).reshape(B, Hkv, nb + 2, WINDOW, d)
    kwin = jnp.concatenate([kb[:, :, 0:nb], kb[:, :, 1:nb + 1], kb[:, :, 2:nb + 2]], axis=3)
    vwin = jnp.concatenate([vb[:, :, 0:nb], vb[:, :, 1:nb + 1], vb[:, :, 2:nb + 2]], axis=3)
    qb = q.reshape(B, Hkv, G, nb, WINDOW, d)
    s_loc = jnp.einsum('bhgnqd,bhnkd->bhgnqk', qb, kwin).astype(jnp.float32) * scale
    qi = jnp.arange(WINDOW)[:, None]
    kj = jnp.arange(3 * WINDOW)[None, :]
    kpos = jnp.arange(nb)[:, None, None] * WINDOW - WINDOW + kj
    valid = (jnp.abs(kj - WINDOW - qi) <= WINDOW)[None] & (kpos >= 0) & (kpos < S)
    s_loc = jnp.where(valid, s_loc, -jnp.inf)
    s_ctx = jnp.einsum('bhgnqd,bhkd->bhgnqk', qb, kc).astype(jnp.float32) * scale
    s_sink = jnp.broadcast_to(sink.astype(jnp.float32).reshape(1, Hkv, G, 1, 1, 1), s_ctx.shape[:-1] + (1,))
    p = jax.nn.softmax(jnp.concatenate([s_loc, s_ctx, s_sink], axis=-1), axis=-1).astype(v.dtype)
    n_loc = 3 * WINDOW
    o = (jnp.einsum('bhgnqk,bhnkd->bhgnqd', p[..., :n_loc], vwin)
         + jnp.einsum('bhgnqk,bhkd->bhgnqd', p[..., n_loc:n_loc + C], vc))
    return o.reshape(B, Hq, S, d)


def merge_heads(outs, w_out):
    cat = jnp.concatenate([o.swapaxes(1, 2).reshape(o.shape[0], o.shape[2], -1) for o in outs], axis=-1)
    return cat @ w_out


def token_mixing(h, hc, w_in, w_out, diff_lam, diff_g, qk_g, rpb, sink, lam_init, rope, need_ctx):
    r32, c32, r64, c64 = rope
    hd_scale = HEAD_DIM ** -0.5
    (dq, dk, dv, gq, gk, gv, nq, nk, nv, wq, wk, wv) = project_heads(h, w_in)
    (dqc, dkc, dvc, gqc, gkc, gvc, nqc, nkc, nvc, wqc, wkc, wvc) = project_heads(hc, w_in)

    lf = diff_lam.astype(jnp.float32)
    lam = jnp.exp(jnp.sum(lf[0] * lf[1])) - jnp.exp(jnp.sum(lf[2] * lf[3])) + lam_init

    def pair(t):
        return t.reshape(t.shape[0], DIFF_HEADS, 2, t.shape[2], DIFF_DQK)

    def diff_out(q, k, v):
        o = diff_attn(q[:, :, 0], q[:, :, 1], k[:, :, 0], k[:, :, 1], v, lam, DIFF_DQK ** -0.5)
        return rms_norm(o, diff_g) * (1.0 - lam_init)

    dqc, dkc = pair(dqc), pair(dkc)
    dq = apply_axial_rope(pair(dq), r32, c32)
    dk = apply_axial_rope(pair(dk), r32, c32)
    o_a = diff_out(dq, jnp.concatenate([dkc, dk], axis=3), jnp.concatenate([dvc, dv], axis=2))

    gqc, gkc = rms_norm(gqc, qk_g[0]), rms_norm(gkc, qk_g[1])
    gq = apply_axial_rope(rms_norm(gq, qk_g[0]), r64, c64)
    gk = apply_axial_rope(rms_norm(gk, qk_g[1]), r64, c64)
    o_b = block_softmax_attn(gq, jnp.concatenate([gkc, gk], axis=2), jnp.concatenate([gvc, gv], axis=2), hd_scale)

    o_c = neighborhood_attn(nq, nk, nv, nkc, nvc, rpb, hd_scale)

    o_d = window_attn(apply_axial_rope(wq, r64, c64), apply_axial_rope(wk, r64, c64), wv, wkc, wvc, sink, hd_scale)

    o = merge_heads([o_a, o_b, o_c, o_d], w_out)
    oc = None
    if need_ctx:
        oc = merge_heads([
            diff_out(dqc, dkc, dvc),
            block_softmax_attn(gqc, gkc, gvc, hd_scale),
            block_softmax_attn(nqc, nkc, nvc, hd_scale),
            block_softmax_attn(wqc, wkc, wvc, hd_scale, sink),
        ], w_out)
    return o, oc


def moe_ffn(h, router_w, router_b, w_gu, b_gu, w_dn, b_dn):
    N, D = h.shape
    logits = (h @ router_w).astype(jnp.float32) + router_b.astype(jnp.float32)
    top_v, top_i = lax.top_k(logits, TOP_K)
    gates = jax.nn.softmax(top_v, axis=-1).astype(h.dtype)
    nk = N * TOP_K
    flat_e = top_i.reshape(nk)
    order = jnp.argsort(flat_e)
    e_sorted = flat_e[order]
    tok_sorted = order // TOP_K
    gate_sorted = gates.reshape(nk)[order]
    counts = jnp.bincount(flat_e, length=N_EXPERTS)
    padded = (counts + MOE_BLK - 1) // MOE_BLK * MOE_BLK
    pad_end = jnp.cumsum(padded)
    pad_start = pad_end - padded
    start = jnp.cumsum(counts) - counts
    dest = pad_start[e_sorted] + jnp.arange(nk) - start[e_sorted]
    n_blocks = -(-nk // MOE_BLK) + N_EXPERTS
    buf = jnp.zeros((n_blocks * MOE_BLK, D), h.dtype).at[dest].set(h[tok_sorted])
    block_e = jnp.minimum(jnp.searchsorted(pad_end, jnp.arange(n_blocks) * MOE_BLK, side='right'), N_EXPERTS - 1)

    def expert_block(args):
        xb, e = args
        gu = xb @ w_gu[e] + b_gu[e]
        g, u = jnp.split(gu, 2, axis=-1)
        g = jnp.minimum(g, SWIGLU_LIMIT)
        u = jnp.clip(u, -SWIGLU_LIMIT, SWIGLU_LIMIT)
        a = g * jax.nn.sigmoid(SWIGLU_ALPHA * g) * (u + 1.0)
        return a @ w_dn[e] + b_dn[e]

    yb = lax.map(expert_block, (buf.reshape(n_blocks, MOE_BLK, D), block_e))
    y_sorted = yb.reshape(-1, D)[dest] * gate_sorted[:, None]
    return jnp.zeros((N, D), h.dtype).at[tok_sorted].add(y_sorted)


def setup_inputs(seed: int = 0) -> dict:
    key = jax.random.key(seed)
    ks = jax.random.split(key, 22)
    L, D, E, F = DEPTH, D_MODEL, N_EXPERTS, D_FF

    def nrm(k, shape, s):
        return jax.random.normal(k, shape, jnp.float32) * s

    return {
        'x': nrm(ks[0], (BATCH, SEQ, D), 1.0),
        'c': nrm(ks[1], (BATCH, D), 1.0),
        'ctx': nrm(ks[2], (BATCH, CTX_LEN, D), 1.0),
        'c_ctx': nrm(ks[3], (D,), 1.0),
        'w_ada': nrm(ks[4], (L, D, 6 * D), 0.5 * D ** -0.5),
        'b_ada': nrm(ks[5], (L, 6 * D), 0.02),
        'norm1_g': 1.0 + nrm(ks[6], (L, D), 0.02),
        'norm2_g': 1.0 + nrm(ks[7], (L, D), 0.02),
        'w_in': nrm(ks[8], (L, D, IN_WIDTH), D ** -0.5),
        'w_out': nrm(ks[9], (L, MIX_WIDTH, D), MIX_WIDTH ** -0.5),
        'diff_lam': nrm(ks[10], (L, 4, DIFF_DQK), 0.1),
        'diff_subln_g': 1.0 + nrm(ks[11], (L, DIFF_DV), 0.02),
        'gqa_qk_g': 1.0 + nrm(ks[12], (L, 2, HEAD_DIM), 0.02),
        'na_rpb': nrm(ks[13], (L, NA_HEADS, 2 * NA_WIN_ROWS - 1, 2 * NA_WIN_COLS - 1), 0.1),
        'swa_sink': nrm(ks[14], (L, SWA_HEADS), 0.5),
        'router_w': nrm(ks[15], (L, D, E), D ** -0.5),
        'router_b': nrm(ks[16], (L, E), 0.01),
        'exp_w_gu': nrm(ks[17], (L, E, D, 2 * F), D ** -0.5),
        'exp_b_gu': nrm(ks[18], (L, E, 2 * F), 0.01),
        'exp_w_down': nrm(ks[19], (L, E, F, D), F ** -0.5),
        'exp_b_down': nrm(ks[20], (L, E, D), 0.01),
        'final_g': 1.0 + nrm(ks[21], (D,), 0.02),
    }


def reference(x, c, ctx, c_ctx, w_ada, b_ada, norm1_g, norm2_g, w_in, w_out, diff_lam, diff_subln_g,
              gqa_qk_g, na_rpb, swa_sink, router_w, router_b, exp_w_gu, exp_b_gu, exp_w_down, exp_b_down,
              final_g):
    B, S, D = x.shape
    r32, c32 = rope_angles(S, DIFF_DQK)
    r64, c64 = rope_angles(S, HEAD_DIM)
    rope = (r32, c32, r64, c64)
    xc = ctx
    silu_c = jax.nn.silu(c)
    silu_cc = jax.nn.silu(c_ctx)
    for l in range(DEPTH):
        need_ctx = l < DEPTH - 1
        lam_init = 0.8 - 0.6 * math.exp(-0.3 * l)
        sh1, sc1, g1, sh2, sc2, g2 = jnp.split((silu_c @ w_ada[l] + b_ada[l])[:, None, :], 6, axis=-1)
        sh1c, sc1c, g1c, sh2c, sc2c, g2c = jnp.split((silu_cc @ w_ada[l] + b_ada[l])[None, None, :], 6, axis=-1)
        h = rms_norm(x, norm1_g[l]) * (1.0 + sc1) + sh1
        hc = rms_norm(xc, norm1_g[l]) * (1.0 + sc1c) + sh1c
        o, oc = token_mixing(h, hc, w_in[l], w_out[l], diff_lam[l], diff_subln_g[l], gqa_qk_g[l], na_rpb[l],
                             swa_sink[l], lam_init, rope, need_ctx)
        x = x + g1 * o
        h2 = rms_norm(x, norm2_g[l]) * (1.0 + sc2) + sh2
        moe_w = (router_w[l], router_b[l], exp_w_gu[l], exp_b_gu[l], exp_w_down[l], exp_b_down[l])
        if need_ctx:
            xc = xc + g1c * oc
            h2c = rms_norm(xc, norm2_g[l]) * (1.0 + sc2c) + sh2c
            y = moe_ffn(jnp.concatenate([h2.reshape(-1, D), h2c.reshape(-1, D)], axis=0), *moe_w)
            x = x + g2 * y[:B * S].reshape(B, S, D)
            xc = xc + g2c * y[B * S:].reshape(xc.shape)
        else:
            x = x + g2 * moe_ffn(h2.reshape(-1, D), *moe_w).reshape(B, S, D)
    return rms_norm(x, final_g)
```

```cpp
#include <hip/hip_runtime.h>
#include <cstdio>
#include <cstdint>

#ifndef MK_PER_PHASE
#define MK_PER_PHASE 1
#endif

#define GAS __attribute__((address_space(1)))
#define LAS __attribute__((address_space(3)))
typedef unsigned short bf16;
typedef unsigned v4u __attribute__((ext_vector_type(4)));
typedef unsigned v2u __attribute__((ext_vector_type(2)));
typedef float f32x4 __attribute__((ext_vector_type(4)));
typedef short bf16x8 __attribute__((ext_vector_type(8)));
typedef GAS unsigned gu32;

constexpr int NB = 8, SEQ = 4096, CTX = 256, T = CTX + SEQ, D = 1024, NL = 4;
constexpr int M = NB * T;
constexpr int INW = 2560;
constexpr int NE = 32, FF = 1024, GU = 2048;
constexpr int MOE_BLKS = M * 4 / 256 + NE;
constexpr int MOE_ROWS = MOE_BLKS * 256;
constexpr float EPS = 1e-6f;

namespace pg8 {
constexpr int BM = 256, BK = 64, HALF = 128, HTB = HALF * BK * 2, STAGE_BYTES = 8 * HTB, NXCD = 8, WGM = 8;
__host__ __device__ __forceinline__ int lds_byte(int r, int c) { const int st = (r >> 4) * 2 + (c >> 5), rr = r & 15, cc = c & 31, ob = rr * 64 + cc * 2; return st * 1024 + (ob ^ (((ob >> 9) & 1) << 5)); }
__host__ __device__ __forceinline__ void stage_rc(int b, int& R, int& C) { const int st = b / 1024, sb = b % 1024, swz = sb ^ (((sb >> 9) & 1) << 5); R = (st >> 1) * 16 + swz / 64; C = (st & 1) * 32 + (swz % 64) / 2; }
__host__ __device__ __forceinline__ int perm32(int rho) { const int n = rho >> 4, i = rho & 15; return 8 * (i >> 2) + 4 * n + (i & 3); }

struct Unit { int pm, pn, pb, e; };
struct Gemm { const bf16* A; const bf16* Bt; int K; };

struct StaticOrder {
    int nM, nN, nwg, G, c;
    __device__ void init(int M_, int N_, int G_, int c_) { nM = M_ / BM; nN = N_ / BM; nwg = nM * nN; G = G_; c = c_; }
    __device__ bool next(int i, Unit& u) const {
        const long L = (long)i * G + c; if (L >= nwg) return false;
        int wgid = (int)L; { const int q = nwg / NXCD, r = nwg % NXCD, xcd = wgid % NXCD, off = wgid / NXCD; wgid = (xcd < r ? xcd * (q + 1) : r * (q + 1) + (xcd - r) * q) + off; }
        const int nig = WGM * nN, gid = wgid / nig, fm = gid * WGM, gsz = (nM - fm) < WGM ? (nM - fm) : WGM;
        u.pm = fm + ((wgid % nig) % gsz); u.pn = (wgid % nig) / gsz; u.pb = u.pn; u.e = 0; return true;
    }
};
struct MoeOrder {
    const int* tab; int nN, G, c, total;
    __device__ void init(const int* tab_, int nN_, int G_, int c_) { tab = tab_; nN = nN_; G = G_; c = c_; total = tab_[MOE_BLKS] * nN_; }
    __device__ bool next(int i, Unit& u) const {
        const int L = i * G + c; if (L >= total) return false;
        const int blk = L / nN, pn = L % nN, e = tab[blk];
        u.pm = blk; u.pn = pn; u.pb = e * nN + pn; u.e = e; return true;
    }
};

__device__ __forceinline__ unsigned cvt_pk_bf16(float lo, float hi) { unsigned r; asm volatile("v_cvt_pk_bf16_f32 %0, %1, %2" : "=v"(r) : "v"(lo), "v"(hi)); return r; }

struct EpiStore {
    bf16* O; int ldc; const float* bias; int bias_stride;
    __device__ __forceinline__ void operator()(const f32x4 (&acc)[2][2][4][2], const Unit& u, int wr, int wc, int fr, int fq) const {
        const int row0 = u.pm * BM + wr * 64 + fr, col0 = u.pn * BM + wc * 32 + 8 * fq;
        f32x4 bv[2][2];
#pragma unroll
        for (int bj = 0; bj < 2; ++bj)
#pragma unroll
            for (int n = 0; n < 2; ++n) bv[bj][n] = bias ? *(const f32x4*)(bias + (size_t)u.e * bias_stride + col0 + bj * HALF + 4 * n) : (f32x4){0.f, 0.f, 0.f, 0.f};
#pragma unroll
        for (int ai = 0; ai < 2; ++ai)
#pragma unroll
            for (int m = 0; m < 4; ++m) { bf16* rowp = O + (size_t)(row0 + ai * HALF + m * 16) * ldc + col0;
#pragma unroll
                for (int bj = 0; bj < 2; ++bj) { const f32x4 v0 = acc[ai][bj][m][0] + bv[bj][0], v1 = acc[ai][bj][m][1] + bv[bj][1];
                    v4u w; w.x = cvt_pk_bf16(v0[0], v0[1]); w.y = cvt_pk_bf16(v0[2], v0[3]); w.z = cvt_pk_bf16(v1[0], v1[1]); w.w = cvt_pk_bf16(v1[2], v1[3]);
                    *(v4u*)(rowp + bj * HALF) = w; } }
    }
};
__device__ __forceinline__ float swiglu1(float g, float u) {
    g = fminf(g, 7.0f); u = fminf(fmaxf(u, -7.0f), 7.0f);
    const float sg = __builtin_amdgcn_rcpf(1.0f + __expf(-1.702f * g));
    return g * sg * (u + 1.0f);
}
struct EpiSwiglu {
    bf16* O; const float* bias;
    __device__ __forceinline__ void operator()(const f32x4 (&acc)[2][2][4][2], const Unit& u, int wr, int wc, int fr, int fq) const {
        const int row0 = u.pm * BM + wr * 64 + fr, colA = u.pn * HALF + wc * 32 + 8 * fq;
        f32x4 bg[2], bu[2];
#pragma unroll
        for (int n = 0; n < 2; ++n) { bg[n] = *(const f32x4*)(bias + (size_t)u.e * GU + colA + 4 * n); bu[n] = *(const f32x4*)(bias + (size_t)u.e * GU + FF + colA + 4 * n); }
#pragma unroll
        for (int ai = 0; ai < 2; ++ai)
#pragma unroll
            for (int m = 0; m < 4; ++m) { bf16* rowp = O + (size_t)(row0 + ai * HALF + m * 16) * FF + colA;
                float a[8];
#pragma unroll
                for (int n = 0; n < 2; ++n) { const f32x4 g = acc[ai][0][m][n] + bg[n], uu = acc[ai][1][m][n] + bu[n];
#pragma unroll
                    for (int i = 0; i < 4; ++i) a[4 * n + i] = swiglu1(g[i], uu[i]); }
                v4u w; w.x = cvt_pk_bf16(a[0], a[1]); w.y = cvt_pk_bf16(a[2], a[3]); w.z = cvt_pk_bf16(a[4], a[5]); w.w = cvt_pk_bf16(a[6], a[7]);
                *(v4u*)rowp = w; }
    }
};

template <class Epi, class Sched>
__device__ __forceinline__ void gemm_phase(LAS unsigned char* lds, const Gemm g, const Sched& S, const Epi& E, int wid) {
    int lane; asm volatile("v_mbcnt_lo_u32_b32 %0, -1, 0\n\tv_mbcnt_hi_u32_b32 %0, -1, %0" : "=&v"(lane));
    const int tid = wid * 64 + lane, wr = wid >> 2, wc = wid & 3, fr = lane & 15, fq = lane >> 4;
    const int K = g.K, nt = K / BK;
    unsigned voffA[2], voffB[2];
#pragma unroll
    for (int i = 0; i < 2; ++i) { int R, C; stage_rc(tid * 16 + i * 8192, R, C); const int Rb = (R & ~31) + perm32(R & 31);
        voffA[i] = (unsigned)(R * K + C) * 2u; voffB[i] = (unsigned)(Rb * K + C) * 2u; }
    const size_t kstep = (size_t)(BK * 2);
    const size_t hstep = (size_t)HALF * K * 2;
    const size_t tstep = 2 * hstep;
    const unsigned ldsw = (unsigned)wid * 1024u;
    const int aoff = lds_byte(wr * 64 + fr, fq * 8), boff = lds_byte(wc * 32 + fr, fq * 8);
#define PG8_SA(b, h) (((b) * 2 + (h)) * HTB)
#define PG8_SB(b, h) ((4 + (b) * 2 + (h)) * HTB)
#define PG8_STAGE(bufoff, gbase, voff) do { _Pragma("unroll") for (int _i = 0; _i < 2; ++_i) \
        __builtin_amdgcn_global_load_lds((const unsigned*)((const char*)(gbase) + (voff)[_i]), (LAS unsigned*)(lds + (bufoff) + ldsw + _i * 8192), 16, 0, 0); } while (0)
#define PG8_LDA(dst, b, h) do { _Pragma("unroll") for (int m = 0; m < 4; ++m) _Pragma("unroll") for (int k = 0; k < 2; ++k) dst[m][k] = *(const LAS bf16x8*)(lds + PG8_SA(b, h) + aoff + m * 2048 + k * 1024); } while (0)
#define PG8_LDB(dst, b, h) do { _Pragma("unroll") for (int n = 0; n < 2; ++n) _Pragma("unroll") for (int k = 0; k < 2; ++k) dst[n][k] = *(const LAS bf16x8*)(lds + PG8_SB(b, h) + boff + n * 2048 + k * 1024); } while (0)
#define PG8_MMA(ai, bj, At, Bt) do { __builtin_amdgcn_s_setprio(1); _Pragma("unroll") for (int m = 0; m < 4; ++m) _Pragma("unroll") for (int n = 0; n < 2; ++n) _Pragma("unroll") for (int k = 0; k < 2; ++k) \
        acc[ai][bj][m][n] = __builtin_amdgcn_mfma_f32_16x16x32_bf16(Bt[n][k], At[m][k], acc[ai][bj][m][n], 0, 0, 0); __builtin_amdgcn_s_setprio(0); } while (0)
#define PG8_WAIT_V(n) asm volatile("s_waitcnt vmcnt(" #n ")" ::: "memory")
#define PG8_WAIT_L(n) asm volatile("s_waitcnt lgkmcnt(" #n ")" ::: "memory")
#define PG8_BAR __builtin_amdgcn_s_barrier()
#define PG8_SCHED __builtin_amdgcn_sched_barrier(0)
    Unit cur, nxt; int ui = 0;
    if (!S.next(0, cur)) return;
    f32x4 acc[2][2][4][2];
#pragma unroll
    for (int a = 0; a < 2; ++a)
#pragma unroll
        for (int b = 0; b < 2; ++b)
#pragma unroll
            for (int m = 0; m < 4; ++m)
#pragma unroll
                for (int n = 0; n < 2; ++n) acc[a][b][m][n] = (f32x4){0.f, 0.f, 0.f, 0.f};
    bf16x8 At[4][2], B0[2][2], B1[2][2];
    const char* cA = (const char*)g.A + (size_t)cur.pm * tstep; const char* cB = (const char*)g.Bt + (size_t)cur.pb * tstep;
    PG8_STAGE(PG8_SB(0, 0), cB, voffB); PG8_STAGE(PG8_SB(0, 1), cB + hstep, voffB); PG8_STAGE(PG8_SA(0, 0), cA, voffA); PG8_STAGE(PG8_SA(0, 1), cA + hstep, voffA);
    if (wr == 1) PG8_BAR;
    PG8_WAIT_V(2); PG8_BAR;
    PG8_STAGE(PG8_SB(1, 0), cB + kstep, voffB); PG8_STAGE(PG8_SA(1, 0), cA + kstep, voffA); PG8_STAGE(PG8_SB(1, 1), cB + hstep + kstep, voffB);
    PG8_WAIT_V(6); PG8_BAR;
    for (;;) {
        const bool has_next = S.next(ui + 1, nxt);
        const char* nA = has_next ? (const char*)g.A + (size_t)nxt.pm * tstep : cA; const char* nB = has_next ? (const char*)g.Bt + (size_t)nxt.pb * tstep : cB;
        for (int t = 0; t < nt; t += 2) {
            const bool last = (t == nt - 2);
            const char* a1 = cA + (size_t)(t + 1) * kstep;
            const char* a2 = last ? nA : cA + (size_t)(t + 2) * kstep; const char* b2 = last ? nB : cB + (size_t)(t + 2) * kstep;
            const char* a3 = a2 + kstep; const char* b3 = b2 + kstep;
            PG8_LDB(B0, 0, 0); PG8_LDB(B1, 0, 1); PG8_SCHED; PG8_LDA(At, 0, 0); PG8_STAGE(PG8_SA(1, 1), a1 + hstep, voffA);
            PG8_WAIT_V(8); PG8_WAIT_L(0); PG8_BAR; PG8_MMA(0, 0, At, B0); PG8_MMA(0, 1, At, B1); PG8_BAR; PG8_SCHED;
            PG8_LDA(At, 0, 1); PG8_STAGE(PG8_SB(0, 0), b2, voffB); PG8_STAGE(PG8_SB(0, 1), b2 + hstep, voffB); PG8_STAGE(PG8_SA(0, 0), a2, voffA);
            PG8_WAIT_V(8); PG8_WAIT_L(0); PG8_BAR; PG8_MMA(1, 0, At, B0); PG8_MMA(1, 1, At, B1); PG8_BAR; PG8_SCHED;
            PG8_LDB(B0, 1, 0); PG8_LDB(B1, 1, 1); PG8_SCHED; PG8_LDA(At, 1, 0); PG8_STAGE(PG8_SA(0, 1), a2 + hstep, voffA);
            PG8_WAIT_V(8); PG8_WAIT_L(0); PG8_BAR; PG8_MMA(0, 0, At, B0); PG8_MMA(0, 1, At, B1); PG8_BAR; PG8_SCHED;
            PG8_LDA(At, 1, 1); PG8_STAGE(PG8_SB(1, 0), b3, voffB); PG8_STAGE(PG8_SB(1, 1), b3 + hstep, voffB); PG8_STAGE(PG8_SA(1, 0), a3, voffA);
            PG8_WAIT_V(8); PG8_WAIT_L(0); PG8_BAR; PG8_MMA(1, 0, At, B0); PG8_MMA(1, 1, At, B1); PG8_BAR; PG8_SCHED;
        }
        if (wr == 0) PG8_BAR;
        E(acc, cur, wr, wc, fr, fq);
        if (!has_next) break;
#pragma unroll
        for (int a = 0; a < 2; ++a)
#pragma unroll
            for (int b = 0; b < 2; ++b)
#pragma unroll
                for (int m = 0; m < 4; ++m)
#pragma unroll
                    for (int n = 0; n < 2; ++n) acc[a][b][m][n] = (f32x4){0.f, 0.f, 0.f, 0.f};
        cur = nxt; cA = nA; cB = nB; ++ui;
        if (wr == 1) PG8_BAR;
    }
    PG8_WAIT_V(0);
    PG8_BAR;
#undef PG8_SA
#undef PG8_SB
#undef PG8_STAGE
#undef PG8_LDA
#undef PG8_LDB
#undef PG8_MMA
#undef PG8_WAIT_V
#undef PG8_WAIT_L
#undef PG8_BAR
#undef PG8_SCHED
}
}

constexpr size_t MiB = 1u << 20;
constexpr size_t WS_CTL = 0, CTL_ZERO_BYTES = 1 * MiB;
constexpr size_t WS_MOD = 2 * MiB;
constexpr size_t WS_TAB = 3 * MiB;
constexpr size_t WS_RE = 4 * MiB, WS_RPOS = 5 * MiB, WS_RGATE = 6 * MiB, WS_RDEST = 7 * MiB;
constexpr size_t WS_WIN = 8 * MiB;
constexpr size_t WS_WOUT = 28 * MiB;
constexpr size_t WS_WGU = 36 * MiB;
constexpr size_t WS_WDN = 548 * MiB;
constexpr size_t WS_X = 804 * MiB;
constexpr size_t WS_H = 940 * MiB;
constexpr size_t WS_P = 1008 * MiB;
constexpr size_t WS_VT = 1178 * MiB;
constexpr size_t WS_CAT = 1229 * MiB;
constexpr size_t WS_O = 1297 * MiB;
constexpr size_t WS_BUF = 1365 * MiB;
constexpr size_t WS_ACT = 1653 * MiB;
constexpr size_t WS_END = 1941 * MiB;
constexpr int CW_TMO = 0, CW_CODE = 1, CW_BAR = 4096, CW_CNT = 8192, CW_WORK = 8192 + 1024;

constexpr int NWAVES = 8;
constexpr int RING_BYTES = 131072;
constexpr int LDSCTL_OFF = RING_BYTES, MISC_OFF = LDSCTL_OFF + 320;
constexpr int LDS_BYTES = 147456;

#define RLX_AGENT __ATOMIC_RELAXED, __HIP_MEMORY_SCOPE_AGENT
#define LDS_WAIT() asm volatile("s_waitcnt lgkmcnt(0)" ::: "memory")
__device__ __forceinline__ unsigned f2bf(float f) { unsigned u = __builtin_bit_cast(unsigned, f); return (u + 0x7fffu + ((u >> 16) & 1u)) >> 16; }
__device__ __forceinline__ unsigned pk2(float lo, float hi) { return f2bf(lo) | (f2bf(hi) << 16); }
__device__ __forceinline__ float bflo(unsigned w) { return __builtin_bit_cast(float, w << 16); }
__device__ __forceinline__ float bfhi(unsigned w) { return __builtin_bit_cast(float, w & 0xffff0000u); }
__device__ __forceinline__ float bf2f(bf16 h) { return __builtin_bit_cast(float, (unsigned)h << 16); }
template <class Tp> __device__ __forceinline__ Tp* opq(Tp* p) { asm volatile("" : "+s"(p)); return p; }
__device__ __forceinline__ int lane_id() { int x; asm volatile("v_mbcnt_lo_u32_b32 %0, -1, 0\n\tv_mbcnt_hi_u32_b32 %0, -1, %0" : "=&v"(x)); return x; }
__device__ __forceinline__ float wave_sum(float v) {
#pragma unroll
    for (int o = 1; o < 64; o <<= 1) v += __shfl_xor(v, o);
    return v;
}

#define XB_TMO      128
#define XB_XCNT(j)  (256  + 64 * (j))
#define XB_XSUB(j)  (1280 + 64 * (j))
#define XB_XGEN(j)  (2304 + 64 * (j))
#define XB_TOP      3328
#define XB_TOPGEN   3392
#define XCD_BAR_WORDS 3456
#define XB_SPIN_CAP (1u << 18)
__device__ __forceinline__ unsigned xb_ld(unsigned* p)              { return __hip_atomic_load(p, __ATOMIC_RELAXED, __HIP_MEMORY_SCOPE_AGENT); }
__device__ __forceinline__ unsigned xb_add(unsigned* p, unsigned v) { return __hip_atomic_fetch_add(p, v, __ATOMIC_RELAXED, __HIP_MEMORY_SCOPE_AGENT); }
__device__ __forceinline__ unsigned xb_xcc_id() { return (unsigned)__builtin_amdgcn_s_getreg((3 << 11) | 20) & 0xFu; }
#define XB_SPIN(cond, bar) do { unsigned _sp = 0; while (cond) { __builtin_amdgcn_s_sleep(1); \
    if ((++_sp & 255u) == 0u) { if (xb_ld(&(bar)[XB_TMO])) break; if (_sp > XB_SPIN_CAP) { atomicAdd(&(bar)[XB_TMO], 1u); break; } } } } while (0)
struct XcdBarrier { unsigned* bar; unsigned x; volatile LAS unsigned* st; int wave; };
__device__ __forceinline__ XcdBarrier xcd_barrier_post(unsigned* bar, volatile LAS unsigned* st, int wave) {
    XcdBarrier b; b.bar = bar; b.x = xb_xcc_id(); b.st = st; b.wave = wave;
    if (wave == 0 && lane_id() == 0) (void)xb_add(&bar[XB_XCNT(b.x)], 1u);
    return b;
}
__device__ __forceinline__ void xcd_barrier_complete(unsigned* bar, unsigned x, unsigned& nloc, unsigned& nx) {
    const unsigned G = gridDim.x * gridDim.y * gridDim.z;
    unsigned sum, cnt, mine, sp = 0u;
    for (;;) {
        sum = 0u; cnt = 0u; mine = 0u;
#pragma unroll
        for (unsigned j = 0; j < 16; ++j) { const unsigned c = xb_ld(&bar[XB_XCNT(j)]); sum += c; cnt += (c > 0u) ? 1u : 0u; mine = (j == x) ? c : mine; }
        if (sum == G) break;
        __builtin_amdgcn_s_sleep(1);
        if ((++sp & 255u) == 0u) { if (xb_ld(&bar[XB_TMO])) break; if (sp > XB_SPIN_CAP) { atomicAdd(&bar[XB_TMO], 1u); break; } }
    }
    nloc = mine > 0u ? mine : 1u; nx = cnt > 0u ? cnt : 1u;
}
__device__ __forceinline__ void xcd_barrier(const XcdBarrier& b) {
    asm volatile("s_waitcnt vmcnt(0)" ::: "memory");
    __syncthreads();
    if (b.wave == 0 && lane_id() == 0) {
        unsigned* bar = opq(b.bar);
        __builtin_amdgcn_s_waitcnt(0);
        unsigned nloc = b.st[0], nx = b.st[1];
        if (nloc == 0u) { xcd_barrier_complete(bar, b.x, nloc, nx); b.st[0] = nloc; b.st[1] = nx; }
        const unsigned old = xb_add(&bar[XB_XSUB(b.x)], 1u);
        const unsigned gen = old / nloc;
        if (old + 1u == (gen + 1u) * nloc) {
            __builtin_amdgcn_fence(__ATOMIC_RELEASE, "agent");
            asm volatile("s_waitcnt vmcnt(0)" ::: "memory");
            const unsigned og = xb_add(&bar[XB_TOP], 1u);
            const unsigned tg = og / nx;
            if (og + 1u == (tg + 1u) * nx) xb_add(&bar[XB_TOPGEN], 1u);
            else XB_SPIN(xb_ld(&bar[XB_TOPGEN]) == tg, bar);
            __builtin_amdgcn_fence(__ATOMIC_ACQUIRE, "agent");
            xb_add(&bar[XB_XGEN(b.x)], 1u);
            asm volatile("s_waitcnt vmcnt(0)" ::: "memory");
        } else {
            XB_SPIN(xb_ld(&bar[XB_XGEN(b.x)]) == gen, bar);
            __builtin_amdgcn_fence(__ATOMIC_ACQUIRE, "agent");
            asm volatile("s_waitcnt vmcnt(0)" ::: "memory");
        }
    }
    __syncthreads();
}

struct Args { const float* in[22]; float* out; unsigned char* ws; int ph_lo, ph_hi; };
enum { I_X = 0, I_C, I_CTX, I_CCTX, I_WADA, I_BADA, I_N1G, I_N2G, I_WIN, I_WOUT, I_DLAM, I_DG, I_QKG, I_RPB, I_SINK, I_RW, I_RB, I_WGU, I_BGU, I_WDN, I_BDN, I_FG };
struct Frame {
    LAS unsigned char* lds; unsigned char* ws; unsigned* ctl;
    int vcu, G, wave;
};
#define WSP(type, off) ((type*)(F.ws + (off)))

struct Row { f32x4 v[4]; };
__device__ __forceinline__ void row_load_f32(Row& r, const float* p, int lane) {
#pragma unroll
    for (int j = 0; j < 4; ++j) r.v[j] = ((const f32x4*)p)[lane + 64 * j];
}
__device__ __forceinline__ void row_store_f32(const Row& r, float* p, int lane) {
#pragma unroll
    for (int j = 0; j < 4; ++j) ((f32x4*)p)[lane + 64 * j] = r.v[j];
}
__device__ __forceinline__ void row_load_bf16(Row& r, const bf16* p, int lane) {
#pragma unroll
    for (int j = 0; j < 4; ++j) { const v2u w = ((const v2u*)p)[lane + 64 * j]; r.v[j] = (f32x4){bflo(w.x), bfhi(w.x), bflo(w.y), bfhi(w.y)}; }
}
__device__ __forceinline__ void row_store_bf16(const Row& r, bf16* p, int lane) {
#pragma unroll
    for (int j = 0; j < 4; ++j) { v2u w; w.x = pk2(r.v[j][0], r.v[j][1]); w.y = pk2(r.v[j][2], r.v[j][3]); ((v2u*)p)[lane + 64 * j] = w; }
}
__device__ __forceinline__ float row_rstd(const Row& r) {
    float s = 0.f;
#pragma unroll
    for (int j = 0; j < 4; ++j) s += (r.v[j][0] * r.v[j][0] + r.v[j][1] * r.v[j][1]) + (r.v[j][2] * r.v[j][2] + r.v[j][3] * r.v[j][3]);
    return 1.0f / sqrtf(wave_sum(s) * (1.0f / D) + EPS);
}
__device__ __forceinline__ void row_modulate(Row& h, const Row& x, float rstd, const float* g, const float* sc, const float* sh, int lane) {
#pragma unroll
    for (int j = 0; j < 4; ++j) { const f32x4 gg = ((const f32x4*)g)[lane + 64 * j], s1 = ((const f32x4*)sc)[lane + 64 * j], s0 = ((const f32x4*)sh)[lane + 64 * j];
        h.v[j] = x.v[j] * rstd * gg * (s1 + 1.0f) + s0; }
}

__device__ __forceinline__ void transpose_item(const float* W, int K, int N, bf16* WT, int k0, int n0, int dest_row0, LAS float* scr, int lane) {
#pragma unroll 8
    for (int i = 0; i < 32; ++i) { const int kk = 2 * i + (lane >> 5); scr[kk * 33 + (lane & 31)] = W[(size_t)(k0 + kk) * N + n0 + (lane & 31)]; }
    LDS_WAIT(); asm volatile("" ::: "memory");
    const int c = lane & 7;
#pragma unroll
    for (int j = 0; j < 4; ++j) { const int n = (lane >> 3) + 8 * j; const LAS float* s = scr + (8 * c) * 33 + n;
        v4u o; o.x = pk2(s[0 * 33], s[1 * 33]); o.y = pk2(s[2 * 33], s[3 * 33]); o.z = pk2(s[4 * 33], s[5 * 33]); o.w = pk2(s[6 * 33], s[7 * 33]);
        *(v4u*)(WT + (size_t)(dest_row0 + n) * K + k0 + 8 * c) = o; }
    LDS_WAIT(); asm volatile("" ::: "memory");
}
__device__ __forceinline__ void phase_proA(const Args& A, Frame& F) {
    const int wave = F.wave, lane = lane_id(), tid = wave * 64 + lane; (void)tid;
    LAS float* sl = (LAS float*)F.lds;
    LAS float* scr = (LAS float*)(F.lds + 40960 + wave * 8704);
    for (int i = tid; i < 9 * D; i += NWAVES * 64) { const int r = i >> 10, k = i & 1023; const float v = r < 8 ? A.in[I_C][r * D + k] : A.in[I_CCTX][k]; sl[i] = v / (1.0f + __expf(-v)); }
    __syncthreads();
    const int gw = F.vcu * NWAVES + wave, NGW = F.G * NWAVES;
    constexpr int N_ADA = NL * 96;
    constexpr int IT_IN = 16 * 80, IT_OUT = 16 * 32, IT_GU = 16 * 64, IT_DN = 16 * 32;
    constexpr int IT_LAYER = IT_IN + IT_OUT + NE * IT_GU + NE * IT_DN;
    constexpr int NITEMS = N_ADA + NL * IT_LAYER;
    for (int it = gw; it < NITEMS; it += NGW) {
        if (it < N_ADA) {
            const int l = it / 96, n = (it % 96) * 64 + lane;
            const float* w = A.in[I_WADA] + (size_t)l * D * 6144 + n;
            float acc[9];
#pragma unroll
            for (int r = 0; r < 9; ++r) acc[r] = 0.f;
#pragma unroll 4
            for (int k = 0; k < D; ++k) { const float wv = w[(size_t)k * 6144];
#pragma unroll
                for (int r = 0; r < 9; ++r) acc[r] += sl[r * D + k] * wv; }
            const float bb = A.in[I_BADA][l * 6144 + n];
            float* mod = WSP(float, WS_MOD);
#pragma unroll
            for (int r = 0; r < 9; ++r) mod[(size_t)(l * 9 + r) * 6144 + n] = acc[r] + bb;
            continue;
        }
        int r = it - N_ADA; const int l = r / IT_LAYER; r -= l * IT_LAYER;
        if (r < IT_IN) { const int kb = r / 80, nb = r % 80; transpose_item(A.in[I_WIN] + (size_t)l * D * INW, D, INW, WSP(bf16, WS_WIN) + (size_t)l * INW * D, 64 * kb, 32 * nb, 32 * nb, scr, lane); continue; } r -= IT_IN;
        if (r < IT_OUT) { const int kb = r / 32, nb = r % 32; transpose_item(A.in[I_WOUT] + (size_t)l * D * D, D, D, WSP(bf16, WS_WOUT) + (size_t)l * D * D, 64 * kb, 32 * nb, 32 * nb, scr, lane); continue; } r -= IT_OUT;
        if (r < NE * IT_GU) { const int e = r / IT_GU, q = r % IT_GU, kb = q / 64, nb = q % 64, n0 = 32 * nb;
            const int dest = n0 < FF ? (n0 >> 7) * 256 + (n0 & 127) : ((n0 - FF) >> 7) * 256 + 128 + ((n0 - FF) & 127);
            transpose_item(A.in[I_WGU] + (size_t)(l * NE + e) * D * GU, D, GU, WSP(bf16, WS_WGU) + (size_t)(l * NE + e) * GU * D, 64 * kb, n0, dest, scr, lane); continue; } r -= NE * IT_GU;
        { const int e = r / IT_DN, q = r % IT_DN, kb = q / 32, nb = q % 32;
            transpose_item(A.in[I_WDN] + (size_t)(l * NE + e) * FF * D, FF, D, WSP(bf16, WS_WDN) + (size_t)(l * NE + e) * D * FF, 64 * kb, 32 * nb, 32 * nb, scr, lane); }
    }
}

__device__ __forceinline__ void phase_proB(const Args& A, Frame& F) {
    const int wave = F.wave, lane = lane_id(), tid = wave * 64 + lane; (void)tid;
    const int gw = F.vcu * NWAVES + wave, NGW = F.G * NWAVES;
    const float* mod = WSP(float, WS_MOD);
    for (int m = gw; m < M; m += NGW) {
        const int b = m / T, t = m % T; const int r = t < CTX ? 8 : b;
        const float* src = t < CTX ? A.in[I_CTX] + ((size_t)b * CTX + t) * D : A.in[I_X] + ((size_t)b * SEQ + (t - CTX)) * D;
        Row x, h; row_load_f32(x, src, lane);
        row_store_f32(x, WSP(float, WS_X) + (size_t)m * D, lane);
        const float rstd = row_rstd(x);
        const float* md = mod + (size_t)(0 * 9 + r) * 6144;
        row_modulate(h, x, rstd, A.in[I_N1G], md + 1024, md, lane);
        row_store_bf16(h, WSP(bf16, WS_H) + (size_t)m * D, lane);
    }
}

__device__ __forceinline__ void phase_post_proj(const Args& A, Frame& F, int l) {
    const int wave = F.wave, lane = lane_id(), tid = wave * 64 + lane; (void)tid;
    LAS bf16* vt = (LAS bf16*)F.lds;
    LAS float* t64 = (LAS float*)(F.lds + 102400);
    LAS float* t32 = (LAS float*)(F.lds + 102400 + 8192);
    for (int i = tid; i < 64 * 16; i += NWAVES * 64) { const int pos = i >> 4, f = i & 15; const float inv = exp2f(-(float)f * (13.287712379549449f / 16.0f)); const float a = (float)pos * inv; t64[2 * i] = cosf(a); t64[2 * i + 1] = sinf(a); }
    for (int i = tid; i < 64 * 8; i += NWAVES * 64) { const int pos = i >> 3, f = i & 7; const float inv = exp2f(-(float)f * (13.287712379549449f / 8.0f)); const float a = (float)pos * inv; t32[2 * i] = cosf(a); t32[2 * i + 1] = sinf(a); }
    __syncthreads();
    const float g0 = A.in[I_QKG][l * 128 + lane], g1 = A.in[I_QKG][l * 128 + 64 + lane];
    bf16* P = WSP(bf16, WS_P); bf16* VT = WSP(bf16, WS_VT);
    for (int tile = F.vcu; tile < M / 64; tile += F.G) {
        for (int tk = 0; tk < 8; ++tk) {
            const int tl = wave * 8 + tk, m = tile * 64 + tl, t = m % T;
            const bool lat = t >= CTX; const int s = t - CTX, grow = s >> 6, gcol = s & 63;
            bf16* prow = P + (size_t)m * INW;
            if (lat) {
                const int i32 = lane & 31, pos = (i32 & 16) ? gcol : grow; const float cs = t32[2 * (pos * 8 + (i32 & 7))], sn = t32[2 * (pos * 8 + (i32 & 7)) + 1];
#pragma unroll
                for (int seg = 0; seg < 8; ++seg) { const float x = bf2f(prow[seg * 64 + lane]); const float pr = __shfl_xor(x, 8);
                    const float o = (i32 & 8) ? x * cs + pr * sn : x * cs - pr * sn; prow[seg * 64 + lane] = (bf16)f2bf(o); }
            }
            const int pos64 = (lane & 32) ? gcol : grow; const float cs64 = lat ? t64[2 * (pos64 * 16 + (lane & 15))] : 1.f, sn64 = lat ? t64[2 * (pos64 * 16 + (lane & 15)) + 1] : 0.f;
#pragma unroll
            for (int seg = 12; seg < 18; ++seg) { float x = bf2f(prow[seg * 64 + lane]); const float ss = wave_sum(x * x);
                x = x * (1.0f / sqrtf(ss * (1.0f / 64.0f) + EPS)) * (seg < 16 ? g0 : g1);
                const float pr = __shfl_xor(x, 16); const float o = (lane & 16) ? x * cs64 + pr * sn64 : x * cs64 - pr * sn64; prow[seg * 64 + lane] = (bf16)f2bf(o); }
            if (lat) {
#pragma unroll
                for (int seg = 32; seg < 38; ++seg) { const float x = bf2f(prow[seg * 64 + lane]); const float pr = __shfl_xor(x, 16);
                    const float o = (lane & 16) ? x * cs64 + pr * sn64 : x * cs64 - pr * sn64; prow[seg * 64 + lane] = (bf16)f2bf(o); }
            }
#pragma unroll
            for (int vh = 0; vh < 12; ++vh) { const int seg = vh < 4 ? 8 + vh : (vh < 6 ? 18 + (vh - 4) : (vh < 10 ? 28 + (vh - 6) : 38 + (vh - 10)));
                vt[(vh * 64 + lane) * 66 + tl] = prow[seg * 64 + lane]; }
        }
        __syncthreads();
        const int b = (tile * 64) / T, t0 = (tile * 64) % T;
        for (int idx = tid; idx < 768 * 8; idx += NWAVES * 64) { const int row = idx >> 3, ch = idx & 7;
            const LAS unsigned* sp = (const LAS unsigned*)((const LAS unsigned char*)vt + row * 132 + ch * 16);
            v4u w; w.x = sp[0]; w.y = sp[1]; w.z = sp[2]; w.w = sp[3];
            *(v4u*)(VT + ((size_t)b * 768 + row) * T + t0 + ch * 8) = w; }
        __syncthreads();
    }
}

template <int DQK>
__device__ __forceinline__ void attn_core(const bf16* P, LAS unsigned char* wl, int lane, int mode, int b, int qt, int qcol, int kcol, int vcol, float scale,
                                          const float* rpb_h, float sinkv, bool use_sink, float (&o)[64]) {
    const size_t mq = (size_t)b * T + qt * 64 + lane;
    float q[DQK];
    { const v4u* qp = (const v4u*)(P + mq * INW + qcol);
#pragma unroll
      for (int i = 0; i < DQK / 8; ++i) { const v4u w = qp[i]; q[8 * i + 0] = bflo(w.x) * scale; q[8 * i + 1] = bfhi(w.x) * scale; q[8 * i + 2] = bflo(w.y) * scale; q[8 * i + 3] = bfhi(w.y) * scale;
          q[8 * i + 4] = bflo(w.z) * scale; q[8 * i + 5] = bfhi(w.z) * scale; q[8 * i + 6] = bflo(w.w) * scale; q[8 * i + 7] = bfhi(w.w) * scale; } }
    float m_run = -INFINITY, l_run = 0.f;
#pragma unroll
    for (int d = 0; d < 64; ++d) o[d] = 0.f;
    const bool lat = qt >= 4; const int qr = qt - 4;
    int lt0 = 0, lt1 = 0;
    if (lat) { if (mode <= 1) { lt0 = 4; lt1 = 68; } else if (mode == 2) { const int r0 = min(max(qr - 4, 0), 56); lt0 = 4 + r0; lt1 = lt0 + 8; } else { lt0 = 4 + max(qr - 2, 0); lt1 = 4 + min(qr + 2, 63) + 1; } }
    const int ntiles = 4 + (lt1 - lt0);
    const int c0 = min(max(lane - 8, 0), 48);
    for (int ti = 0; ti < ntiles; ++ti) {
        const int kt = ti < 4 ? ti : lt0 + (ti - 4);
        const size_t mk0 = (size_t)b * T + kt * 64;
#pragma unroll
        for (int i = 0; i < DQK / 8; ++i) { const int c = lane + 64 * i, row = c / (DQK / 8), part = c % (DQK / 8);
            const v4u w = *(const v4u*)(P + (mk0 + row) * INW + kcol + part * 8); *(LAS v4u*)(wl + c * 16) = w; }
#pragma unroll
        for (int i = 0; i < 8; ++i) { const int c = lane + 64 * i, row = c >> 3, part = c & 7;
            const v4u w = *(const v4u*)(P + (mk0 + row) * INW + vcol + part * 8); *(LAS v4u*)(wl + 8192 + c * 16) = w; }
        const bool masked = (ti >= 4) && (mode >= 2);
        const int dr = (kt - 4) - qr + 7, qi = qr * 64 + lane;
#pragma unroll 1
        for (int j = 0; j < 64; ++j) {
            const LAS v4u* kr = (const LAS v4u*)(wl + j * (DQK * 2)); float a = 0.f;
#pragma unroll
            for (int d8 = 0; d8 < DQK / 8; ++d8) { const v4u kv = kr[d8];
                a += q[8 * d8 + 0] * bflo(kv.x) + q[8 * d8 + 1] * bfhi(kv.x) + q[8 * d8 + 2] * bflo(kv.y) + q[8 * d8 + 3] * bfhi(kv.y)
                   + q[8 * d8 + 4] * bflo(kv.z) + q[8 * d8 + 5] * bfhi(kv.z) + q[8 * d8 + 6] * bflo(kv.w) + q[8 * d8 + 7] * bfhi(kv.w); }
            if (masked) {
                if (mode == 2) { const bool ok = (j >= c0) && (j < c0 + 16); const int bi = ok ? dr * 31 + (j - lane + 15) : 0; const float bias = rpb_h[bi]; a = ok ? a + bias : -INFINITY; }
                else { const int dd = (kt - 4) * 64 + j - qi; const bool ok = (dd <= 128) && (dd >= -128); a = ok ? a : -INFINITY; }
            }
            const float mnew = fmaxf(m_run, a), alpha = __expf(m_run - mnew), p = __expf(a - mnew);
            l_run = l_run * alpha + p; m_run = mnew;
            const LAS v4u* vr = (const LAS v4u*)(wl + 8192 + j * 128);
#pragma unroll
            for (int d8 = 0; d8 < 8; ++d8) { const v4u vv = vr[d8];
                o[8 * d8 + 0] = o[8 * d8 + 0] * alpha + p * bflo(vv.x); o[8 * d8 + 1] = o[8 * d8 + 1] * alpha + p * bfhi(vv.x); o[8 * d8 + 2] = o[8 * d8 + 2] * alpha + p * bflo(vv.y); o[8 * d8 + 3] = o[8 * d8 + 3] * alpha + p * bfhi(vv.y);
                o[8 * d8 + 4] = o[8 * d8 + 4] * alpha + p * bflo(vv.z); o[8 * d8 + 5] = o[8 * d8 + 5] * alpha + p * bfhi(vv.z); o[8 * d8 + 6] = o[8 * d8 + 6] * alpha + p * bflo(vv.w); o[8 * d8 + 7] = o[8 * d8 + 7] * alpha + p * bfhi(vv.w); }
        }
    }
    if (use_sink) l_run += __expf(sinkv - m_run);
    const float inv = 1.0f / l_run;
#pragma unroll
    for (int d = 0; d < 64; ++d) o[d] *= inv;
}
__device__ __forceinline__ void store_row64(bf16* dst, const float (&o)[64]) {
#pragma unroll
    for (int i = 0; i < 8; ++i) { v4u w; w.x = pk2(o[8 * i], o[8 * i + 1]); w.y = pk2(o[8 * i + 2], o[8 * i + 3]); w.z = pk2(o[8 * i + 4], o[8 * i + 5]); w.w = pk2(o[8 * i + 6], o[8 * i + 7]); ((v4u*)dst)[i] = w; }
}
__device__ __forceinline__ void phase_attn_naive(const Args& A, Frame& F, int l) {
    const int wave = F.wave, lane0 = lane_id();
    LAS unsigned char* wl = F.lds + wave * 16384;
    const bf16* P = WSP(bf16, WS_P); bf16* CAT = WSP(bf16, WS_CAT);
    const float lam_init = 0.8f - 0.6f * expf(-0.3f * (float)l);
    float lam;
    { const float* lf = A.in[I_DLAM] + l * 128; float a = 0.f, bq = 0.f; if (lane0 < 32) { a = lf[lane0] * lf[32 + lane0]; bq = lf[64 + lane0] * lf[96 + lane0]; }
      a = wave_sum(a); bq = wave_sum(bq); lam = expf(a) - expf(bq) + lam_init; }
    const int NU = (l < NL - 1) ? 8192 + 512 : 8192;
    unsigned* ctr = F.ctl + CW_WORK + 64 * l;
    for (;;) {
        int u = 0; if (lane0 == 0) u = (int)__hip_atomic_fetch_add(ctr, 1u, RLX_AGENT);
        u = __builtin_amdgcn_readfirstlane(u);
        if (u >= NU) break;
        const int lane = lane_id();
        int mode, b, h, qt;
        if (u < 8192) { mode = u >> 11; const int r = u & 2047; b = r >> 8; h = (r >> 6) & 3; qt = 4 + (r & 63); }
        else { const int v = u - 8192; mode = v >> 7; const int r = v & 127; b = r >> 4; h = (r >> 2) & 3; qt = r & 3; }
        bf16* dst = CAT + ((size_t)b * T + qt * 64 + lane) * D + (mode * 4 + h) * 64;
        if (mode == 0) {
            float o[64];
            float* sc1 = WSP(float, WS_O) + (((size_t)b * T + qt * 64 + lane) * 4 + h) * 64;
            attn_core<32>(P, wl, lane, 0, b, qt, (2 * h) * 32, 256 + (2 * h) * 32, 512 + h * 64, 0.17677669529663687f, nullptr, 0.f, false, o);
#pragma unroll
            for (int d = 0; d < 16; ++d) ((f32x4*)sc1)[d] = (f32x4){o[4 * d], o[4 * d + 1], o[4 * d + 2], o[4 * d + 3]};
            attn_core<32>(P, wl, lane, 0, b, qt, (2 * h + 1) * 32, 256 + (2 * h + 1) * 32, 512 + h * 64, 0.17677669529663687f, nullptr, 0.f, false, o);
            float ss = 0.f;
#pragma unroll
            for (int d = 0; d < 16; ++d) { const f32x4 a = ((const f32x4*)sc1)[d];
#pragma unroll
                for (int i = 0; i < 4; ++i) { o[4 * d + i] = a[i] - lam * o[4 * d + i]; ss += o[4 * d + i] * o[4 * d + i]; } }
            const float rs = (1.0f - lam_init) / sqrtf(ss * (1.0f / 64.0f) + EPS);
            const float* dg = A.in[I_DG] + l * 64;
#pragma unroll
            for (int d = 0; d < 64; ++d) o[d] *= rs * dg[d];
            store_row64(dst, o);
        } else {
            float o[64];
            int qcol, kcol, vcol;
            if (mode == 1) { qcol = 768 + h * 64; kcol = 1024 + (h >> 1) * 64; vcol = 1152 + (h >> 1) * 64; }
            else if (mode == 2) { qcol = 1280 + h * 64; kcol = 1536 + h * 64; vcol = 1792 + h * 64; }
            else { qcol = 2048 + h * 64; kcol = 2304 + (h >> 1) * 64; vcol = 2432 + (h >> 1) * 64; }
            const float sinkv = A.in[I_SINK][l * 4 + h];
            attn_core<64>(P, wl, lane, mode, b, qt, qcol, kcol, vcol, 0.125f, A.in[I_RPB] + (size_t)(l * 4 + h) * 465, sinkv, mode == 3, o);
            store_row64(dst, o);
        }
    }
}

__device__ __forceinline__ void phase_post_out(const Args& A, Frame& F, int l) {
    const int wave = F.wave, lane = lane_id(), tid = wave * 64 + lane; (void)tid;
    LAS float* wr_l = (LAS float*)F.lds;
    { const float* rw = A.in[I_RW] + (size_t)l * D * NE;
      for (int idx = tid; idx < D * NE; idx += NWAVES * 64) { const int k = idx >> 5, e = idx & 31, ln = (k & 255) >> 2, j = k >> 8, i = k & 3; wr_l[((j * 4 + i) * 32 + e) * 64 + ln] = rw[idx]; } }
    __syncthreads();
    const int gw = F.vcu * NWAVES + wave, NGW = F.G * NWAVES;
    const float* mod = WSP(float, WS_MOD);
    const float* rb = A.in[I_RB] + l * NE;
    unsigned* cnt = F.ctl + CW_CNT + 64 * l;
    for (int m = gw; m < M; m += NGW) {
        const int b = m / T, t = m % T; if (l == NL - 1 && t < CTX) continue;
        const int r = t < CTX ? 8 : b;
        const float* md = mod + (size_t)(l * 9 + r) * 6144;
        Row x, o, h;
        float* xp = WSP(float, WS_X) + (size_t)m * D;
        row_load_f32(x, xp, lane); row_load_bf16(o, WSP(bf16, WS_O) + (size_t)m * D, lane);
#pragma unroll
        for (int j = 0; j < 4; ++j) x.v[j] += ((const f32x4*)(md + 2048))[lane + 64 * j] * o.v[j];
        row_store_f32(x, xp, lane);
        const float rstd = row_rstd(x);
        row_modulate(h, x, rstd, A.in[I_N2G] + l * D, md + 4096, md + 3072, lane);
        row_store_bf16(h, WSP(bf16, WS_H) + (size_t)m * D, lane);
        float acc[32];
#pragma unroll
        for (int e = 0; e < 32; ++e) acc[e] = 0.f;
#pragma unroll
        for (int j = 0; j < 4; ++j)
#pragma unroll
            for (int i = 0; i < 4; ++i) { const float xv = h.v[j][i]; const LAS float* wp = wr_l + ((j * 4 + i) * 32) * 64 + lane;
#pragma unroll
                for (int e = 0; e < 32; ++e) acc[e] += xv * wp[e * 64]; }
#pragma unroll
        for (int i = 0; i < 16; ++i) { const bool hi = lane & 32; const float send = hi ? acc[i] : acc[i + 16], keep = hi ? acc[i + 16] : acc[i]; acc[i] = keep + __shfl_xor(send, 32); }
#pragma unroll
        for (int i = 0; i < 8; ++i) { const bool hi = lane & 16; const float send = hi ? acc[i] : acc[i + 8], keep = hi ? acc[i + 8] : acc[i]; acc[i] = keep + __shfl_xor(send, 16); }
#pragma unroll
        for (int i = 0; i < 4; ++i) { const bool hi = lane & 8; const float send = hi ? acc[i] : acc[i + 4], keep = hi ? acc[i + 4] : acc[i]; acc[i] = keep + __shfl_xor(send, 8); }
#pragma unroll
        for (int i = 0; i < 2; ++i) { const bool hi = lane & 4; const float send = hi ? acc[i] : acc[i + 2], keep = hi ? acc[i + 2] : acc[i]; acc[i] = keep + __shfl_xor(send, 4); }
        { const bool hi = lane & 2; const float send = hi ? acc[0] : acc[1], keep = hi ? acc[1] : acc[0]; acc[0] = keep + __shfl_xor(send, 2); }
        const int my_e = lane >> 1;
        float logit = acc[0] + __shfl_xor(acc[0], 1) + rb[my_e];
        float tv[4]; int te[4];
#pragma unroll
        for (int k = 0; k < 4; ++k) {
            float bv = logit; int be = my_e;
#pragma unroll
            for (int off = 2; off < 64; off <<= 1) { const float ov = __shfl_xor(bv, off); const int oe = __shfl_xor(be, off); const bool take = (ov > bv) || (ov == bv && oe < be); bv = take ? ov : bv; be = take ? oe : be; }
            tv[k] = bv; te[k] = be; if (my_e == be) logit = -INFINITY;
        }
        const float e1 = __expf(tv[1] - tv[0]), e2 = __expf(tv[2] - tv[0]), e3 = __expf(tv[3] - tv[0]); const float inv = 1.0f / (1.0f + e1 + e2 + e3);
        if (lane < 4) { const int ee = lane == 0 ? te[0] : (lane == 1 ? te[1] : (lane == 2 ? te[2] : te[3])); const float gg = (lane == 0 ? 1.0f : (lane == 1 ? e1 : (lane == 2 ? e2 : e3))) * inv;
            const unsigned pos = __hip_atomic_fetch_add(cnt + ee, 1u, RLX_AGENT);
            WSP(int, WS_RE)[(size_t)m * 4 + lane] = ee; WSP(int, WS_RPOS)[(size_t)m * 4 + lane] = (int)pos; WSP(float, WS_RGATE)[(size_t)m * 4 + lane] = gg; }
    }
}

__device__ __forceinline__ void phase_moe_gather(const Args& A, Frame& F, int l) {
    const int wave = F.wave, lane = lane_id(), tid = wave * 64 + lane; (void)tid;
    LAS int* bs = (LAS int*)F.lds;
    if (tid == 0) { int acc = 0; for (int e = 0; e < NE; ++e) { bs[e] = acc; const int c = (int)__hip_atomic_load(F.ctl + CW_CNT + 64 * l + e, RLX_AGENT); acc += (c + 255) >> 8; } bs[NE] = acc; }
    __syncthreads();
    if (blockIdx.x == 0) { int* tab = WSP(int, WS_TAB); const int total = bs[NE];
        for (int blk = tid; blk < MOE_BLKS; blk += NWAVES * 64) { int e = 0; for (int j = 1; j < NE; ++j) e += (bs[j] <= blk) ? 1 : 0; tab[blk] = blk < total ? e : 0; }
        if (tid == 0) tab[MOE_BLKS] = total; }
    const int gw = F.vcu * NWAVES + wave, NGW = F.G * NWAVES;
    for (int pr = gw; pr < M * 4; pr += NGW) {
        const int m = pr >> 2, t = m % T; if (l == NL - 1 && t < CTX) continue;
        const int e = WSP(int, WS_RE)[pr], pos = WSP(int, WS_RPOS)[pr];
        const int dest = bs[e] * 256 + pos;
        if (lane == 0) WSP(int, WS_RDEST)[pr] = dest;
        const v4u* src = (const v4u*)(WSP(bf16, WS_H) + (size_t)m * D); v4u* dst = (v4u*)(WSP(bf16, WS_BUF) + (size_t)dest * D);
        const v4u a0 = src[lane], a1 = src[lane + 64]; dst[lane] = a0; dst[lane + 64] = a1;
    }
}

__device__ __forceinline__ void phase_combine(const Args& A, Frame& F, int l) {
    const int wave = F.wave, lane = lane_id(), tid = wave * 64 + lane; (void)tid;
    const int gw = F.vcu * NWAVES + wave, NGW = F.G * NWAVES;
    const float* mod = WSP(float, WS_MOD);
    const bf16* Y = WSP(bf16, WS_BUF);
    for (int m = gw; m < M; m += NGW) {
        const int b = m / T, t = m % T; if (l == NL - 1 && t < CTX) continue;
        const int r = t < CTX ? 8 : b;
        const float* md = mod + (size_t)(l * 9 + r) * 6144;
        Row x, y, yk;
        float* xp = WSP(float, WS_X) + (size_t)m * D;
        row_load_f32(x, xp, lane);
#pragma unroll
        for (int j = 0; j < 4; ++j) y.v[j] = (f32x4){0.f, 0.f, 0.f, 0.f};
#pragma unroll
        for (int k = 0; k < 4; ++k) { const int dest = WSP(int, WS_RDEST)[(size_t)m * 4 + k]; const float gg = WSP(float, WS_RGATE)[(size_t)m * 4 + k];
            row_load_bf16(yk, Y + (size_t)dest * D, lane);
#pragma unroll
            for (int j = 0; j < 4; ++j) y.v[j] += yk.v[j] * gg; }
#pragma unroll
        for (int j = 0; j < 4; ++j) x.v[j] += ((const f32x4*)(md + 5120))[lane + 64 * j] * y.v[j];
        const float rstd = row_rstd(x);
        if (l < NL - 1) {
            row_store_f32(x, xp, lane);
            const float* md2 = mod + (size_t)((l + 1) * 9 + r) * 6144;
            Row h; row_modulate(h, x, rstd, A.in[I_N1G] + (l + 1) * D, md2 + 1024, md2, lane);
            row_store_bf16(h, WSP(bf16, WS_H) + (size_t)m * D, lane);
        } else {
            float* op = A.out + ((size_t)b * SEQ + (t - CTX)) * D;
#pragma unroll
            for (int j = 0; j < 4; ++j) ((f32x4*)op)[lane + 64 * j] = x.v[j] * rstd * ((const f32x4*)A.in[I_FG])[lane + 64 * j];
        }
    }
}

constexpr int PH_PER_LAYER = 9, N_PHASES = 2 + NL * PH_PER_LAYER;
__global__ void __launch_bounds__(NWAVES * 64, 2) fwd(Args A) {
    extern __shared__ __attribute__((aligned(16))) unsigned char lds_raw[];
    Frame F;
    F.lds = (LAS unsigned char*)lds_raw; F.ws = A.ws; F.ctl = (unsigned*)(A.ws + WS_CTL);
    F.wave = __builtin_amdgcn_readfirstlane((int)threadIdx.x >> 6);
    F.G = gridDim.x; { const int bx = blockIdx.x; F.vcu = (F.G % 8 == 0) ? (bx % 8) * (F.G / 8) + bx / 8 : bx; }
    for (int u = threadIdx.x; u < (LDS_BYTES - LDSCTL_OFF) / 4; u += NWAVES * 64) ((LAS unsigned*)(F.lds + LDSCTL_OFF))[u] = 0u;
    __syncthreads();
    const int lo = A.ph_lo, hi = A.ph_hi;
    XcdBarrier bar; bar.bar = F.ctl + CW_BAR; bar.x = 0; bar.st = nullptr; bar.wave = F.wave;
    if (hi - lo > 1) bar = xcd_barrier_post(F.ctl + CW_BAR, (volatile LAS unsigned*)(F.lds + MISC_OFF) + 8, F.wave);
#define IN(k) (lo <= (k) && (k) < hi)
#define SEAM(k) do { if (IN(k) && IN((k) + 1)) xcd_barrier(bar); } while (0)
    if (IN(0)) { phase_proA(A, F); SEAM(0); }
    if (IN(1)) { phase_proB(A, F); SEAM(1); }
    for (int l = 0; l < NL; ++l) {
        F.ws = opq(F.ws); F.ctl = opq(F.ctl); asm volatile("" : "+s"(F.wave), "+s"(F.vcu), "+s"(F.G));
        const int pb = 2 + PH_PER_LAYER * l;
        if (IN(pb + 0)) {
            pg8::Gemm g{WSP(bf16, WS_H), WSP(bf16, WS_WIN) + (size_t)l * INW * D, D}; pg8::StaticOrder S; S.init(M, INW, F.G, (int)blockIdx.x);
            pg8::EpiStore E{WSP(bf16, WS_P), INW, nullptr, 0};
            pg8::gemm_phase<pg8::EpiStore, pg8::StaticOrder>(F.lds, g, S, E, F.wave);
            SEAM(pb + 0);
        }
        if (IN(pb + 1)) { phase_post_proj(A, F, l); SEAM(pb + 1); }
        if (IN(pb + 2)) { phase_attn_naive(A, F, l); SEAM(pb + 2); }
        if (IN(pb + 3)) {
            pg8::Gemm g{WSP(bf16, WS_CAT), WSP(bf16, WS_WOUT) + (size_t)l * D * D, D}; pg8::StaticOrder S; S.init(M, D, F.G, (int)blockIdx.x);
            pg8::EpiStore E{WSP(bf16, WS_O), D, nullptr, 0};
            pg8::gemm_phase<pg8::EpiStore, pg8::StaticOrder>(F.lds, g, S, E, F.wave);
            SEAM(pb + 3);
        }
        if (IN(pb + 4)) { phase_post_out(A, F, l); SEAM(pb + 4); }
        if (IN(pb + 5)) { phase_moe_gather(A, F, l); SEAM(pb + 5); }
        if (IN(pb + 6)) {
            pg8::Gemm g{WSP(bf16, WS_BUF), WSP(bf16, WS_WGU) + (size_t)l * NE * GU * D, D}; pg8::MoeOrder S; S.init(WSP(int, WS_TAB), GU / 256, F.G, (int)blockIdx.x);
            pg8::EpiSwiglu E{WSP(bf16, WS_ACT), A.in[I_BGU] + (size_t)l * NE * GU};
            pg8::gemm_phase<pg8::EpiSwiglu, pg8::MoeOrder>(F.lds, g, S, E, F.wave);
            SEAM(pb + 6);
        }
        if (IN(pb + 7)) {
            pg8::Gemm g{WSP(bf16, WS_ACT), WSP(bf16, WS_WDN) + (size_t)l * NE * D * FF, FF}; pg8::MoeOrder S; S.init(WSP(int, WS_TAB), D / 256, F.G, (int)blockIdx.x);
            pg8::EpiStore E{WSP(bf16, WS_BUF), D, A.in[I_BDN] + (size_t)l * NE * D, D};
            pg8::gemm_phase<pg8::EpiStore, pg8::MoeOrder>(F.lds, g, S, E, F.wave);
            SEAM(pb + 7);
        }
        if (IN(pb + 8)) { phase_combine(A, F, l); SEAM(pb + 8); }
    }
#undef IN
#undef SEAM
}

extern "C" void kernel_launch(void* const* d_in, const int* in_sizes, int n_in, void* d_out, int out_size, void* d_ws, size_t ws_size, hipStream_t stream) {
    static int grid = 0;
    if (grid == 0) {
        if (n_in != 22 || out_size != NB * SEQ * D || ws_size < WS_END) { fprintf(stderr, "kernel_launch: unexpected shapes (n_in %d out %d ws %zu)\n", n_in, out_size, ws_size); grid = -1; return; }
        int dev = 0, cus = 0, per_cu = 0;
        if (hipGetDevice(&dev) != hipSuccess || hipDeviceGetAttribute(&cus, hipDeviceAttributeMultiprocessorCount, dev) != hipSuccess) { grid = -1; return; }
        if (hipFuncSetAttribute((const void*)fwd, hipFuncAttributeMaxDynamicSharedMemorySize, LDS_BYTES) != hipSuccess) { fprintf(stderr, "kernel_launch: hipFuncSetAttribute failed\n"); grid = -1; return; }
        if (hipOccupancyMaxActiveBlocksPerMultiprocessor(&per_cu, (const void*)fwd, NWAVES * 64, LDS_BYTES) != hipSuccess || per_cu < 1) fprintf(stderr, "kernel_launch: occupancy query reports %d\n", per_cu);
        (void)hipGetLastError();
        grid = cus;
    }
    if (grid < 0) return;
    if (hipMemsetAsync((char*)d_ws + WS_CTL, 0, CTL_ZERO_BYTES, stream) != hipSuccess) return;
    Args a{};
    for (int i = 0; i < 22; ++i) a.in[i] = (const float*)d_in[i];
    a.out = (float*)d_out; a.ws = (unsigned char*)d_ws;
#if MK_PER_PHASE
    for (int p = 0; p < N_PHASES; ++p) { a.ph_lo = p; a.ph_hi = p + 1; hipLaunchKernelGGL(fwd, dim3(grid), dim3(NWAVES * 64), LDS_BYTES, stream, a); }
#else
    a.ph_lo = 0; a.ph_hi = N_PHASES;
    hipLaunchKernelGGL(fwd, dim3(grid), dim3(NWAVES * 64), LDS_BYTES, stream, a);
#endif
}
```

```cpp
#include <hip/hip_runtime.h>
#include <cstdio>
#include <cstdint>

#ifndef MK_PER_PHASE
#define MK_PER_PHASE 0
#endif

#define GAS __attribute__((address_space(1)))
#define LAS __attribute__((address_space(3)))
typedef unsigned short bf16;
typedef unsigned v4u __attribute__((ext_vector_type(4)));
typedef unsigned v2u __attribute__((ext_vector_type(2)));
typedef float f32x4 __attribute__((ext_vector_type(4)));
typedef short bf16x8 __attribute__((ext_vector_type(8)));
typedef GAS unsigned gu32;

constexpr int NB = 8, SEQ = 4096, CTX = 256, T = CTX + SEQ, D = 1024, NL = 4;
constexpr int M = NB * T;
constexpr int INW = 2560;
constexpr int NE = 32, FF = 1024, GU = 2048;
constexpr int MOE_BLKS = M * 4 / 256 + NE;
constexpr int MOE_ROWS = MOE_BLKS * 256;
constexpr float EPS = 1e-6f;

namespace pg8 {
constexpr int BM = 256, BK = 64, HALF = 128, HTB = HALF * BK * 2, STAGE_BYTES = 8 * HTB, NXCD = 8, WGM = 8;
__host__ __device__ __forceinline__ int lds_byte(int r, int c) { const int st = (r >> 4) * 2 + (c >> 5), rr = r & 15, cc = c & 31, ob = rr * 64 + cc * 2; return st * 1024 + (ob ^ (((ob >> 9) & 1) << 5)); }
__host__ __device__ __forceinline__ void stage_rc(int b, int& R, int& C) { const int st = b / 1024, sb = b % 1024, swz = sb ^ (((sb >> 9) & 1) << 5); R = (st >> 1) * 16 + swz / 64; C = (st & 1) * 32 + (swz % 64) / 2; }
__host__ __device__ __forceinline__ int perm32(int rho) { const int n = rho >> 4, i = rho & 15; return 8 * (i >> 2) + 4 * n + (i & 3); }

struct Unit { int pm, pn, pb, e; };
struct Gemm { const bf16* A; const bf16* Bt; int K; };

struct StaticOrder {
    int nM, nN, nwg, G, c;
    __device__ void init(int M_, int N_, int G_, int c_) { nM = M_ / BM; nN = N_ / BM; nwg = nM * nN; G = G_; c = c_; }
    __device__ bool next(int i, Unit& u) const {
        const long L = (long)i * G + c; if (L >= nwg) return false;
        int wgid = (int)L; { const int q = nwg / NXCD, r = nwg % NXCD, xcd = wgid % NXCD, off = wgid / NXCD; wgid = (xcd < r ? xcd * (q + 1) : r * (q + 1) + (xcd - r) * q) + off; }
        const int nig = WGM * nN, gid = wgid / nig, fm = gid * WGM, gsz = (nM - fm) < WGM ? (nM - fm) : WGM;
        u.pm = fm + ((wgid % nig) % gsz); u.pn = (wgid % nig) / gsz; u.pb = u.pn; u.e = 0; return true;
    }
};
struct MoeOrder {
    const int* tab; int nN, G, c, total;
    __device__ void init(const int* tab_, int nN_, int G_, int c_) { tab = tab_; nN = nN_; G = G_; c = c_; total = tab_[MOE_BLKS] * nN_; }
    __device__ bool next(int i, Unit& u) const {
        const int L = i * G + c; if (L >= total) return false;
        const int blk = L / nN, pn = L % nN, e = tab[blk];
        u.pm = blk; u.pn = pn; u.pb = e * nN + pn; u.e = e; return true;
    }
};

__device__ __forceinline__ unsigned cvt_pk_bf16(float lo, float hi) { unsigned r; asm volatile("v_cvt_pk_bf16_f32 %0, %1, %2" : "=v"(r) : "v"(lo), "v"(hi)); return r; }

struct EpiStore {
    bf16* O; int ldc; const float* bias; int bias_stride;
    __device__ __forceinline__ void operator()(const f32x4 (&acc)[2][2][4][2], const Unit& u, int wr, int wc, int fr, int fq) const {
        const int row0 = u.pm * BM + wr * 64 + fr, col0 = u.pn * BM + wc * 32 + 8 * fq;
        f32x4 bv[2][2];
#pragma unroll
        for (int bj = 0; bj < 2; ++bj)
#pragma unroll
            for (int n = 0; n < 2; ++n) bv[bj][n] = bias ? *(const f32x4*)(bias + (size_t)u.e * bias_stride + col0 + bj * HALF + 4 * n) : (f32x4){0.f, 0.f, 0.f, 0.f};
#pragma unroll
        for (int ai = 0; ai < 2; ++ai)
#pragma unroll
            for (int m = 0; m < 4; ++m) { bf16* rowp = O + (size_t)(row0 + ai * HALF + m * 16) * ldc + col0;
#pragma unroll
                for (int bj = 0; bj < 2; ++bj) { const f32x4 v0 = acc[ai][bj][m][0] + bv[bj][0], v1 = acc[ai][bj][m][1] + bv[bj][1];
                    v4u w; w.x = cvt_pk_bf16(v0[0], v0[1]); w.y = cvt_pk_bf16(v0[2], v0[3]); w.z = cvt_pk_bf16(v1[0], v1[1]); w.w = cvt_pk_bf16(v1[2], v1[3]);
                    *(v4u*)(rowp + bj * HALF) = w; } }
    }
};
__device__ __forceinline__ float swiglu1(float g, float u) {
    g = fminf(g, 7.0f); u = fminf(fmaxf(u, -7.0f), 7.0f);
    const float sg = __builtin_amdgcn_rcpf(1.0f + __expf(-1.702f * g));
    return g * sg * (u + 1.0f);
}
struct EpiSwiglu {
    bf16* O; const float* bias;
    __device__ __forceinline__ void operator()(const f32x4 (&acc)[2][2][4][2], const Unit& u, int wr, int wc, int fr, int fq) const {
        const int row0 = u.pm * BM + wr * 64 + fr, colA = u.pn * HALF + wc * 32 + 8 * fq;
        f32x4 bg[2], bu[2];
#pragma unroll
        for (int n = 0; n < 2; ++n) { bg[n] = *(const f32x4*)(bias + (size_t)u.e * GU + colA + 4 * n); bu[n] = *(const f32x4*)(bias + (size_t)u.e * GU + FF + colA + 4 * n); }
#pragma unroll
        for (int ai = 0; ai < 2; ++ai)
#pragma unroll
            for (int m = 0; m < 4; ++m) { bf16* rowp = O + (size_t)(row0 + ai * HALF + m * 16) * FF + colA;
                float a[8];
#pragma unroll
                for (int n = 0; n < 2; ++n) { const f32x4 g = acc[ai][0][m][n] + bg[n], uu = acc[ai][1][m][n] + bu[n];
#pragma unroll
                    for (int i = 0; i < 4; ++i) a[4 * n + i] = swiglu1(g[i], uu[i]); }
                v4u w; w.x = cvt_pk_bf16(a[0], a[1]); w.y = cvt_pk_bf16(a[2], a[3]); w.z = cvt_pk_bf16(a[4], a[5]); w.w = cvt_pk_bf16(a[6], a[7]);
                *(v4u*)rowp = w; }
    }
};

template <class Epi, class Sched>
__device__ __forceinline__ void gemm_phase(LAS unsigned char* lds, const Gemm g, const Sched& S, const Epi& E, int wid) {
    int lane; asm volatile("v_mbcnt_lo_u32_b32 %0, -1, 0\n\tv_mbcnt_hi_u32_b32 %0, -1, %0" : "=&v"(lane));
    const int tid = wid * 64 + lane, wr = wid >> 2, wc = wid & 3, fr = lane & 15, fq = lane >> 4;
    const int K = g.K, nt = K / BK;
    unsigned voffA[2], voffB[2];
#pragma unroll
    for (int i = 0; i < 2; ++i) { int R, C; stage_rc(tid * 16 + i * 8192, R, C); const int Rb = (R & ~31) + perm32(R & 31);
        voffA[i] = (unsigned)(R * K + C) * 2u; voffB[i] = (unsigned)(Rb * K + C) * 2u; }
    const size_t kstep = (size_t)(BK * 2);
    const size_t hstep = (size_t)HALF * K * 2;
    const size_t tstep = 2 * hstep;
    const unsigned ldsw = (unsigned)wid * 1024u;
    const int aoff = lds_byte(wr * 64 + fr, fq * 8), boff = lds_byte(wc * 32 + fr, fq * 8);
#define PG8_SA(b, h) (((b) * 2 + (h)) * HTB)
#define PG8_SB(b, h) ((4 + (b) * 2 + (h)) * HTB)
#define PG8_STAGE(bufoff, gbase, voff) do { _Pragma("unroll") for (int _i = 0; _i < 2; ++_i) \
        __builtin_amdgcn_global_load_lds((const unsigned*)((const char*)(gbase) + (voff)[_i]), (LAS unsigned*)(lds + (bufoff) + ldsw + _i * 8192), 16, 0, 0); } while (0)
#define PG8_LDA(dst, b, h) do { _Pragma("unroll") for (int m = 0; m < 4; ++m) _Pragma("unroll") for (int k = 0; k < 2; ++k) dst[m][k] = *(const LAS bf16x8*)(lds + PG8_SA(b, h) + aoff + m * 2048 + k * 1024); } while (0)
#define PG8_LDB(dst, b, h) do { _Pragma("unroll") for (int n = 0; n < 2; ++n) _Pragma("unroll") for (int k = 0; k < 2; ++k) dst[n][k] = *(const LAS bf16x8*)(lds + PG8_SB(b, h) + boff + n * 2048 + k * 1024); } while (0)
#define PG8_MMA(ai, bj, At, Bt) do { __builtin_amdgcn_s_setprio(1); _Pragma("unroll") for (int m = 0; m < 4; ++m) _Pragma("unroll") for (int n = 0; n < 2; ++n) _Pragma("unroll") for (int k = 0; k < 2; ++k) \
        acc[ai][bj][m][n] = __builtin_amdgcn_mfma_f32_16x16x32_bf16(Bt[n][k], At[m][k], acc[ai][bj][m][n], 0, 0, 0); __builtin_amdgcn_s_setprio(0); } while (0)
#define PG8_WAIT_V(n) asm volatile("s_waitcnt vmcnt(" #n ")" ::: "memory")
#define PG8_WAIT_L(n) asm volatile("s_waitcnt lgkmcnt(" #n ")" ::: "memory")
#define PG8_BAR __builtin_amdgcn_s_barrier()
#define PG8_SCHED __builtin_amdgcn_sched_barrier(0)
    Unit cur, nxt; int ui = 0;
    if (!S.next(0, cur)) return;
    f32x4 acc[2][2][4][2];
#pragma unroll
    for (int a = 0; a < 2; ++a)
#pragma unroll
        for (int b = 0; b < 2; ++b)
#pragma unroll
            for (int m = 0; m < 4; ++m)
#pragma unroll
                for (int n = 0; n < 2; ++n) acc[a][b][m][n] = (f32x4){0.f, 0.f, 0.f, 0.f};
    bf16x8 At[4][2], B0[2][2], B1[2][2];
    const char* cA = (const char*)g.A + (size_t)cur.pm * tstep; const char* cB = (const char*)g.Bt + (size_t)cur.pb * tstep;
    PG8_STAGE(PG8_SB(0, 0), cB, voffB); PG8_STAGE(PG8_SB(0, 1), cB + hstep, voffB); PG8_STAGE(PG8_SA(0, 0), cA, voffA); PG8_STAGE(PG8_SA(0, 1), cA + hstep, voffA);
    if (wr == 1) PG8_BAR;
    PG8_WAIT_V(2); PG8_BAR;
    PG8_STAGE(PG8_SB(1, 0), cB + kstep, voffB); PG8_STAGE(PG8_SA(1, 0), cA + kstep, voffA); PG8_STAGE(PG8_SB(1, 1), cB + hstep + kstep, voffB);
    PG8_WAIT_V(6); PG8_BAR;
    for (;;) {
        const bool has_next = S.next(ui + 1, nxt);
        const char* nA = has_next ? (const char*)g.A + (size_t)nxt.pm * tstep : cA; const char* nB = has_next ? (const char*)g.Bt + (size_t)nxt.pb * tstep : cB;
        for (int t = 0; t < nt; t += 2) {
            const bool last = (t == nt - 2);
            const char* a1 = cA + (size_t)(t + 1) * kstep;
            const char* a2 = last ? nA : cA + (size_t)(t + 2) * kstep; const char* b2 = last ? nB : cB + (size_t)(t + 2) * kstep;
            const char* a3 = a2 + kstep; const char* b3 = b2 + kstep;
            PG8_LDB(B0, 0, 0); PG8_LDB(B1, 0, 1); PG8_SCHED; PG8_LDA(At, 0, 0); PG8_STAGE(PG8_SA(1, 1), a1 + hstep, voffA);
            PG8_WAIT_V(8); PG8_WAIT_L(0); PG8_BAR; PG8_MMA(0, 0, At, B0); PG8_MMA(0, 1, At, B1); PG8_BAR; PG8_SCHED;
            PG8_LDA(At, 0, 1); PG8_STAGE(PG8_SB(0, 0), b2, voffB); PG8_STAGE(PG8_SB(0, 1), b2 + hstep, voffB); PG8_STAGE(PG8_SA(0, 0), a2, voffA);
            PG8_WAIT_V(8); PG8_WAIT_L(0); PG8_BAR; PG8_MMA(1, 0, At, B0); PG8_MMA(1, 1, At, B1); PG8_BAR; PG8_SCHED;
            PG8_LDB(B0, 1, 0); PG8_LDB(B1, 1, 1); PG8_SCHED; PG8_LDA(At, 1, 0); PG8_STAGE(PG8_SA(0, 1), a2 + hstep, voffA);
            PG8_WAIT_V(8); PG8_WAIT_L(0); PG8_BAR; PG8_MMA(0, 0, At, B0); PG8_MMA(0, 1, At, B1); PG8_BAR; PG8_SCHED;
            PG8_LDA(At, 1, 1); PG8_STAGE(PG8_SB(1, 0), b3, voffB); PG8_STAGE(PG8_SB(1, 1), b3 + hstep, voffB); PG8_STAGE(PG8_SA(1, 0), a3, voffA);
            PG8_WAIT_V(8); PG8_WAIT_L(0); PG8_BAR; PG8_MMA(1, 0, At, B0); PG8_MMA(1, 1, At, B1); PG8_BAR; PG8_SCHED;
        }
        if (wr == 0) PG8_BAR;
        E(acc, cur, wr, wc, fr, fq);
        if (!has_next) break;
#pragma unroll
        for (int a = 0; a < 2; ++a)
#pragma unroll
            for (int b = 0; b < 2; ++b)
#pragma unroll
                for (int m = 0; m < 4; ++m)
#pragma unroll
                    for (int n = 0; n < 2; ++n) acc[a][b][m][n] = (f32x4){0.f, 0.f, 0.f, 0.f};
        cur = nxt; cA = nA; cB = nB; ++ui;
        if (wr == 1) PG8_BAR;
    }
    PG8_WAIT_V(0);
    PG8_BAR;
#undef PG8_SA
#undef PG8_SB
#undef PG8_STAGE
#undef PG8_LDA
#undef PG8_LDB
#undef PG8_MMA
#undef PG8_WAIT_V
#undef PG8_WAIT_L
#undef PG8_BAR
#undef PG8_SCHED
}
}

constexpr size_t MiB = 1u << 20;
constexpr size_t WS_CTL = 0, CTL_ZERO_BYTES = 1 * MiB;
constexpr size_t WS_MOD = 2 * MiB;
constexpr size_t WS_TAB = 3 * MiB;
constexpr size_t WS_RE = 4 * MiB, WS_RPOS = 5 * MiB, WS_RGATE = 6 * MiB, WS_RDEST = 7 * MiB;
constexpr size_t WS_WIN = 8 * MiB;
constexpr size_t WS_WOUT = 28 * MiB;
constexpr size_t WS_WGU = 36 * MiB;
constexpr size_t WS_WDN = 548 * MiB;
constexpr size_t WS_X = 804 * MiB;
constexpr size_t WS_H = 940 * MiB;
constexpr size_t WS_P = 1008 * MiB;
constexpr size_t WS_VT = 1178 * MiB;
constexpr size_t WS_CAT = 1229 * MiB;
constexpr size_t WS_O = 1297 * MiB;
constexpr size_t WS_BUF = 1365 * MiB;
constexpr size_t WS_ACT = 1653 * MiB;
constexpr size_t WS_END = 1941 * MiB;
constexpr int CW_TMO = 0, CW_CODE = 1, CW_BAR = 4096, CW_CNT = 8192, CW_WORK = 8192 + 1024, CW_KMAX = 8192 + 2048;

constexpr int NWAVES = 8;
constexpr int RING_BYTES = 131072;
constexpr int LDSCTL_OFF = RING_BYTES, MISC_OFF = LDSCTL_OFF + 320;
constexpr int LDS_BYTES = 147456;

#define RLX_AGENT __ATOMIC_RELAXED, __HIP_MEMORY_SCOPE_AGENT
#define LDS_WAIT() asm volatile("s_waitcnt lgkmcnt(0)" ::: "memory")
__device__ __forceinline__ unsigned f2bf(float f) { unsigned u = __builtin_bit_cast(unsigned, f); return (u + 0x7fffu + ((u >> 16) & 1u)) >> 16; }
__device__ __forceinline__ unsigned pk2(float lo, float hi) { return f2bf(lo) | (f2bf(hi) << 16); }
__device__ __forceinline__ float bflo(unsigned w) { return __builtin_bit_cast(float, w << 16); }
__device__ __forceinline__ float bfhi(unsigned w) { return __builtin_bit_cast(float, w & 0xffff0000u); }
__device__ __forceinline__ float bf2f(bf16 h) { return __builtin_bit_cast(float, (unsigned)h << 16); }
template <class Tp> __device__ __forceinline__ Tp* opq(Tp* p) { asm volatile("" : "+s"(p)); return p; }
__device__ __forceinline__ int lane_id() { int x; asm volatile("v_mbcnt_lo_u32_b32 %0, -1, 0\n\tv_mbcnt_hi_u32_b32 %0, -1, %0" : "=&v"(x)); return x; }
template <int MASK> __device__ __forceinline__ float sx(float v) {
    static_assert(MASK >= 1 && MASK < 32, "sx: xor mask inside a 32-lane half");
    return __builtin_bit_cast(float, __builtin_amdgcn_ds_swizzle(__builtin_bit_cast(int, v), (MASK << 10) | 0x1f));
}
template <int MASK> __device__ __forceinline__ int sxi(int v) { return __builtin_amdgcn_ds_swizzle(v, (MASK << 10) | 0x1f); }
__device__ __forceinline__ void swap32(unsigned& a, unsigned& b) { asm volatile("s_nop 1\n\tv_permlane32_swap_b32 %0, %1\n\ts_nop 1" : "+v"(a), "+v"(b)); }
__device__ __forceinline__ float sum32(float v) { unsigned a = __builtin_bit_cast(unsigned, v), b = a; swap32(a, b); return __builtin_bit_cast(float, a) + __builtin_bit_cast(float, b); }
__device__ __forceinline__ float max32(float v) { unsigned a = __builtin_bit_cast(unsigned, v), b = a; swap32(a, b); return fmaxf(__builtin_bit_cast(float, a), __builtin_bit_cast(float, b)); }
__device__ __forceinline__ float other32(float v, bool) { const unsigned u = __builtin_bit_cast(unsigned, v); unsigned a = u, b = u; swap32(a, b); return __builtin_bit_cast(float, a ^ b ^ u); }
__device__ __forceinline__ int other32i(int v, bool) { unsigned a = (unsigned)v, b = a; swap32(a, b); return (int)(a ^ b ^ (unsigned)v); }
__device__ __forceinline__ float half_sum(float v) { v += sx<1>(v); v += sx<2>(v); v += sx<4>(v); v += sx<8>(v); v += sx<16>(v); return v; }
__device__ __forceinline__ float wave_sum(float v) { return sum32(half_sum(v)); }

#define XB_TMO      128
#define XB_XCNT(j)  (256  + 64 * (j))
#define XB_XSUB(j)  (1280 + 64 * (j))
#define XB_XGEN(j)  (2304 + 64 * (j))
#define XB_TOP      3328
#define XB_TOPGEN   3392
#define XCD_BAR_WORDS 3456
#define XB_SPIN_CAP (1u << 18)
__device__ __forceinline__ unsigned xb_ld(unsigned* p)              { return __hip_atomic_load(p, __ATOMIC_RELAXED, __HIP_MEMORY_SCOPE_AGENT); }
__device__ __forceinline__ unsigned xb_add(unsigned* p, unsigned v) { return __hip_atomic_fetch_add(p, v, __ATOMIC_RELAXED, __HIP_MEMORY_SCOPE_AGENT); }
__device__ __forceinline__ unsigned xb_xcc_id() { return (unsigned)__builtin_amdgcn_s_getreg((3 << 11) | 20) & 0xFu; }
#define XB_SPIN(cond, bar) do { unsigned _sp = 0; while (cond) { __builtin_amdgcn_s_sleep(1); \
    if ((++_sp & 255u) == 0u) { if (xb_ld(&(bar)[XB_TMO])) break; if (_sp > XB_SPIN_CAP) { atomicAdd(&(bar)[XB_TMO], 1u); break; } } } } while (0)
struct XcdBarrier { unsigned* bar; unsigned x; volatile LAS unsigned* st; int wave; };
__device__ __forceinline__ XcdBarrier xcd_barrier_post(unsigned* bar, volatile LAS unsigned* st, int wave) {
    XcdBarrier b; b.bar = bar; b.x = xb_xcc_id(); b.st = st; b.wave = wave;
    if (wave == 0 && lane_id() == 0) (void)xb_add(&bar[XB_XCNT(b.x)], 1u);
    return b;
}
__device__ __forceinline__ void xcd_barrier_complete(unsigned* bar, unsigned x, unsigned& nloc, unsigned& nx) {
    const unsigned G = gridDim.x * gridDim.y * gridDim.z;
    unsigned sum, cnt, mine, sp = 0u;
    for (;;) {
        sum = 0u; cnt = 0u; mine = 0u;
#pragma unroll
        for (unsigned j = 0; j < 16; ++j) { const unsigned c = xb_ld(&bar[XB_XCNT(j)]); sum += c; cnt += (c > 0u) ? 1u : 0u; mine = (j == x) ? c : mine; }
        if (sum == G) break;
        __builtin_amdgcn_s_sleep(1);
        if ((++sp & 255u) == 0u) { if (xb_ld(&bar[XB_TMO])) break; if (sp > XB_SPIN_CAP) { atomicAdd(&bar[XB_TMO], 1u); break; } }
    }
    nloc = mine > 0u ? mine : 1u; nx = cnt > 0u ? cnt : 1u;
}
__device__ __forceinline__ void xcd_barrier(const XcdBarrier& b) {
    asm volatile("s_waitcnt vmcnt(0)" ::: "memory");
    __syncthreads();
    if (b.wave == 0 && lane_id() == 0) {
        unsigned* bar = opq(b.bar);
        __builtin_amdgcn_s_waitcnt(0);
        unsigned nloc = b.st[0], nx = b.st[1];
        if (nloc == 0u) { xcd_barrier_complete(bar, b.x, nloc, nx); b.st[0] = nloc; b.st[1] = nx; }
        const unsigned old = xb_add(&bar[XB_XSUB(b.x)], 1u);
        const unsigned gen = old / nloc;
        if (old + 1u == (gen + 1u) * nloc) {
            __builtin_amdgcn_fence(__ATOMIC_RELEASE, "agent");
            asm volatile("s_waitcnt vmcnt(0)" ::: "memory");
            const unsigned og = xb_add(&bar[XB_TOP], 1u);
            const unsigned tg = og / nx;
            if (og + 1u == (tg + 1u) * nx) xb_add(&bar[XB_TOPGEN], 1u);
            else XB_SPIN(xb_ld(&bar[XB_TOPGEN]) == tg, bar);
            __builtin_amdgcn_fence(__ATOMIC_ACQUIRE, "agent");
            xb_add(&bar[XB_XGEN(b.x)], 1u);
            asm volatile("s_waitcnt vmcnt(0)" ::: "memory");
        } else {
            XB_SPIN(xb_ld(&bar[XB_XGEN(b.x)]) == gen, bar);
            __builtin_amdgcn_fence(__ATOMIC_ACQUIRE, "agent");
            asm volatile("s_waitcnt vmcnt(0)" ::: "memory");
        }
    }
    __syncthreads();
}

struct Args { const float* in[22]; float* out; unsigned char* ws; int ph_lo, ph_hi; };
enum { I_X = 0, I_C, I_CTX, I_CCTX, I_WADA, I_BADA, I_N1G, I_N2G, I_WIN, I_WOUT, I_DLAM, I_DG, I_QKG, I_RPB, I_SINK, I_RW, I_RB, I_WGU, I_BGU, I_WDN, I_BDN, I_FG };
struct Frame {
    LAS unsigned char* lds; unsigned char* ws; unsigned* ctl;
    int vcu, G, wave;
};
#define WSP(type, off) ((type*)(F.ws + (off)))

struct Row { f32x4 v[4]; };
__device__ __forceinline__ void row_load_f32(Row& r, const float* p, int lane) {
#pragma unroll
    for (int j = 0; j < 4; ++j) r.v[j] = ((const f32x4*)p)[lane + 64 * j];
}
__device__ __forceinline__ void row_store_f32(const Row& r, float* p, int lane) {
#pragma unroll
    for (int j = 0; j < 4; ++j) ((f32x4*)p)[lane + 64 * j] = r.v[j];
}
__device__ __forceinline__ void row_load_bf16(Row& r, const bf16* p, int lane) {
#pragma unroll
    for (int j = 0; j < 4; ++j) { const v2u w = ((const v2u*)p)[lane + 64 * j]; r.v[j] = (f32x4){bflo(w.x), bfhi(w.x), bflo(w.y), bfhi(w.y)}; }
}
__device__ __forceinline__ void row_store_bf16(const Row& r, bf16* p, int lane) {
#pragma unroll
    for (int j = 0; j < 4; ++j) { v2u w; w.x = pk2(r.v[j][0], r.v[j][1]); w.y = pk2(r.v[j][2], r.v[j][3]); ((v2u*)p)[lane + 64 * j] = w; }
}
__device__ __forceinline__ float row_rstd(const Row& r) {
    float s = 0.f;
#pragma unroll
    for (int j = 0; j < 4; ++j) s += (r.v[j][0] * r.v[j][0] + r.v[j][1] * r.v[j][1]) + (r.v[j][2] * r.v[j][2] + r.v[j][3] * r.v[j][3]);
    return 1.0f / sqrtf(wave_sum(s) * (1.0f / D) + EPS);
}
__device__ __forceinline__ void row_modulate(Row& h, const Row& x, float rstd, const float* g, const float* sc, const float* sh, int lane) {
#pragma unroll
    for (int j = 0; j < 4; ++j) { const f32x4 gg = ((const f32x4*)g)[lane + 64 * j], s1 = ((const f32x4*)sc)[lane + 64 * j], s0 = ((const f32x4*)sh)[lane + 64 * j];
        h.v[j] = x.v[j] * rstd * gg * (s1 + 1.0f) + s0; }
}

__device__ __forceinline__ void transpose_item(const float* W, int K, int N, bf16* WT, int k0, int n0, int dest_row0, LAS float* scr, int lane) {
#pragma unroll 8
    for (int i = 0; i < 32; ++i) { const int kk = 2 * i + (lane >> 5); scr[kk * 33 + (lane & 31)] = W[(size_t)(k0 + kk) * N + n0 + (lane & 31)]; }
    LDS_WAIT(); asm volatile("" ::: "memory");
    const int c = lane & 7;
#pragma unroll
    for (int j = 0; j < 4; ++j) { const int n = (lane >> 3) + 8 * j; const LAS float* s = scr + (8 * c) * 33 + n;
        v4u o; o.x = pk2(s[0 * 33], s[1 * 33]); o.y = pk2(s[2 * 33], s[3 * 33]); o.z = pk2(s[4 * 33], s[5 * 33]); o.w = pk2(s[6 * 33], s[7 * 33]);
        *(v4u*)(WT + (size_t)(dest_row0 + n) * K + k0 + 8 * c) = o; }
    LDS_WAIT(); asm volatile("" ::: "memory");
}
__device__ __forceinline__ void phase_proA(const Args& A, Frame& F) {
    const int wave = F.wave, lane = lane_id(), tid = wave * 64 + lane; (void)tid;
    LAS float* sl = (LAS float*)F.lds;
    LAS float* scr = (LAS float*)(F.lds + 40960 + wave * 8704);
    for (int i = tid; i < 9 * D; i += NWAVES * 64) { const int r = i >> 10, k = i & 1023; const float v = r < 8 ? A.in[I_C][r * D + k] : A.in[I_CCTX][k]; sl[i] = v / (1.0f + __expf(-v)); }
    __syncthreads();
    const int gw = F.vcu * NWAVES + wave, NGW = F.G * NWAVES;
    constexpr int N_ADA = NL * 96;
    constexpr int IT_IN = 16 * 80, IT_OUT = 16 * 32, IT_GU = 16 * 64, IT_DN = 16 * 32;
    constexpr int IT_LAYER = IT_IN + IT_OUT + NE * IT_GU + NE * IT_DN;
    constexpr int NITEMS = N_ADA + NL * IT_LAYER;
    for (int it = gw; it < NITEMS; it += NGW) {
        if (it < N_ADA) {
            const int l = it / 96, n = (it % 96) * 64 + lane;
            const float* w = A.in[I_WADA] + (size_t)l * D * 6144 + n;
            float acc[9];
#pragma unroll
            for (int r = 0; r < 9; ++r) acc[r] = 0.f;
#pragma unroll 4
            for (int k = 0; k < D; ++k) { const float wv = w[(size_t)k * 6144];
#pragma unroll
                for (int r = 0; r < 9; ++r) acc[r] += sl[r * D + k] * wv; }
            const float bb = A.in[I_BADA][l * 6144 + n];
            float* mod = WSP(float, WS_MOD);
#pragma unroll
            for (int r = 0; r < 9; ++r) mod[(size_t)(l * 9 + r) * 6144 + n] = acc[r] + bb;
            continue;
        }
        int r = it - N_ADA; const int l = r / IT_LAYER; r -= l * IT_LAYER;
        if (r < IT_IN) { const int kb = r / 80, nb = r % 80; transpose_item(A.in[I_WIN] + (size_t)l * D * INW, D, INW, WSP(bf16, WS_WIN) + (size_t)l * INW * D, 64 * kb, 32 * nb, 32 * nb, scr, lane); continue; } r -= IT_IN;
        if (r < IT_OUT) { const int kb = r / 32, nb = r % 32; transpose_item(A.in[I_WOUT] + (size_t)l * D * D, D, D, WSP(bf16, WS_WOUT) + (size_t)l * D * D, 64 * kb, 32 * nb, 32 * nb, scr, lane); continue; } r -= IT_OUT;
        if (r < NE * IT_GU) { const int e = r / IT_GU, q = r % IT_GU, kb = q / 64, nb = q % 64, n0 = 32 * nb;
            const int dest = n0 < FF ? (n0 >> 7) * 256 + (n0 & 127) : ((n0 - FF) >> 7) * 256 + 128 + ((n0 - FF) & 127);
            transpose_item(A.in[I_WGU] + (size_t)(l * NE + e) * D * GU, D, GU, WSP(bf16, WS_WGU) + (size_t)(l * NE + e) * GU * D, 64 * kb, n0, dest, scr, lane); continue; } r -= NE * IT_GU;
        { const int e = r / IT_DN, q = r % IT_DN, kb = q / 32, nb = q % 32;
            transpose_item(A.in[I_WDN] + (size_t)(l * NE + e) * FF * D, FF, D, WSP(bf16, WS_WDN) + (size_t)(l * NE + e) * D * FF, 64 * kb, 32 * nb, 32 * nb, scr, lane); }
    }
}

__device__ __forceinline__ void phase_proB(const Args& A, Frame& F) {
    const int wave = F.wave, lane = lane_id(), tid = wave * 64 + lane; (void)tid;
    const int gw = F.vcu * NWAVES + wave, NGW = F.G * NWAVES;
    const float* mod = WSP(float, WS_MOD);
    for (int m = gw; m < M; m += NGW) {
        const int b = m / T, t = m % T; const int r = t < CTX ? 8 : b;
        const float* src = t < CTX ? A.in[I_CTX] + ((size_t)b * CTX + t) * D : A.in[I_X] + ((size_t)b * SEQ + (t - CTX)) * D;
        Row x, h; row_load_f32(x, src, lane);
        row_store_f32(x, WSP(float, WS_X) + (size_t)m * D, lane);
        const float rstd = row_rstd(x);
        const float* md = mod + (size_t)(0 * 9 + r) * 6144;
        row_modulate(h, x, rstd, A.in[I_N1G], md + 1024, md, lane);
        row_store_bf16(h, WSP(bf16, WS_H) + (size_t)m * D, lane);
    }
}

constexpr float LOG2E = 1.4426950408889634f;
constexpr float QS32 = 0.17677669529663687f * LOG2E, QS64 = 0.125f * LOG2E;
__device__ __forceinline__ float rnd_bf(float x) { return __builtin_bit_cast(float, f2bf(x) << 16); }
__device__ __forceinline__ void phase_post_proj(const Args& A, Frame& F, int l) {
    const int wave = F.wave, lane = lane_id(), tid = wave * 64 + lane;
    LAS bf16* vt = (LAS bf16*)F.lds;
    LAS float* t64 = (LAS float*)(F.lds + 102400);
    LAS float* t32 = (LAS float*)(F.lds + 102400 + 8192);
    for (int i = tid; i < 64 * 16; i += NWAVES * 64) { const int pos = i >> 4, f = i & 15; const float inv = exp2f(-(float)f * (13.287712379549449f / 16.0f)); const float a = (float)pos * inv; t64[2 * i] = cosf(a); t64[2 * i + 1] = sinf(a); }
    for (int i = tid; i < 64 * 8; i += NWAVES * 64) { const int pos = i >> 3, f = i & 7; const float inv = exp2f(-(float)f * (13.287712379549449f / 8.0f)); const float a = (float)pos * inv; t32[2 * i] = cosf(a); t32[2 * i + 1] = sinf(a); }
    __syncthreads();
    const float g0 = A.in[I_QKG][l * 128 + lane], g1 = A.in[I_QKG][l * 128 + 64 + lane];
    bf16* P = WSP(bf16, WS_P); bf16* VT = WSP(bf16, WS_VT);
    for (int tile = F.vcu; tile < M / 64; tile += F.G) {
        float kmA[4], kmB[2], kmC[4], kmD[2];
#pragma unroll
        for (int i = 0; i < 4; ++i) { kmA[i] = 0.f; kmC[i] = 0.f; }
        kmB[0] = kmB[1] = kmD[0] = kmD[1] = 0.f;
        for (int tk = 0; tk < 8; ++tk) {
            const int tl = wave * 8 + tk, m = tile * 64 + tl, t = m % T;
            const bool lat = t >= CTX; const int sp = t - CTX, grow = sp >> 6, gcol = sp & 63;
            bf16* prow = P + (size_t)m * INW;
            { const int i32 = lane & 31, pos = (i32 & 16) ? gcol : grow; const float cs = lat ? t32[2 * (pos * 8 + (i32 & 7))] : 1.f, sn = lat ? t32[2 * (pos * 8 + (i32 & 7)) + 1] : 0.f;
#pragma unroll
              for (int seg = 0; seg < 8; ++seg) { const float x = bf2f(prow[seg * 64 + lane]); const float pr = sx<8>(x);
                  float o = (i32 & 8) ? x * cs + pr * sn : x * cs - pr * sn; if (seg < 4) o *= QS32;
                  const unsigned ob = f2bf(o); prow[seg * 64 + lane] = (bf16)ob;
                  if (seg >= 4) { const float kr = __builtin_bit_cast(float, ob << 16); kmA[seg - 4] = fmaxf(kmA[seg - 4], half_sum(kr * kr)); } } }
            const int pos64 = (lane & 32) ? gcol : grow; const float cs64 = lat ? t64[2 * (pos64 * 16 + (lane & 15))] : 1.f, sn64 = lat ? t64[2 * (pos64 * 16 + (lane & 15)) + 1] : 0.f;
#pragma unroll
            for (int seg = 12; seg < 18; ++seg) { float x = bf2f(prow[seg * 64 + lane]); const float ss = wave_sum(x * x);
                x = x * (1.0f / sqrtf(ss * (1.0f / 64.0f) + EPS)) * (seg < 16 ? g0 : g1);
                const float pr = sx<16>(x); float o = (lane & 16) ? x * cs64 + pr * sn64 : x * cs64 - pr * sn64; if (seg < 16) o *= QS64;
                const unsigned ob = f2bf(o); prow[seg * 64 + lane] = (bf16)ob;
                if (seg >= 16) { const float kr = __builtin_bit_cast(float, ob << 16); kmB[seg - 16] = fmaxf(kmB[seg - 16], wave_sum(kr * kr)); } }
#pragma unroll
            for (int seg = 20; seg < 24; ++seg) { const float x = bf2f(prow[seg * 64 + lane]); prow[seg * 64 + lane] = (bf16)f2bf(x * QS64); }
#pragma unroll
            for (int seg = 24; seg < 28; ++seg) { const float kr = bf2f(prow[seg * 64 + lane]); kmC[seg - 24] = fmaxf(kmC[seg - 24], wave_sum(kr * kr)); }
#pragma unroll
            for (int seg = 32; seg < 38; ++seg) { const float x = bf2f(prow[seg * 64 + lane]); const float pr = sx<16>(x);
                float o = (lane & 16) ? x * cs64 + pr * sn64 : x * cs64 - pr * sn64; if (seg < 36) o *= QS64;
                const unsigned ob = f2bf(o); prow[seg * 64 + lane] = (bf16)ob;
                if (seg >= 36) { const float kr = __builtin_bit_cast(float, ob << 16); kmD[seg - 36] = fmaxf(kmD[seg - 36], wave_sum(kr * kr)); } }
#pragma unroll
            for (int vh = 0; vh < 12; ++vh) { const int seg = vh < 4 ? 8 + vh : (vh < 6 ? 18 + (vh - 4) : (vh < 10 ? 28 + (vh - 6) : 38 + (vh - 10)));
                vt[(vh * 64 + lane) * 66 + tl] = prow[seg * 64 + lane]; }
        }
        const int b = (tile * 64) / T, t0 = (tile * 64) % T;
        { unsigned* km = F.ctl + CW_KMAX + (l * NB + b) * 16;
          if (lane == 0 || lane == 32) {
#pragma unroll
              for (int i = 0; i < 4; ++i) __hip_atomic_fetch_max(km + 2 * i + (lane >> 5), __builtin_bit_cast(unsigned, kmA[i]), RLX_AGENT); }
          if (lane == 0) { __hip_atomic_fetch_max(km + 8, __builtin_bit_cast(unsigned, kmB[0]), RLX_AGENT); __hip_atomic_fetch_max(km + 9, __builtin_bit_cast(unsigned, kmB[1]), RLX_AGENT);
#pragma unroll
              for (int i = 0; i < 4; ++i) __hip_atomic_fetch_max(km + 10 + i, __builtin_bit_cast(unsigned, kmC[i]), RLX_AGENT);
              __hip_atomic_fetch_max(km + 14, __builtin_bit_cast(unsigned, kmD[0]), RLX_AGENT); __hip_atomic_fetch_max(km + 15, __builtin_bit_cast(unsigned, kmD[1]), RLX_AGENT); } }
        __syncthreads();
        for (int idx = tid; idx < 768 * 8; idx += NWAVES * 64) { const int row = idx >> 3, ch = idx & 7;
            const LAS unsigned* sp = (const LAS unsigned*)((const LAS unsigned char*)vt + row * 132 + ch * 16);
            v4u w; w.x = sp[0]; w.y = sp[1]; w.z = sp[2]; w.w = sp[3];
            *(v4u*)(VT + ((size_t)b * 768 + row) * T + t0 + ch * 8) = w; }
        __syncthreads();
    }
}

namespace att {
typedef float f32x16 __attribute__((ext_vector_type(16)));
constexpr int K_RING = 0, V_RING = 24576, RPB_OFF = 49152, UW_OFF = 51200;
__device__ __forceinline__ int swap23(int r) { return (r & ~12) | ((r & 4) << 1) | ((r & 8) >> 1); }
__device__ __forceinline__ bf16x8 pack8(const f32x16& p, int base) {
    v4u w; w.x = pg8::cvt_pk_bf16(p[base + 0], p[base + 1]); w.y = pg8::cvt_pk_bf16(p[base + 2], p[base + 3]); w.z = pg8::cvt_pk_bf16(p[base + 4], p[base + 5]); w.w = pg8::cvt_pk_bf16(p[base + 6], p[base + 7]);
    return __builtin_bit_cast(bf16x8, w);
}
__device__ __forceinline__ float sumsq8(bf16x8 q) { const v4u w = __builtin_bit_cast(v4u, q); float s = 0.f;
    s += bflo(w.x) * bflo(w.x) + bfhi(w.x) * bfhi(w.x) + bflo(w.y) * bflo(w.y) + bfhi(w.y) * bfhi(w.y) + bflo(w.z) * bflo(w.z) + bfhi(w.z) * bfhi(w.z) + bflo(w.w) * bflo(w.w) + bfhi(w.w) * bfhi(w.w); return s; }

template <bool DIFF>
__device__ __forceinline__ void unit(const Args& A, Frame& F, int l, int mode, int b, int hk, int qblk, bool is_ctx, float lam, float lam_init) {
    const int wave = F.wave, lane = lane_id(), r = lane & 31, h = lane >> 5;
    LAS unsigned char* lds = F.lds;
    const bf16* P = WSP(bf16, WS_P); const bf16* VT = WSP(bf16, WS_VT);
    const bool gqa = (mode & 1) != 0;
    const int head = gqa ? 2 * hk + (wave >> 2) : hk;
    const int pos0w = gqa ? qblk * 128 + 32 * (wave & 3) : qblk * 256 + 32 * wave;
    const int pos = pos0w + r;
    const size_t mq = (size_t)b * T + (is_ctx ? pos : CTX + pos);
    const int qcol = mode == 0 ? 64 * head : (mode == 1 ? 768 + 64 * head : (mode == 2 ? 1280 + 64 * head : 2048 + 64 * head));
    const int kcol = mode == 0 ? 256 + 64 * hk : (mode == 1 ? 1024 + 64 * hk : (mode == 2 ? 1536 + 64 * hk : 2304 + 64 * hk));
    const int vh = mode == 0 ? hk : (mode == 1 ? 4 + hk : (mode == 2 ? 6 + hk : 10 + hk));
    const int kid = mode == 0 ? 2 * hk : (mode == 1 ? 8 + hk : (mode == 2 ? 10 + hk : 14 + hk));
    const int ocol = mode * 256 + 64 * head;
    bf16x8 qf[4];
#pragma unroll
    for (int ks = 0; ks < 4; ++ks) qf[ks] = *(const bf16x8*)(P + mq * INW + qcol + 16 * ks + 8 * h);
    const unsigned* km = F.ctl + CW_KMAX + (l * NB + b) * 16;
    float negM[2];
    float bias_max = 0.f;
    LAS float* rpbL = (LAS float*)(lds + RPB_OFF);
    if (mode == 2 && !is_ctx) {
        const float* rp = A.in[I_RPB] + (size_t)(l * 4 + hk) * 465;
        for (int i = wave * 64 + lane; i < 465; i += NWAVES * 64) { const float v = rp[i] * LOG2E; rpbL[(i / 31) * 32 + (i % 31)] = v; }
        float mx = 0.f; for (int i = lane; i < 465; i += 64) mx = fmaxf(mx, fabsf(rp[i]) * LOG2E);
#pragma unroll
        for (int o = 0; o < 1; ++o) { mx = fmaxf(mx, sx<1>(mx)); mx = fmaxf(mx, sx<2>(mx)); mx = fmaxf(mx, sx<4>(mx)); mx = fmaxf(mx, sx<8>(mx)); mx = fmaxf(mx, sx<16>(mx)); mx = max32(mx); }
        bias_max = mx;
    }
    if (DIFF) {
        float s0 = sumsq8(qf[0]) + sumsq8(qf[1]), s1 = sumsq8(qf[2]) + sumsq8(qf[3]);
        s0 = sum32(s0); s1 = sum32(s1);
        negM[0] = -sqrtf(s0 * __builtin_bit_cast(float, __hip_atomic_load(km + kid, RLX_AGENT))) * 1.0001f;
        negM[1] = -sqrtf(s1 * __builtin_bit_cast(float, __hip_atomic_load(km + kid + 1, RLX_AGENT))) * 1.0001f;
    } else {
        float s0 = sumsq8(qf[0]) + sumsq8(qf[1]) + sumsq8(qf[2]) + sumsq8(qf[3]);
        s0 = sum32(s0);
        negM[0] = -(sqrtf(s0 * __builtin_bit_cast(float, __hip_atomic_load(km + kid, RLX_AGENT))) * 1.0001f + bias_max); negM[1] = 0.f;
    }
    int lt0 = 0, lt1 = 0;
    if (!is_ctx) {
        if (mode <= 1) { lt0 = 4; lt1 = 68; }
        else if (mode == 2) { const int R = 4 * qblk; lt0 = 4 + min(max(R - 4, 0), 56); lt1 = 4 + min(max(R + 3 - 4, 0), 56) + 8; }
        else { const int s0 = qblk * 128; lt0 = 4 + max(0, (s0 - 128) >> 6); lt1 = 4 + min(63, (s0 + 255) >> 6) + 1; }
    }
    const int ntiles = 4 + (lt1 - lt0);
    const int pidx = wave * 64 + lane, rho = pidx >> 3, cch = (pidx & 7) ^ ((rho >> 1) & 7);
    const char* ksrc = (const char*)(P + ((size_t)b * T + rho) * INW + kcol + cch * 8);
    const char* vsrc = (const char*)(VT + (((size_t)b * 12 + vh) * 64 + rho) * T + cch * 8);
#define ATT_ISSUE(ti_) ATT_ISSUE_AT(ti_, (ti_) % 3)
#define ATT_ISSUE_AT(ti_, bufi_) do { const int kt_ = (ti_) < 4 ? (ti_) : lt0 + (ti_) - 4; const int bf_ = (bufi_); \
        __builtin_amdgcn_global_load_lds((const unsigned*)(ksrc + (size_t)kt_ * (64 * INW * 2)), (LAS unsigned*)(lds + K_RING + bf_ * 8192 + wave * 1024), 16, 0, 0); \
        __builtin_amdgcn_global_load_lds((const unsigned*)(vsrc + (size_t)kt_ * 128), (LAS unsigned*)(lds + V_RING + bf_ * 8192 + wave * 1024), 16, 0, 0); } while (0)
    const int xk = swap23(r), gk = (xk >> 1) & 7, gv = (r >> 1) & 7;
    int kofs[4], vofs[4];
#pragma unroll
    for (int i = 0; i < 4; ++i) { kofs[i] = xk * 128 + (((2 * i + h) ^ gk) << 4); vofs[i] = r * 128 + (((2 * i + h) ^ gv) << 4); }
    const int rw = pos0w >> 6, r0w = min(max(rw - 4, 0), 56), cq = pos & 63, c0 = min(max(cq - 8, 0), 48);
    f32x16 O[DIFF ? 4 : 2];
#pragma unroll
    for (int i = 0; i < (DIFF ? 4 : 2); ++i)
#pragma unroll
        for (int j = 0; j < 16; ++j) O[i][j] = 0.f;
    float lsum[2] = {0.f, 0.f};
    ATT_ISSUE(0); ATT_ISSUE(1);
#pragma clang loop unroll(disable)
    for (int ti = 0; ti < ntiles; ++ti) {
        asm volatile("s_waitcnt vmcnt(2)" ::: "memory");
        __builtin_amdgcn_s_barrier(); asm volatile("" ::: "memory");
        { const int tn = min(ti + 2, ntiles - 1); ATT_ISSUE_AT(tn, (ti + 2) % 3); }
        const int kt = ti < 4 ? ti : lt0 + ti - 4, bf = ti % 3;
        const bool latt = ti >= 4;
        bool active = true; int msk = 0;
        if (latt && mode == 2) { const int kr = kt - 4; active = (kr >= r0w) && (kr < r0w + 8); msk = 2; }
        if (latt && mode == 3) { const int k0 = 64 * (kt - 4); active = (k0 + 63 >= pos0w - 128) && (k0 <= pos0w + 31 + 128); msk = 3; }
        if (!active) continue;
        const LAS unsigned char* kb = lds + K_RING + bf * 8192; const LAS unsigned char* vb = lds + V_RING + bf * 8192;
#pragma unroll
        for (int mp = 0; mp < (DIFF ? 2 : 1); ++mp) {
            f32x16 p0, p1;
#pragma unroll
            for (int j = 0; j < 16; ++j) { p0[j] = DIFF ? 0.f : negM[mp]; p1[j] = DIFF ? 0.f : negM[mp]; }
#pragma unroll
            for (int kk = 0; kk < (DIFF ? 2 : 4); ++kk) { const int ks = DIFF ? 2 * mp + kk : kk;
                const bf16x8 a0 = *(const LAS bf16x8*)(kb + kofs[ks]), a1 = *(const LAS bf16x8*)(kb + 4096 + kofs[ks]);
                p0 = __builtin_amdgcn_mfma_f32_32x32x16_bf16(a0, qf[ks], p0, 0, 0, 0);
                p1 = __builtin_amdgcn_mfma_f32_32x32x16_bf16(a1, qf[ks], p1, 0, 0, 0); }
            __builtin_amdgcn_sched_barrier(0);
            float ps = 0.f;
            if (msk == 0) {
#pragma unroll
                for (int j = 0; j < 16; ++j) { p0[j] = __builtin_amdgcn_exp2f(DIFF ? p0[j] + negM[mp] : p0[j]); p1[j] = __builtin_amdgcn_exp2f(DIFF ? p1[j] + negM[mp] : p1[j]); ps += p0[j] + p1[j]; }
            } else if (msk == 2) {
                const LAS float* brow = rpbL + (kt - 4 - rw + 7) * 32 + (15 - cq);
#pragma unroll
                for (int j = 0; j < 16; ++j) { const int kc0 = 16 * (j >> 3) + 8 * h + (j & 7), kc1 = kc0 + 32;
                    const bool ok0 = (kc0 >= c0) && (kc0 < c0 + 16), ok1 = (kc1 >= c0) && (kc1 < c0 + 16);
                    const float b0 = ok0 ? brow[kc0] : 0.f, b1 = ok1 ? brow[kc1] : 0.f;
                    p0[j] = ok0 ? __builtin_amdgcn_exp2f(p0[j] + b0) : 0.f; p1[j] = ok1 ? __builtin_amdgcn_exp2f(p1[j] + b1) : 0.f; ps += p0[j] + p1[j]; }
            } else {
                const int d0 = 64 * (kt - 4) - pos;
#pragma unroll
                for (int j = 0; j < 16; ++j) { const int kc0 = 16 * (j >> 3) + 8 * h + (j & 7), dd0 = d0 + kc0, dd1 = dd0 + 32;
                    const bool ok0 = (dd0 <= 128) && (dd0 >= -128), ok1 = (dd1 <= 128) && (dd1 >= -128);
                    p0[j] = ok0 ? __builtin_amdgcn_exp2f(p0[j]) : 0.f; p1[j] = ok1 ? __builtin_amdgcn_exp2f(p1[j]) : 0.f; ps += p0[j] + p1[j]; }
            }
            lsum[mp] += ps;
            __builtin_amdgcn_sched_barrier(0);
            bf16x8 pa[4]; pa[0] = pack8(p0, 0); pa[1] = pack8(p0, 8); pa[2] = pack8(p1, 0); pa[3] = pack8(p1, 8);
            __builtin_amdgcn_sched_barrier(0);
#pragma unroll
            for (int dvb = 0; dvb < 2; ++dvb)
#pragma unroll
                for (int s4 = 0; s4 < 4; ++s4) { const bf16x8 vf = *(const LAS bf16x8*)(vb + dvb * 4096 + vofs[s4]);
                    O[(DIFF ? 2 * mp : 0) + dvb] = __builtin_amdgcn_mfma_f32_32x32x16_bf16(vf, pa[s4], O[(DIFF ? 2 * mp : 0) + dvb], 0, 0, 0); }
            __builtin_amdgcn_sched_barrier(0);
        }
    }
#undef ATT_ISSUE
#undef ATT_ISSUE_AT
    asm volatile("s_waitcnt vmcnt(0)" ::: "memory");
    bf16* orow = WSP(bf16, WS_CAT) + mq * D + ocol;
    float l0 = sum32(lsum[0]);
    if (mode == 3) l0 += __builtin_amdgcn_exp2f(A.in[I_SINK][l * 4 + head] * LOG2E + negM[0]);
    const float inv0 = 1.0f / l0;
    if (DIFF) {
        const float l1 = sum32(lsum[1]); const float inv1 = lam / l1;
        float ss = 0.f;
#pragma unroll
        for (int dvb = 0; dvb < 2; ++dvb)
#pragma unroll
            for (int j = 0; j < 16; ++j) { const float v = O[dvb][j] * inv0 - O[2 + dvb][j] * inv1; O[dvb][j] = v; ss += v * v; }
        ss = sum32(ss);
        const float rs = (1.0f - lam_init) / sqrtf(ss * (1.0f / 64.0f) + EPS);
        const float* dg = A.in[I_DG] + l * 64;
#pragma unroll
        for (int dvb = 0; dvb < 2; ++dvb)
#pragma unroll
            for (int g = 0; g < 4; ++g) { const int dv = 32 * dvb + 8 * g + 4 * h; const f32x4 gg = *(const f32x4*)(dg + dv);
                v2u w; w.x = pk2(O[dvb][4 * g] * rs * gg[0], O[dvb][4 * g + 1] * rs * gg[1]); w.y = pk2(O[dvb][4 * g + 2] * rs * gg[2], O[dvb][4 * g + 3] * rs * gg[3]);
                *(v2u*)(orow + dv) = w; }
    } else {
#pragma unroll
        for (int dvb = 0; dvb < 2; ++dvb)
#pragma unroll
            for (int g = 0; g < 4; ++g) { const int dv = 32 * dvb + 8 * g + 4 * h;
                v2u w; w.x = pk2(O[dvb][4 * g] * inv0, O[dvb][4 * g + 1] * inv0); w.y = pk2(O[dvb][4 * g + 2] * inv0, O[dvb][4 * g + 3] * inv0);
                *(v2u*)(orow + dv) = w; }
    }
}
}

__device__ __forceinline__ void phase_attn(const Args& A, Frame& F, int l) {
    const int wave = F.wave, lane0 = lane_id();
    const float lam_init = 0.8f - 0.6f * expf(-0.3f * (float)l);
    float lam;
    { const float* lf = A.in[I_DLAM] + l * 128; float a = 0.f, bq = 0.f; if (lane0 < 32) { a = lf[lane0] * lf[32 + lane0]; bq = lf[64 + lane0] * lf[96 + lane0]; }
      a = wave_sum(a); bq = wave_sum(bq); lam = expf(a) - expf(bq) + lam_init; }
    const int NU = (l < NL - 1) ? 2048 + 128 : 2048;
    unsigned* ctr = F.ctl + CW_WORK + 64 * l;
    volatile LAS int* uw = (volatile LAS int*)(F.lds + att::UW_OFF);
    for (;;) {
        if (wave == 0 && lane0 == 0) uw[0] = (int)__hip_atomic_fetch_add(ctr, 1u, RLX_AGENT);
        __syncthreads();
        const int u = __builtin_amdgcn_readfirstlane(uw[0]);
        if (u >= NU) break;
        int mode, b, hk, qblk; bool is_ctx = false;
        if (u < 2048) { mode = u >> 9; const int v = u & 511; b = v >> 6;
            if (mode & 1) { hk = (v >> 5) & 1; qblk = v & 31; } else { hk = (v >> 4) & 3; qblk = v & 15; } }
        else { const int v = u - 2048; mode = v >> 5; const int w = v & 31; b = w >> 2; is_ctx = true;
            if (mode & 1) { hk = (w >> 1) & 1; qblk = w & 1; } else { hk = w & 3; qblk = 0; } }
        if (mode == 0) att::unit<true>(A, F, l, 0, b, hk, qblk, is_ctx, lam, lam_init);
        else att::unit<false>(A, F, l, mode, b, hk, qblk, is_ctx, lam, lam_init);
    }
}

__device__ __forceinline__ void phase_post_out(const Args& A, Frame& F, int l) {
    const int wave = F.wave, lane = lane_id(), tid = wave * 64 + lane; (void)tid;
    LAS float* wr_l = (LAS float*)F.lds;
    { const float* rw = A.in[I_RW] + (size_t)l * D * NE;
      for (int idx = tid; idx < D * NE; idx += NWAVES * 64) { const int k = idx >> 5, e = idx & 31, ln = (k & 255) >> 2, j = k >> 8, i = k & 3; wr_l[((j * 4 + i) * 32 + e) * 64 + ln] = rw[idx]; } }
    __syncthreads();
    const int gw = F.vcu * NWAVES + wave, NGW = F.G * NWAVES;
    const float* mod = WSP(float, WS_MOD);
    const float* rb = A.in[I_RB] + l * NE;
    unsigned* cnt = F.ctl + CW_CNT + 64 * l;
    for (int m = gw; m < M; m += NGW) {
        const int b = m / T, t = m % T; if (l == NL - 1 && t < CTX) continue;
        const int r = t < CTX ? 8 : b;
        const float* md = mod + (size_t)(l * 9 + r) * 6144;
        Row x, o, h;
        float* xp = WSP(float, WS_X) + (size_t)m * D;
        row_load_f32(x, xp, lane); row_load_bf16(o, WSP(bf16, WS_O) + (size_t)m * D, lane);
#pragma unroll
        for (int j = 0; j < 4; ++j) x.v[j] += ((const f32x4*)(md + 2048))[lane + 64 * j] * o.v[j];
        row_store_f32(x, xp, lane);
        const float rstd = row_rstd(x);
        row_modulate(h, x, rstd, A.in[I_N2G] + l * D, md + 4096, md + 3072, lane);
        row_store_bf16(h, WSP(bf16, WS_H) + (size_t)m * D, lane);
        float acc[32];
#pragma unroll
        for (int e = 0; e < 32; ++e) acc[e] = 0.f;
#pragma unroll
        for (int j = 0; j < 4; ++j)
#pragma unroll
            for (int i = 0; i < 4; ++i) { const float xv = h.v[j][i]; const LAS float* wp = wr_l + ((j * 4 + i) * 32) * 64 + lane;
#pragma unroll
                for (int e = 0; e < 32; ++e) acc[e] += xv * wp[e * 64]; }
#pragma unroll
        for (int i = 0; i < 16; ++i) { const bool hi = lane & 32; const float send = hi ? acc[i] : acc[i + 16], keep = hi ? acc[i + 16] : acc[i]; acc[i] = keep + other32(send, hi); }
#pragma unroll
        for (int i = 0; i < 8; ++i) { const bool hi = lane & 16; const float send = hi ? acc[i] : acc[i + 8], keep = hi ? acc[i + 8] : acc[i]; acc[i] = keep + sx<16>(send); }
#pragma unroll
        for (int i = 0; i < 4; ++i) { const bool hi = lane & 8; const float send = hi ? acc[i] : acc[i + 4], keep = hi ? acc[i + 4] : acc[i]; acc[i] = keep + sx<8>(send); }
#pragma unroll
        for (int i = 0; i < 2; ++i) { const bool hi = lane & 4; const float send = hi ? acc[i] : acc[i + 2], keep = hi ? acc[i + 2] : acc[i]; acc[i] = keep + sx<4>(send); }
        { const bool hi = lane & 2; const float send = hi ? acc[0] : acc[1], keep = hi ? acc[1] : acc[0]; acc[0] = keep + sx<2>(send); }
        const int my_e = lane >> 1;
        float logit = acc[0] + sx<1>(acc[0]) + rb[my_e];
        float tv[4]; int te[4];
#pragma unroll
        for (int k = 0; k < 4; ++k) {
            float bv = logit; int be = my_e;
#define AMX(ov_, oe_) do { const float ov = (ov_); const int oe = (oe_); const bool take = (ov > bv) || (ov == bv && oe < be); bv = take ? ov : bv; be = take ? oe : be; } while (0)
            AMX(sx<2>(bv), sxi<2>(be)); AMX(sx<4>(bv), sxi<4>(be)); AMX(sx<8>(bv), sxi<8>(be)); AMX(sx<16>(bv), sxi<16>(be)); AMX(other32(bv, lane >= 32), other32i(be, lane >= 32));
#undef AMX
            tv[k] = bv; te[k] = be; if (my_e == be) logit = -INFINITY;
        }
        const float e1 = __expf(tv[1] - tv[0]), e2 = __expf(tv[2] - tv[0]), e3 = __expf(tv[3] - tv[0]); const float inv = 1.0f / (1.0f + e1 + e2 + e3);
        if (lane < 4) { const int ee = lane == 0 ? te[0] : (lane == 1 ? te[1] : (lane == 2 ? te[2] : te[3])); const float gg = (lane == 0 ? 1.0f : (lane == 1 ? e1 : (lane == 2 ? e2 : e3))) * inv;
            const unsigned pos = __hip_atomic_fetch_add(cnt + ee, 1u, RLX_AGENT);
            WSP(int, WS_RE)[(size_t)m * 4 + lane] = ee; WSP(int, WS_RPOS)[(size_t)m * 4 + lane] = (int)pos; WSP(float, WS_RGATE)[(size_t)m * 4 + lane] = gg; }
    }
}

__device__ __forceinline__ void phase_moe_gather(const Args& A, Frame& F, int l) {
    const int wave = F.wave, lane = lane_id(), tid = wave * 64 + lane; (void)tid;
    LAS int* bs = (LAS int*)F.lds;
    if (tid == 0) { int acc = 0; for (int e = 0; e < NE; ++e) { bs[e] = acc; const int c = (int)__hip_atomic_load(F.ctl + CW_CNT + 64 * l + e, RLX_AGENT); acc += (c + 255) >> 8; } bs[NE] = acc; }
    __syncthreads();
    if (blockIdx.x == 0) { int* tab = WSP(int, WS_TAB); const int total = bs[NE];
        for (int blk = tid; blk < MOE_BLKS; blk += NWAVES * 64) { int e = 0; for (int j = 1; j < NE; ++j) e += (bs[j] <= blk) ? 1 : 0; tab[blk] = blk < total ? e : 0; }
        if (tid == 0) tab[MOE_BLKS] = total; }
    const int gw = F.vcu * NWAVES + wave, NGW = F.G * NWAVES;
    for (int pr = gw; pr < M * 4; pr += NGW) {
        const int m = pr >> 2, t = m % T; if (l == NL - 1 && t < CTX) continue;
        const int e = WSP(int, WS_RE)[pr], pos = WSP(int, WS_RPOS)[pr];
        const int dest = bs[e] * 256 + pos;
        if (lane == 0) WSP(int, WS_RDEST)[pr] = dest;
        const v4u* src = (const v4u*)(WSP(bf16, WS_H) + (size_t)m * D); v4u* dst = (v4u*)(WSP(bf16, WS_BUF) + (size_t)dest * D);
        const v4u a0 = src[lane], a1 = src[lane + 64]; dst[lane] = a0; dst[lane + 64] = a1;
    }
}

__device__ __forceinline__ void phase_combine(const Args& A, Frame& F, int l) {
    const int wave = F.wave, lane = lane_id(), tid = wave * 64 + lane; (void)tid;
    const int gw = F.vcu * NWAVES + wave, NGW = F.G * NWAVES;
    const float* mod = WSP(float, WS_MOD);
    const bf16* Y = WSP(bf16, WS_BUF);
    for (int m = gw; m < M; m += NGW) {
        const int b = m / T, t = m % T; if (l == NL - 1 && t < CTX) continue;
        const int r = t < CTX ? 8 : b;
        const float* md = mod + (size_t)(l * 9 + r) * 6144;
        Row x, y, yk;
        float* xp = WSP(float, WS_X) + (size_t)m * D;
        row_load_f32(x, xp, lane);
#pragma unroll
        for (int j = 0; j < 4; ++j) y.v[j] = (f32x4){0.f, 0.f, 0.f, 0.f};
#pragma unroll
        for (int k = 0; k < 4; ++k) { const int dest = WSP(int, WS_RDEST)[(size_t)m * 4 + k]; const float gg = WSP(float, WS_RGATE)[(size_t)m * 4 + k];
            row_load_bf16(yk, Y + (size_t)dest * D, lane);
#pragma unroll
            for (int j = 0; j < 4; ++j) y.v[j] += yk.v[j] * gg; }
#pragma unroll
        for (int j = 0; j < 4; ++j) x.v[j] += ((const f32x4*)(md + 5120))[lane + 64 * j] * y.v[j];
        const float rstd = row_rstd(x);
        if (l < NL - 1) {
            row_store_f32(x, xp, lane);
            const float* md2 = mod + (size_t)((l + 1) * 9 + r) * 6144;
            Row h; row_modulate(h, x, rstd, A.in[I_N1G] + (l + 1) * D, md2 + 1024, md2, lane);
            row_store_bf16(h, WSP(bf16, WS_H) + (size_t)m * D, lane);
        } else {
            float* op = A.out + ((size_t)b * SEQ + (t - CTX)) * D;
#pragma unroll
            for (int j = 0; j < 4; ++j) ((f32x4*)op)[lane + 64 * j] = x.v[j] * rstd * ((const f32x4*)A.in[I_FG])[lane + 64 * j];
        }
    }
}

constexpr int PH_PER_LAYER = 9, N_PHASES = 2 + NL * PH_PER_LAYER;
__global__ void __launch_bounds__(NWAVES * 64, 2) fwd(Args A) {
    extern __shared__ __attribute__((aligned(16))) unsigned char lds_raw[];
    Frame F;
    F.lds = (LAS unsigned char*)lds_raw; F.ws = A.ws; F.ctl = (unsigned*)(A.ws + WS_CTL);
    F.wave = __builtin_amdgcn_readfirstlane((int)threadIdx.x >> 6);
    F.G = gridDim.x; { const int bx = blockIdx.x; F.vcu = (F.G % 8 == 0) ? (bx % 8) * (F.G / 8) + bx / 8 : bx; }
    for (int u = threadIdx.x; u < (LDS_BYTES - LDSCTL_OFF) / 4; u += NWAVES * 64) ((LAS unsigned*)(F.lds + LDSCTL_OFF))[u] = 0u;
    __syncthreads();
    const int lo = A.ph_lo, hi = A.ph_hi;
    XcdBarrier bar; bar.bar = F.ctl + CW_BAR; bar.x = 0; bar.st = nullptr; bar.wave = F.wave;
    if (hi - lo > 1) bar = xcd_barrier_post(F.ctl + CW_BAR, (volatile LAS unsigned*)(F.lds + MISC_OFF) + 8, F.wave);
#define IN(k) (lo <= (k) && (k) < hi)
#define SEAM(k) do { if (IN(k) && IN((k) + 1)) xcd_barrier(bar); } while (0)
    if (IN(0)) { phase_proA(A, F); SEAM(0); }
    if (IN(1)) { phase_proB(A, F); SEAM(1); }
    for (int l = 0; l < NL; ++l) {
        F.ws = opq(F.ws); F.ctl = opq(F.ctl); asm volatile("" : "+s"(F.wave), "+s"(F.vcu), "+s"(F.G));
        const int pb = 2 + PH_PER_LAYER * l;
        if (IN(pb + 0)) {
            pg8::Gemm g{WSP(bf16, WS_H), WSP(bf16, WS_WIN) + (size_t)l * INW * D, D}; pg8::StaticOrder S; S.init(M, INW, F.G, (int)blockIdx.x);
            pg8::EpiStore E{WSP(bf16, WS_P), INW, nullptr, 0};
            pg8::gemm_phase<pg8::EpiStore, pg8::StaticOrder>(F.lds, g, S, E, F.wave);
            SEAM(pb + 0);
        }
        if (IN(pb + 1)) { phase_post_proj(A, F, l); SEAM(pb + 1); }
        if (IN(pb + 2)) { phase_attn(A, F, l); SEAM(pb + 2); }
        if (IN(pb + 3)) {
            pg8::Gemm g{WSP(bf16, WS_CAT), WSP(bf16, WS_WOUT) + (size_t)l * D * D, D}; pg8::StaticOrder S; S.init(M, D, F.G, (int)blockIdx.x);
            pg8::EpiStore E{WSP(bf16, WS_O), D, nullptr, 0};
            pg8::gemm_phase<pg8::EpiStore, pg8::StaticOrder>(F.lds, g, S, E, F.wave);
            SEAM(pb + 3);
        }
        if (IN(pb + 4)) { phase_post_out(A, F, l); SEAM(pb + 4); }
        if (IN(pb + 5)) { phase_moe_gather(A, F, l); SEAM(pb + 5); }
        if (IN(pb + 6)) {
            pg8::Gemm g{WSP(bf16, WS_BUF), WSP(bf16, WS_WGU) + (size_t)l * NE * GU * D, D}; pg8::MoeOrder S; S.init(WSP(int, WS_TAB), GU / 256, F.G, (int)blockIdx.x);
            pg8::EpiSwiglu E{WSP(bf16, WS_ACT), A.in[I_BGU] + (size_t)l * NE * GU};
            pg8::gemm_phase<pg8::EpiSwiglu, pg8::MoeOrder>(F.lds, g, S, E, F.wave);
            SEAM(pb + 6);
        }
        if (IN(pb + 7)) {
            pg8::Gemm g{WSP(bf16, WS_ACT), WSP(bf16, WS_WDN) + (size_t)l * NE * D * FF, FF}; pg8::MoeOrder S; S.init(WSP(int, WS_TAB), D / 256, F.G, (int)blockIdx.x);
            pg8::EpiStore E{WSP(bf16, WS_BUF), D, A.in[I_BDN] + (size_t)l * NE * D, D};
            pg8::gemm_phase<pg8::EpiStore, pg8::MoeOrder>(F.lds, g, S, E, F.wave);
            SEAM(pb + 7);
        }
        if (IN(pb + 8)) { phase_combine(A, F, l); SEAM(pb + 8); }
    }
#undef IN
#undef SEAM
}

extern "C" void kernel_launch(void* const* d_in, const int* in_sizes, int n_in, void* d_out, int out_size, void* d_ws, size_t ws_size, hipStream_t stream) {
    static int grid = 0;
    if (grid == 0) {
        if (n_in != 22 || out_size != NB * SEQ * D || ws_size < WS_END) { fprintf(stderr, "kernel_launch: unexpected shapes (n_in %d out %d ws %zu)\n", n_in, out_size, ws_size); grid = -1; return; }
        int dev = 0, cus = 0, per_cu = 0;
        if (hipGetDevice(&dev) != hipSuccess || hipDeviceGetAttribute(&cus, hipDeviceAttributeMultiprocessorCount, dev) != hipSuccess) { grid = -1; return; }
        if (hipFuncSetAttribute((const void*)fwd, hipFuncAttributeMaxDynamicSharedMemorySize, LDS_BYTES) != hipSuccess) { fprintf(stderr, "kernel_launch: hipFuncSetAttribute failed\n"); grid = -1; return; }
        if (hipOccupancyMaxActiveBlocksPerMultiprocessor(&per_cu, (const void*)fwd, NWAVES * 64, LDS_BYTES) != hipSuccess || per_cu < 1) fprintf(stderr, "kernel_launch: occupancy query reports %d\n", per_cu);
        (void)hipGetLastError();
        grid = cus;
    }
    if (grid < 0) return;
    if (hipMemsetAsync((char*)d_ws + WS_CTL, 0, CTL_ZERO_BYTES, stream) != hipSuccess) return;
    Args a{};
    for (int i = 0; i < 22; ++i) a.in[i] = (const float*)d_in[i];
    a.out = (float*)d_out; a.ws = (unsigned char*)d_ws;
#if MK_PER_PHASE
    for (int p = 0; p < N_PHASES; ++p) { a.ph_lo = p; a.ph_hi = p + 1; hipLaunchKernelGGL(fwd, dim3(grid), dim3(NWAVES * 64), LDS_BYTES, stream, a); }
#else
    a.ph_lo = 0; a.ph_hi = N_PHASES;
    hipLaunchKernelGGL(fwd, dim3(grid), dim3(NWAVES * 64), LDS_BYTES, stream, a);
#endif
}
```

```cpp
#include <hip/hip_runtime.h>
#include <cstdio>
#include <cstdint>

#ifndef REP_MASK
#define REP_MASK 0
#endif
#ifndef MK_PER_PHASE
#define MK_PER_PHASE 0
#endif

#define GAS __attribute__((address_space(1)))
#define LAS __attribute__((address_space(3)))
typedef unsigned short bf16;
typedef unsigned v4u __attribute__((ext_vector_type(4)));
typedef unsigned v2u __attribute__((ext_vector_type(2)));
typedef float f32x4 __attribute__((ext_vector_type(4)));
typedef short bf16x8 __attribute__((ext_vector_type(8)));
typedef GAS unsigned gu32;

constexpr int NB = 8, SEQ = 4096, CTX = 256, T = CTX + SEQ, D = 1024, NL = 4;
constexpr int M = NB * T;
constexpr int INW = 2560;
constexpr int NE = 32, FF = 1024, GU = 2048;
constexpr int MOE_BLKS = M * 4 / 256 + NE;
constexpr int MOE_ROWS = MOE_BLKS * 256;
constexpr float EPS = 1e-6f;

namespace pg8 {
constexpr int BM = 256, BK = 64, HALF = 128, HTB = HALF * BK * 2, STAGE_BYTES = 8 * HTB, NXCD = 8, WGM = 8;
__host__ __device__ __forceinline__ int lds_byte(int r, int c) { const int st = (r >> 4) * 2 + (c >> 5), rr = r & 15, cc = c & 31, ob = rr * 64 + cc * 2; return st * 1024 + (ob ^ (((ob >> 9) & 1) << 5)); }
__host__ __device__ __forceinline__ void stage_rc(int b, int& R, int& C) { const int st = b / 1024, sb = b % 1024, swz = sb ^ (((sb >> 9) & 1) << 5); R = (st >> 1) * 16 + swz / 64; C = (st & 1) * 32 + (swz % 64) / 2; }
__host__ __device__ __forceinline__ int perm32(int rho) { const int n = rho >> 4, i = rho & 15; return 8 * (i >> 2) + 4 * n + (i & 3); }

struct Unit { int pm, pn, pb, e, ui; };
struct Gemm { const bf16* A; const bf16* Bt; int K; };

struct StaticOrder {
    int nM, nN, nwg, G, c;
    __device__ void init(int M_, int N_, int G_, int c_) { nM = M_ / BM; nN = N_ / BM; nwg = nM * nN; G = G_; c = c_; }
    __device__ bool next(int i, Unit& u) const {
        const long L = (long)i * G + c; if (L >= nwg) return false;
        int wgid = (int)L; { const int q = nwg / NXCD, r = nwg % NXCD, xcd = wgid % NXCD, off = wgid / NXCD; wgid = (xcd < r ? xcd * (q + 1) : r * (q + 1) + (xcd - r) * q) + off; }
        const int nig = WGM * nN, gid = wgid / nig, fm = gid * WGM, gsz = (nM - fm) < WGM ? (nM - fm) : WGM;
        u.pm = fm + ((wgid % nig) % gsz); u.pn = (wgid % nig) / gsz; u.pb = u.pn; u.e = 0; u.ui = i; return true;
    }
};
struct MoeOrder {
    const LAS int* ut; int n, nN;
    __device__ bool next(int i, Unit& u) const {
        if (i >= n) return false;
        const int blk = __builtin_amdgcn_readfirstlane(ut[4 * i]), pn = __builtin_amdgcn_readfirstlane(ut[4 * i + 1]), e = __builtin_amdgcn_readfirstlane(ut[4 * i + 2]);
        u.pm = blk; u.pn = pn; u.pb = e * nN + pn; u.e = e; u.ui = i; return true;
    }
};

__device__ __forceinline__ unsigned cvt_pk_bf16(float lo, float hi) { unsigned r; asm volatile("v_cvt_pk_bf16_f32 %0, %1, %2" : "=v"(r) : "v"(lo), "v"(hi)); return r; }

struct EpiStore {
    bf16* O; int ldc; const float* bias; int bias_stride;
    __device__ __forceinline__ void operator()(const f32x4 (&acc)[2][2][4][2], const Unit& u, int wr, int wc, int fr, int fq) const {
        const int row0 = u.pm * BM + wr * 64 + fr, col0 = u.pn * BM + wc * 32 + 8 * fq;
        f32x4 bv[2][2];
#pragma unroll
        for (int bj = 0; bj < 2; ++bj)
#pragma unroll
            for (int n = 0; n < 2; ++n) bv[bj][n] = bias ? *(const f32x4*)(bias + (size_t)u.e * bias_stride + col0 + bj * HALF + 4 * n) : (f32x4){0.f, 0.f, 0.f, 0.f};
#pragma unroll
        for (int ai = 0; ai < 2; ++ai)
#pragma unroll
            for (int m = 0; m < 4; ++m) { bf16* rowp = O + (size_t)(row0 + ai * HALF + m * 16) * ldc + col0;
#pragma unroll
                for (int bj = 0; bj < 2; ++bj) { const f32x4 v0 = acc[ai][bj][m][0] + bv[bj][0], v1 = acc[ai][bj][m][1] + bv[bj][1];
                    v4u w; w.x = cvt_pk_bf16(v0[0], v0[1]); w.y = cvt_pk_bf16(v0[2], v0[3]); w.z = cvt_pk_bf16(v1[0], v1[1]); w.w = cvt_pk_bf16(v1[2], v1[3]);
                    *(v4u*)(rowp + bj * HALF) = w; } }
    }
};
__device__ __forceinline__ float swiglu1(float g, float u) {
    g = fminf(g, 7.0f); u = fminf(fmaxf(u, -7.0f), 7.0f);
    const float sg = __builtin_amdgcn_rcpf(1.0f + __expf(-1.702f * g));
    return g * sg * (u + 1.0f);
}
struct EpiSwiglu {
    bf16* O; const float* bias;
    __device__ __forceinline__ void operator()(const f32x4 (&acc)[2][2][4][2], const Unit& u, int wr, int wc, int fr, int fq) const {
        const int row0 = u.pm * BM + wr * 64 + fr, colA = u.pn * HALF + wc * 32 + 8 * fq;
        f32x4 bg[2], bu[2];
#pragma unroll
        for (int n = 0; n < 2; ++n) { bg[n] = *(const f32x4*)(bias + (size_t)u.e * GU + colA + 4 * n); bu[n] = *(const f32x4*)(bias + (size_t)u.e * GU + FF + colA + 4 * n); }
#pragma unroll
        for (int ai = 0; ai < 2; ++ai)
#pragma unroll
            for (int m = 0; m < 4; ++m) { bf16* rowp = O + (size_t)(row0 + ai * HALF + m * 16) * FF + colA;
                float a[8];
#pragma unroll
                for (int n = 0; n < 2; ++n) { const f32x4 g = acc[ai][0][m][n] + bg[n], uu = acc[ai][1][m][n] + bu[n];
#pragma unroll
                    for (int i = 0; i < 4; ++i) a[4 * n + i] = swiglu1(g[i], uu[i]); }
                v4u w; w.x = cvt_pk_bf16(a[0], a[1]); w.y = cvt_pk_bf16(a[2], a[3]); w.z = cvt_pk_bf16(a[4], a[5]); w.w = cvt_pk_bf16(a[6], a[7]);
                *(v4u*)rowp = w; }
    }
};

struct EpiYT {
    bf16* YT; const float* bias; const LAS int* idx;
    __device__ __forceinline__ void operator()(const f32x4 (&acc)[2][2][4][2], const Unit& u, int wr, int wc, int fr, int fq) const {
        const int col0 = u.pn * BM + wc * 32 + 8 * fq;
        f32x4 bv[2][2];
#pragma unroll
        for (int bj = 0; bj < 2; ++bj)
#pragma unroll
            for (int n = 0; n < 2; ++n) bv[bj][n] = *(const f32x4*)(bias + (size_t)u.e * D + col0 + bj * HALF + 4 * n);
#pragma unroll
        for (int ai = 0; ai < 2; ++ai)
#pragma unroll
            for (int m = 0; m < 4; ++m) { const int info = idx[u.ui * 256 + ai * HALF + wr * 64 + m * 16 + fr];
                if (info >= 0) { bf16* rowp = YT + (size_t)info * D + col0;
#pragma unroll
                    for (int bj = 0; bj < 2; ++bj) { const f32x4 v0 = acc[ai][bj][m][0] + bv[bj][0], v1 = acc[ai][bj][m][1] + bv[bj][1];
                        v4u w; w.x = cvt_pk_bf16(v0[0], v0[1]); w.y = cvt_pk_bf16(v0[2], v0[3]); w.z = cvt_pk_bf16(v1[0], v1[1]); w.w = cvt_pk_bf16(v1[2], v1[3]);
                        *(v4u*)(rowp + bj * HALF) = w; } } }
    }
};

template <class Epi, class Sched, bool GATHER = false>
__device__ __forceinline__ void gemm_phase(LAS unsigned char* lds, const Gemm g, const Sched& S, const Epi& E, int wid, const LAS int* gidx = nullptr) {
    int lane; asm volatile("v_mbcnt_lo_u32_b32 %0, -1, 0\n\tv_mbcnt_hi_u32_b32 %0, -1, %0" : "=&v"(lane));
    const int tid = wid * 64 + lane, wr = wid >> 2, wc = wid & 3, fr = lane & 15, fq = lane >> 4;
    const int K = g.K, nt = K / BK;
    unsigned voffA[2], voffB[2];
#pragma unroll
    for (int i = 0; i < 2; ++i) { int R, C; stage_rc(tid * 16 + i * 8192, R, C); const int Rb = (R & ~31) + perm32(R & 31);
        voffA[i] = (unsigned)(R * K + C) * 2u; voffB[i] = (unsigned)(Rb * K + C) * 2u; }
    int sR[2], sC[2];
#pragma unroll
    for (int i = 0; i < 2; ++i) stage_rc(tid * 16 + i * 8192, sR[i], sC[i]);
    unsigned vgc[2][2], vgn[2][2];
#define PG8_GOFF(dst, ui_) do { _Pragma("unroll") for (int _h = 0; _h < 2; ++_h) _Pragma("unroll") for (int _i = 0; _i < 2; ++_i) { \
        const int _inf = gidx[(ui_) * 256 + _h * HALF + sR[_i]]; dst[_h][_i] = (unsigned)((_inf < 0 ? 0 : (_inf >> 2)) * K + sC[_i]) * 2u; } } while (0)
    const size_t kstep = (size_t)(BK * 2);
    const size_t hstep = (size_t)HALF * K * 2;
    const size_t tstep = 2 * hstep;
    const unsigned ldsw = (unsigned)wid * 1024u;
    const int aoff = lds_byte(wr * 64 + fr, fq * 8), boff = lds_byte(wc * 32 + fr, fq * 8);
#define PG8_SA(b, h) (((b) * 2 + (h)) * HTB)
#define PG8_SB(b, h) ((4 + (b) * 2 + (h)) * HTB)
#define PG8_STAGE(bufoff, gbase, voff) do { _Pragma("unroll") for (int _i = 0; _i < 2; ++_i) \
        __builtin_amdgcn_global_load_lds((const unsigned*)((const char*)(gbase) + (voff)[_i]), (LAS unsigned*)(lds + (bufoff) + ldsw + _i * 8192), 16, 0, 0); } while (0)
#define PG8_LDA(dst, b, h) do { _Pragma("unroll") for (int m = 0; m < 4; ++m) _Pragma("unroll") for (int k = 0; k < 2; ++k) dst[m][k] = *(const LAS bf16x8*)(lds + PG8_SA(b, h) + aoff + m * 2048 + k * 1024); } while (0)
#define PG8_LDB(dst, b, h) do { _Pragma("unroll") for (int n = 0; n < 2; ++n) _Pragma("unroll") for (int k = 0; k < 2; ++k) dst[n][k] = *(const LAS bf16x8*)(lds + PG8_SB(b, h) + boff + n * 2048 + k * 1024); } while (0)
#define PG8_MMA(ai, bj, At, Bt) do { __builtin_amdgcn_s_setprio(1); _Pragma("unroll") for (int m = 0; m < 4; ++m) _Pragma("unroll") for (int n = 0; n < 2; ++n) _Pragma("unroll") for (int k = 0; k < 2; ++k) \
        acc[ai][bj][m][n] = __builtin_amdgcn_mfma_f32_16x16x32_bf16(Bt[n][k], At[m][k], acc[ai][bj][m][n], 0, 0, 0); __builtin_amdgcn_s_setprio(0); } while (0)
#define PG8_WAIT_V(n) asm volatile("s_waitcnt vmcnt(" #n ")" ::: "memory")
#define PG8_WAIT_L(n) asm volatile("s_waitcnt lgkmcnt(" #n ")" ::: "memory")
#define PG8_BAR __builtin_amdgcn_s_barrier()
#define PG8_SCHED __builtin_amdgcn_sched_barrier(0)
    Unit cur, nxt; int ui = 0;
    if (!S.next(0, cur)) return;
    f32x4 acc[2][2][4][2];
#pragma unroll
    for (int a = 0; a < 2; ++a)
#pragma unroll
        for (int b = 0; b < 2; ++b)
#pragma unroll
            for (int m = 0; m < 4; ++m)
#pragma unroll
                for (int n = 0; n < 2; ++n) acc[a][b][m][n] = (f32x4){0.f, 0.f, 0.f, 0.f};
    bf16x8 At[4][2], B0[2][2], B1[2][2];
    const char* cA = GATHER ? (const char*)g.A : (const char*)g.A + (size_t)cur.pm * tstep; const char* cB = (const char*)g.Bt + (size_t)cur.pb * tstep;
    if constexpr (GATHER) { PG8_GOFF(vgc, cur.ui); }
#define PG8_STAGE_A(bufoff, base, h, vg) do { if constexpr (GATHER) PG8_STAGE(bufoff, base, vg[h]); else PG8_STAGE(bufoff, (base) + (h) * hstep, voffA); } while (0)
    PG8_STAGE(PG8_SB(0, 0), cB, voffB); PG8_STAGE(PG8_SB(0, 1), cB + hstep, voffB); PG8_STAGE_A(PG8_SA(0, 0), cA, 0, vgc); PG8_STAGE_A(PG8_SA(0, 1), cA, 1, vgc);
    if (wr == 1) PG8_BAR;
    PG8_WAIT_V(2); PG8_BAR;
    PG8_STAGE(PG8_SB(1, 0), cB + kstep, voffB); PG8_STAGE_A(PG8_SA(1, 0), cA + kstep, 0, vgc); PG8_STAGE(PG8_SB(1, 1), cB + hstep + kstep, voffB);
    PG8_WAIT_V(6); PG8_BAR;
    for (;;) {
        const bool has_next = S.next(ui + 1, nxt);
        const char* nA = GATHER ? cA : (has_next ? (const char*)g.A + (size_t)nxt.pm * tstep : cA); const char* nB = has_next ? (const char*)g.Bt + (size_t)nxt.pb * tstep : cB;
        if constexpr (GATHER) { if (has_next) { PG8_GOFF(vgn, nxt.ui); } else {
#pragma unroll
            for (int _h = 0; _h < 2; ++_h)
#pragma unroll
                for (int _i = 0; _i < 2; ++_i) vgn[_h][_i] = vgc[_h][_i]; } }
        for (int t = 0; t < nt; t += 2) {
            const bool last = (t == nt - 2);
            const char* a1 = cA + (size_t)(t + 1) * kstep;
            const char* a2 = last ? nA : cA + (size_t)(t + 2) * kstep; const char* b2 = last ? nB : cB + (size_t)(t + 2) * kstep;
            const char* a3 = a2 + kstep; const char* b3 = b2 + kstep;
            unsigned vga[2][2];
            if constexpr (GATHER) {
#pragma unroll
                for (int _h = 0; _h < 2; ++_h)
#pragma unroll
                    for (int _i = 0; _i < 2; ++_i) vga[_h][_i] = last ? vgn[_h][_i] : vgc[_h][_i]; }
            PG8_LDB(B0, 0, 0); PG8_LDB(B1, 0, 1); PG8_SCHED; PG8_LDA(At, 0, 0); PG8_STAGE_A(PG8_SA(1, 1), a1, 1, vgc);
            PG8_WAIT_V(8); PG8_WAIT_L(0); PG8_BAR; PG8_MMA(0, 0, At, B0); PG8_MMA(0, 1, At, B1); PG8_BAR; PG8_SCHED;
            PG8_LDA(At, 0, 1); PG8_STAGE(PG8_SB(0, 0), b2, voffB); PG8_STAGE(PG8_SB(0, 1), b2 + hstep, voffB); PG8_STAGE_A(PG8_SA(0, 0), a2, 0, vga);
            PG8_WAIT_V(8); PG8_WAIT_L(0); PG8_BAR; PG8_MMA(1, 0, At, B0); PG8_MMA(1, 1, At, B1); PG8_BAR; PG8_SCHED;
            PG8_LDB(B0, 1, 0); PG8_LDB(B1, 1, 1); PG8_SCHED; PG8_LDA(At, 1, 0); PG8_STAGE_A(PG8_SA(0, 1), a2, 1, vga);
            PG8_WAIT_V(8); PG8_WAIT_L(0); PG8_BAR; PG8_MMA(0, 0, At, B0); PG8_MMA(0, 1, At, B1); PG8_BAR; PG8_SCHED;
            PG8_LDA(At, 1, 1); PG8_STAGE(PG8_SB(1, 0), b3, voffB); PG8_STAGE(PG8_SB(1, 1), b3 + hstep, voffB); PG8_STAGE_A(PG8_SA(1, 0), a3, 0, vga);
            PG8_WAIT_V(8); PG8_WAIT_L(0); PG8_BAR; PG8_MMA(1, 0, At, B0); PG8_MMA(1, 1, At, B1); PG8_BAR; PG8_SCHED;
        }
        if (wr == 0) PG8_BAR;
        E(acc, cur, wr, wc, fr, fq);
        if (!has_next) break;
#pragma unroll
        for (int a = 0; a < 2; ++a)
#pragma unroll
            for (int b = 0; b < 2; ++b)
#pragma unroll
                for (int m = 0; m < 4; ++m)
#pragma unroll
                    for (int n = 0; n < 2; ++n) acc[a][b][m][n] = (f32x4){0.f, 0.f, 0.f, 0.f};
        cur = nxt; cA = nA; cB = nB; ++ui;
        if constexpr (GATHER) {
#pragma unroll
            for (int _h = 0; _h < 2; ++_h)
#pragma unroll
                for (int _i = 0; _i < 2; ++_i) vgc[_h][_i] = vgn[_h][_i]; }
        if (wr == 1) PG8_BAR;
    }
    PG8_WAIT_V(0);
    PG8_BAR;
#undef PG8_SA
#undef PG8_SB
#undef PG8_STAGE
#undef PG8_STAGE_A
#undef PG8_GOFF
#undef PG8_LDA
#undef PG8_LDB
#undef PG8_MMA
#undef PG8_WAIT_V
#undef PG8_WAIT_L
#undef PG8_BAR
#undef PG8_SCHED
}
}

constexpr size_t MiB = 1u << 20;
constexpr size_t WS_CTL = 0, CTL_ZERO_BYTES = 1 * MiB;
constexpr size_t WS_MOD = 2 * MiB;
constexpr size_t WS_RGATE = 3 * MiB;
constexpr size_t WS_WIN = 8 * MiB;
constexpr size_t WS_WOUT = 28 * MiB;
constexpr size_t WS_WGU = 36 * MiB;
constexpr size_t WS_WDN = 548 * MiB;
constexpr size_t WS_X = 804 * MiB;
constexpr size_t WS_H = 940 * MiB;
constexpr size_t WS_P = 1008 * MiB;
constexpr size_t WS_VT = 1178 * MiB;
constexpr size_t WS_CAT = 1229 * MiB;
constexpr size_t WS_O = 1297 * MiB;
constexpr size_t WS_YT = 1365 * MiB;
constexpr size_t WS_ACT = 1653 * MiB;
constexpr size_t WS_RINFO = 1941 * MiB;
constexpr size_t WS_END = 1946 * MiB;
constexpr int CW_TMO = 0, CW_CODE = 1, CW_BAR = 4096, CW_CNT = 8192, CW_WORK = 8192 + 1024, CW_KMAX = 8192 + 2048;

constexpr int NWAVES = 8;
constexpr int RING_BYTES = 131072;
constexpr int LDSCTL_OFF = RING_BYTES, MISC_OFF = LDSCTL_OFF + 320;
constexpr int MOE_TAB_OFF = LDSCTL_OFF + 512, MOE_UT_OFF = LDSCTL_OFF + 1024, MOE_IDX_OFF = LDSCTL_OFF + 2048, MOE_MAX_UNITS = 18;
constexpr int LDS_BYTES = 163840;

#define RLX_AGENT __ATOMIC_RELAXED, __HIP_MEMORY_SCOPE_AGENT
#define LDS_WAIT() asm volatile("s_waitcnt lgkmcnt(0)" ::: "memory")
__device__ __forceinline__ unsigned f2bf(float f) { unsigned u = __builtin_bit_cast(unsigned, f); return (u + 0x7fffu + ((u >> 16) & 1u)) >> 16; }
__device__ __forceinline__ unsigned pk2(float lo, float hi) { return f2bf(lo) | (f2bf(hi) << 16); }
__device__ __forceinline__ float bflo(unsigned w) { return __builtin_bit_cast(float, w << 16); }
__device__ __forceinline__ float bfhi(unsigned w) { return __builtin_bit_cast(float, w & 0xffff0000u); }
__device__ __forceinline__ float bf2f(bf16 h) { return __builtin_bit_cast(float, (unsigned)h << 16); }
template <class Tp> __device__ __forceinline__ Tp* opq(Tp* p) { asm volatile("" : "+s"(p)); return p; }
__device__ __forceinline__ int lane_id() { int x; asm volatile("v_mbcnt_lo_u32_b32 %0, -1, 0\n\tv_mbcnt_hi_u32_b32 %0, -1, %0" : "=&v"(x)); return x; }
template <int MASK> __device__ __forceinline__ float sx(float v) {
    static_assert(MASK >= 1 && MASK < 32, "sx: xor mask inside a 32-lane half");
    return __builtin_bit_cast(float, __builtin_amdgcn_ds_swizzle(__builtin_bit_cast(int, v), (MASK << 10) | 0x1f));
}
template <int MASK> __device__ __forceinline__ int sxi(int v) { return __builtin_amdgcn_ds_swizzle(v, (MASK << 10) | 0x1f); }
__device__ __forceinline__ void swap32(unsigned& a, unsigned& b) { asm volatile("s_nop 1\n\tv_permlane32_swap_b32 %0, %1\n\ts_nop 1" : "+v"(a), "+v"(b)); }
__device__ __forceinline__ float sum32(float v) { unsigned a = __builtin_bit_cast(unsigned, v), b = a; swap32(a, b); return __builtin_bit_cast(float, a) + __builtin_bit_cast(float, b); }
__device__ __forceinline__ float max32(float v) { unsigned a = __builtin_bit_cast(unsigned, v), b = a; swap32(a, b); return fmaxf(__builtin_bit_cast(float, a), __builtin_bit_cast(float, b)); }
__device__ __forceinline__ float other32(float v, bool) { const unsigned u = __builtin_bit_cast(unsigned, v); unsigned a = u, b = u; swap32(a, b); return __builtin_bit_cast(float, a ^ b ^ u); }
__device__ __forceinline__ int other32i(int v, bool) { unsigned a = (unsigned)v, b = a; swap32(a, b); return (int)(a ^ b ^ (unsigned)v); }
__device__ __forceinline__ float half_sum(float v) { v += sx<1>(v); v += sx<2>(v); v += sx<4>(v); v += sx<8>(v); v += sx<16>(v); return v; }
__device__ __forceinline__ float wave_sum(float v) { return sum32(half_sum(v)); }

#define XB_TMO      128
#define XB_XCNT(j)  (256  + 64 * (j))
#define XB_XSUB(j)  (1280 + 64 * (j))
#define XB_XGEN(j)  (2304 + 64 * (j))
#define XB_TOP      3328
#define XB_TOPGEN   3392
#define XCD_BAR_WORDS 3456
#define XB_SPIN_CAP (1u << 18)
__device__ __forceinline__ unsigned xb_ld(unsigned* p)              { return __hip_atomic_load(p, __ATOMIC_RELAXED, __HIP_MEMORY_SCOPE_AGENT); }
__device__ __forceinline__ unsigned xb_add(unsigned* p, unsigned v) { return __hip_atomic_fetch_add(p, v, __ATOMIC_RELAXED, __HIP_MEMORY_SCOPE_AGENT); }
__device__ __forceinline__ unsigned xb_xcc_id() { return (unsigned)__builtin_amdgcn_s_getreg((3 << 11) | 20) & 0xFu; }
#define XB_SPIN(cond, bar) do { unsigned _sp = 0; while (cond) { __builtin_amdgcn_s_sleep(1); \
    if ((++_sp & 255u) == 0u) { if (xb_ld(&(bar)[XB_TMO])) break; if (_sp > XB_SPIN_CAP) { atomicAdd(&(bar)[XB_TMO], 1u); break; } } } } while (0)
struct XcdBarrier { unsigned* bar; unsigned x; volatile LAS unsigned* st; int wave; };
__device__ __forceinline__ XcdBarrier xcd_barrier_post(unsigned* bar, volatile LAS unsigned* st, int wave) {
    XcdBarrier b; b.bar = bar; b.x = xb_xcc_id(); b.st = st; b.wave = wave;
    if (wave == 0 && lane_id() == 0) (void)xb_add(&bar[XB_XCNT(b.x)], 1u);
    return b;
}
__device__ __forceinline__ void xcd_barrier_complete(unsigned* bar, unsigned x, unsigned& nloc, unsigned& nx) {
    const unsigned G = gridDim.x * gridDim.y * gridDim.z;
    unsigned sum, cnt, mine, sp = 0u;
    for (;;) {
        sum = 0u; cnt = 0u; mine = 0u;
#pragma unroll
        for (unsigned j = 0; j < 16; ++j) { const unsigned c = xb_ld(&bar[XB_XCNT(j)]); sum += c; cnt += (c > 0u) ? 1u : 0u; mine = (j == x) ? c : mine; }
        if (sum == G) break;
        __builtin_amdgcn_s_sleep(1);
        if ((++sp & 255u) == 0u) { if (xb_ld(&bar[XB_TMO])) break; if (sp > XB_SPIN_CAP) { atomicAdd(&bar[XB_TMO], 1u); break; } }
    }
    nloc = mine > 0u ? mine : 1u; nx = cnt > 0u ? cnt : 1u;
}
__device__ __forceinline__ void xcd_barrier(const XcdBarrier& b) {
    asm volatile("s_waitcnt vmcnt(0)" ::: "memory");
    __syncthreads();
    if (b.wave == 0 && lane_id() == 0) {
        unsigned* bar = opq(b.bar);
        __builtin_amdgcn_s_waitcnt(0);
        unsigned nloc = b.st[0], nx = b.st[1];
        if (nloc == 0u) { xcd_barrier_complete(bar, b.x, nloc, nx); b.st[0] = nloc; b.st[1] = nx; }
        const unsigned old = xb_add(&bar[XB_XSUB(b.x)], 1u);
        const unsigned gen = old / nloc;
        if (old + 1u == (gen + 1u) * nloc) {
            __builtin_amdgcn_fence(__ATOMIC_RELEASE, "agent");
            asm volatile("s_waitcnt vmcnt(0)" ::: "memory");
            const unsigned og = xb_add(&bar[XB_TOP], 1u);
            const unsigned tg = og / nx;
            if (og + 1u == (tg + 1u) * nx) xb_add(&bar[XB_TOPGEN], 1u);
            else XB_SPIN(xb_ld(&bar[XB_TOPGEN]) == tg, bar);
            __builtin_amdgcn_fence(__ATOMIC_ACQUIRE, "agent");
            xb_add(&bar[XB_XGEN(b.x)], 1u);
            asm volatile("s_waitcnt vmcnt(0)" ::: "memory");
        } else {
            XB_SPIN(xb_ld(&bar[XB_XGEN(b.x)]) == gen, bar);
            __builtin_amdgcn_fence(__ATOMIC_ACQUIRE, "agent");
            asm volatile("s_waitcnt vmcnt(0)" ::: "memory");
        }
    }
    __syncthreads();
}

struct Args { const float* in[22]; float* out; unsigned char* ws; int ph_lo, ph_hi; };
enum { I_X = 0, I_C, I_CTX, I_CCTX, I_WADA, I_BADA, I_N1G, I_N2G, I_WIN, I_WOUT, I_DLAM, I_DG, I_QKG, I_RPB, I_SINK, I_RW, I_RB, I_WGU, I_BGU, I_WDN, I_BDN, I_FG };
struct Frame {
    LAS unsigned char* lds; unsigned char* ws; unsigned* ctl;
    int vcu, G, wave;
};
#define WSP(type, off) ((type*)(F.ws + (off)))

struct Row { f32x4 v[4]; };
__device__ __forceinline__ void row_load_f32(Row& r, const float* p, int lane) {
#pragma unroll
    for (int j = 0; j < 4; ++j) r.v[j] = ((const GAS f32x4*)p)[lane + 64 * j];
}
__device__ __forceinline__ void row_store_f32(const Row& r, float* p, int lane) {
#pragma unroll
    for (int j = 0; j < 4; ++j) ((GAS f32x4*)p)[lane + 64 * j] = r.v[j];
}
__device__ __forceinline__ void row_load_bf16(Row& r, const bf16* p, int lane) {
#pragma unroll
    for (int j = 0; j < 4; ++j) { const v2u w = ((const GAS v2u*)p)[lane + 64 * j]; r.v[j] = (f32x4){bflo(w.x), bfhi(w.x), bflo(w.y), bfhi(w.y)}; }
}
__device__ __forceinline__ void row_store_bf16(const Row& r, bf16* p, int lane) {
#pragma unroll
    for (int j = 0; j < 4; ++j) { v2u w; w.x = pk2(r.v[j][0], r.v[j][1]); w.y = pk2(r.v[j][2], r.v[j][3]); ((GAS v2u*)p)[lane + 64 * j] = w; }
}
__device__ __forceinline__ float row_rstd(const Row& r) {
    float s = 0.f;
#pragma unroll
    for (int j = 0; j < 4; ++j) s += (r.v[j][0] * r.v[j][0] + r.v[j][1] * r.v[j][1]) + (r.v[j][2] * r.v[j][2] + r.v[j][3] * r.v[j][3]);
    return 1.0f / sqrtf(wave_sum(s) * (1.0f / D) + EPS);
}
__device__ __forceinline__ void row_modulate(Row& h, const Row& x, float rstd, const float* g, const float* sc, const float* sh, int lane) {
#pragma unroll
    for (int j = 0; j < 4; ++j) { const f32x4 gg = ((const GAS f32x4*)g)[lane + 64 * j], s1 = ((const GAS f32x4*)sc)[lane + 64 * j], s0 = ((const GAS f32x4*)sh)[lane + 64 * j];
        h.v[j] = x.v[j] * rstd * gg * (s1 + 1.0f) + s0; }
}

__device__ __forceinline__ void transpose_item(const float* W, int K, int N, bf16* WT, int k0, int n0, int dest_row0, LAS float* scr, int lane) {
#pragma unroll 8
    for (int i = 0; i < 32; ++i) { const int kk = 2 * i + (lane >> 5); scr[kk * 33 + (lane & 31)] = W[(size_t)(k0 + kk) * N + n0 + (lane & 31)]; }
    LDS_WAIT(); asm volatile("" ::: "memory");
    const int c = lane & 7;
#pragma unroll
    for (int j = 0; j < 4; ++j) { const int n = (lane >> 3) + 8 * j; const LAS float* s = scr + (8 * c) * 33 + n;
        v4u o; o.x = pk2(s[0 * 33], s[1 * 33]); o.y = pk2(s[2 * 33], s[3 * 33]); o.z = pk2(s[4 * 33], s[5 * 33]); o.w = pk2(s[6 * 33], s[7 * 33]);
        *(v4u*)(WT + (size_t)(dest_row0 + n) * K + k0 + 8 * c) = o; }
    LDS_WAIT(); asm volatile("" ::: "memory");
}
__device__ __forceinline__ void phase_proA(const Args& A, Frame& F) {
    const int wave = F.wave, lane = lane_id(), tid = wave * 64 + lane; (void)tid;
    LAS float* sl = (LAS float*)F.lds;
    LAS float* scr = (LAS float*)(F.lds + 40960 + wave * 8704);
    for (int i = tid; i < 9 * D; i += NWAVES * 64) { const int r = i >> 10, k = i & 1023; const float v = r < 8 ? A.in[I_C][r * D + k] : A.in[I_CCTX][k]; sl[i] = v / (1.0f + __expf(-v)); }
    __syncthreads();
    const int gw = F.vcu * NWAVES + wave, NGW = F.G * NWAVES;
    constexpr int N_ADA = NL * 96;
    constexpr int IT_IN = 16 * 80, IT_OUT = 16 * 32, IT_GU = 16 * 64, IT_DN = 16 * 32;
    constexpr int IT_LAYER = IT_IN + IT_OUT + NE * IT_GU + NE * IT_DN;
    constexpr int NITEMS = N_ADA + NL * IT_LAYER;
    for (int it = gw; it < NITEMS; it += NGW) {
        if (it < N_ADA) {
            const int l = it / 96, n = (it % 96) * 64 + lane;
            const float* w = A.in[I_WADA] + (size_t)l * D * 6144 + n;
            float acc[9];
#pragma unroll
            for (int r = 0; r < 9; ++r) acc[r] = 0.f;
#pragma unroll 4
            for (int k = 0; k < D; ++k) { const float wv = w[(size_t)k * 6144];
#pragma unroll
                for (int r = 0; r < 9; ++r) acc[r] += sl[r * D + k] * wv; }
            const float bb = A.in[I_BADA][l * 6144 + n];
            float* mod = WSP(float, WS_MOD);
#pragma unroll
            for (int r = 0; r < 9; ++r) mod[(size_t)(l * 9 + r) * 6144 + n] = acc[r] + bb;
            continue;
        }
        int r = it - N_ADA; const int l = r / IT_LAYER; r -= l * IT_LAYER;
        if (r < IT_IN) { const int kb = r / 80, nb = r % 80; transpose_item(A.in[I_WIN] + (size_t)l * D * INW, D, INW, WSP(bf16, WS_WIN) + (size_t)l * INW * D, 64 * kb, 32 * nb, 32 * nb, scr, lane); continue; } r -= IT_IN;
        if (r < IT_OUT) { const int kb = r / 32, nb = r % 32; transpose_item(A.in[I_WOUT] + (size_t)l * D * D, D, D, WSP(bf16, WS_WOUT) + (size_t)l * D * D, 64 * kb, 32 * nb, 32 * nb, scr, lane); continue; } r -= IT_OUT;
        if (r < NE * IT_GU) { const int e = r / IT_GU, q = r % IT_GU, kb = q / 64, nb = q % 64, n0 = 32 * nb;
            const int dest = n0 < FF ? (n0 >> 7) * 256 + (n0 & 127) : ((n0 - FF) >> 7) * 256 + 128 + ((n0 - FF) & 127);
            transpose_item(A.in[I_WGU] + (size_t)(l * NE + e) * D * GU, D, GU, WSP(bf16, WS_WGU) + (size_t)(l * NE + e) * GU * D, 64 * kb, n0, dest, scr, lane); continue; } r -= NE * IT_GU;
        { const int e = r / IT_DN, q = r % IT_DN, kb = q / 32, nb = q % 32;
            transpose_item(A.in[I_WDN] + (size_t)(l * NE + e) * FF * D, FF, D, WSP(bf16, WS_WDN) + (size_t)(l * NE + e) * D * FF, 64 * kb, 32 * nb, 32 * nb, scr, lane); }
    }
}

__device__ __forceinline__ void phase_proB(const Args& A, Frame& F) {
    const int wave = F.wave, lane = lane_id();
    const int gw = F.vcu * NWAVES + wave, NGW = F.G * NWAVES;
    const float* mod = WSP(float, WS_MOD);
    for (int pr = gw; pr < M / 2; pr += NGW) {
        const int m0 = 2 * pr, b = m0 / T, t = m0 % T; const int r = t < CTX ? 8 : b;
        const float* src = t < CTX ? A.in[I_CTX] + ((size_t)b * CTX + t) * D : A.in[I_X] + ((size_t)b * SEQ + (t - CTX)) * D;
        Row x0, x1, h; row_load_f32(x0, src, lane); row_load_f32(x1, src + D, lane);
        row_store_f32(x0, WSP(float, WS_X) + (size_t)m0 * D, lane); row_store_f32(x1, WSP(float, WS_X) + (size_t)(m0 + 1) * D, lane);
        const float* md = mod + (size_t)(0 * 9 + r) * 6144;
        const float r0 = row_rstd(x0), r1 = row_rstd(x1);
        row_modulate(h, x0, r0, A.in[I_N1G], md + 1024, md, lane); row_store_bf16(h, WSP(bf16, WS_H) + (size_t)m0 * D, lane);
        row_modulate(h, x1, r1, A.in[I_N1G], md + 1024, md, lane); row_store_bf16(h, WSP(bf16, WS_H) + (size_t)(m0 + 1) * D, lane);
    }
}

constexpr float LOG2E = 1.4426950408889634f;
constexpr float QS32 = 0.17677669529663687f * LOG2E, QS64 = 0.125f * LOG2E;
__device__ __forceinline__ float rnd_bf(float x) { return __builtin_bit_cast(float, f2bf(x) << 16); }
__device__ __forceinline__ void phase_post_proj(const Args& A, Frame& F, int l) {
    const int wave = F.wave, lane = lane_id(), tid = wave * 64 + lane;
    LAS bf16* vt = (LAS bf16*)F.lds;
    LAS float* t64 = (LAS float*)(F.lds + 102400);
    LAS float* t32 = (LAS float*)(F.lds + 102400 + 8192);
    for (int i = tid; i < 64 * 16; i += NWAVES * 64) { const int pos = i >> 4, f = i & 15; const float inv = exp2f(-(float)f * (13.287712379549449f / 16.0f)); const float a = (float)pos * inv; t64[2 * i] = cosf(a); t64[2 * i + 1] = sinf(a); }
    for (int i = tid; i < 64 * 8; i += NWAVES * 64) { const int pos = i >> 3, f = i & 7; const float inv = exp2f(-(float)f * (13.287712379549449f / 8.0f)); const float a = (float)pos * inv; t32[2 * i] = cosf(a); t32[2 * i + 1] = sinf(a); }
    __syncthreads();
    const float g0 = A.in[I_QKG][l * 128 + lane], g1 = A.in[I_QKG][l * 128 + 64 + lane];
    bf16* P = WSP(bf16, WS_P); bf16* VT = WSP(bf16, WS_VT);
    for (int tile = F.vcu; tile < M / 64; tile += F.G) {
        float kmA[4], kmB[2], kmC[4], kmD[2];
#pragma unroll
        for (int i = 0; i < 4; ++i) { kmA[i] = 0.f; kmC[i] = 0.f; }
        kmB[0] = kmB[1] = kmD[0] = kmD[1] = 0.f;
        for (int tk = 0; tk < 8; ++tk) {
            const int tl = wave * 8 + tk, m = tile * 64 + tl, t = m % T;
            const bool lat = t >= CTX; const int sp = t - CTX, grow = sp >> 6, gcol = sp & 63;
            bf16* prow = P + (size_t)m * INW;
            { const int i32 = lane & 31, pos = (i32 & 16) ? gcol : grow; const float cs = lat ? t32[2 * (pos * 8 + (i32 & 7))] : 1.f, sn = lat ? t32[2 * (pos * 8 + (i32 & 7)) + 1] : 0.f;
#pragma unroll
              for (int seg = 0; seg < 8; ++seg) { const float x = bf2f(prow[seg * 64 + lane]); const float pr = sx<8>(x);
                  float o = (i32 & 8) ? x * cs + pr * sn : x * cs - pr * sn; if (seg < 4) o *= QS32;
                  const unsigned ob = f2bf(o); prow[seg * 64 + lane] = (bf16)ob;
                  if (seg >= 4) { const float kr = __builtin_bit_cast(float, ob << 16); kmA[seg - 4] = fmaxf(kmA[seg - 4], half_sum(kr * kr)); } } }
            const int pos64 = (lane & 32) ? gcol : grow; const float cs64 = lat ? t64[2 * (pos64 * 16 + (lane & 15))] : 1.f, sn64 = lat ? t64[2 * (pos64 * 16 + (lane & 15)) + 1] : 0.f;
#pragma unroll
            for (int seg = 12; seg < 18; ++seg) { float x = bf2f(prow[seg * 64 + lane]); const float ss = wave_sum(x * x);
                x = x * (1.0f / sqrtf(ss * (1.0f / 64.0f) + EPS)) * (seg < 16 ? g0 : g1);
                const float pr = sx<16>(x); float o = (lane & 16) ? x * cs64 + pr * sn64 : x * cs64 - pr * sn64; if (seg < 16) o *= QS64;
                const unsigned ob = f2bf(o); prow[seg * 64 + lane] = (bf16)ob;
                if (seg >= 16) { const float kr = __builtin_bit_cast(float, ob << 16); kmB[seg - 16] = fmaxf(kmB[seg - 16], wave_sum(kr * kr)); } }
#pragma unroll
            for (int seg = 20; seg < 24; ++seg) { const float x = bf2f(prow[seg * 64 + lane]); prow[seg * 64 + lane] = (bf16)f2bf(x * QS64); }
#pragma unroll
            for (int seg = 24; seg < 28; ++seg) { const float kr = bf2f(prow[seg * 64 + lane]); kmC[seg - 24] = fmaxf(kmC[seg - 24], wave_sum(kr * kr)); }
#pragma unroll
            for (int seg = 32; seg < 38; ++seg) { const float x = bf2f(prow[seg * 64 + lane]); const float pr = sx<16>(x);
                float o = (lane & 16) ? x * cs64 + pr * sn64 : x * cs64 - pr * sn64; if (seg < 36) o *= QS64;
                const unsigned ob = f2bf(o); prow[seg * 64 + lane] = (bf16)ob;
                if (seg >= 36) { const float kr = __builtin_bit_cast(float, ob << 16); kmD[seg - 36] = fmaxf(kmD[seg - 36], wave_sum(kr * kr)); } }
#pragma unroll
            for (int vh = 0; vh < 12; ++vh) { const int seg = vh < 4 ? 8 + vh : (vh < 6 ? 18 + (vh - 4) : (vh < 10 ? 28 + (vh - 6) : 38 + (vh - 10)));
                vt[(vh * 64 + lane) * 66 + tl] = prow[seg * 64 + lane]; }
        }
        const int b = (tile * 64) / T, t0 = (tile * 64) % T;
        { unsigned* km = F.ctl + CW_KMAX + (l * NB + b) * 16;
          if (lane == 0 || lane == 32) {
#pragma unroll
              for (int i = 0; i < 4; ++i) __hip_atomic_fetch_max(km + 2 * i + (lane >> 5), __builtin_bit_cast(unsigned, kmA[i]), RLX_AGENT); }
          if (lane == 0) { __hip_atomic_fetch_max(km + 8, __builtin_bit_cast(unsigned, kmB[0]), RLX_AGENT); __hip_atomic_fetch_max(km + 9, __builtin_bit_cast(unsigned, kmB[1]), RLX_AGENT);
#pragma unroll
              for (int i = 0; i < 4; ++i) __hip_atomic_fetch_max(km + 10 + i, __builtin_bit_cast(unsigned, kmC[i]), RLX_AGENT);
              __hip_atomic_fetch_max(km + 14, __builtin_bit_cast(unsigned, kmD[0]), RLX_AGENT); __hip_atomic_fetch_max(km + 15, __builtin_bit_cast(unsigned, kmD[1]), RLX_AGENT); } }
        __syncthreads();
        for (int idx = tid; idx < 768 * 8; idx += NWAVES * 64) { const int row = idx >> 3, ch = idx & 7;
            const LAS unsigned* sp = (const LAS unsigned*)((const LAS unsigned char*)vt + row * 132 + ch * 16);
            v4u w; w.x = sp[0]; w.y = sp[1]; w.z = sp[2]; w.w = sp[3];
            *(v4u*)(VT + ((size_t)b * 768 + row) * T + t0 + ch * 8) = w; }
        __syncthreads();
    }
}

namespace att {
typedef float f32x16 __attribute__((ext_vector_type(16)));
constexpr int K_RING = 0, V_RING = 24576, RPB_OFF = 49152, UW_OFF = 51200;
__device__ __forceinline__ int swap23(int r) { return (r & ~12) | ((r & 4) << 1) | ((r & 8) >> 1); }
__device__ __forceinline__ bf16x8 pack8(const f32x16& p, int base) {
    v4u w; w.x = pg8::cvt_pk_bf16(p[base + 0], p[base + 1]); w.y = pg8::cvt_pk_bf16(p[base + 2], p[base + 3]); w.z = pg8::cvt_pk_bf16(p[base + 4], p[base + 5]); w.w = pg8::cvt_pk_bf16(p[base + 6], p[base + 7]);
    return __builtin_bit_cast(bf16x8, w);
}
__device__ __forceinline__ float sumsq8(bf16x8 q) { const v4u w = __builtin_bit_cast(v4u, q); float s = 0.f;
    s += bflo(w.x) * bflo(w.x) + bfhi(w.x) * bfhi(w.x) + bflo(w.y) * bflo(w.y) + bfhi(w.y) * bfhi(w.y) + bflo(w.z) * bflo(w.z) + bfhi(w.z) * bfhi(w.z) + bflo(w.w) * bflo(w.w) + bfhi(w.w) * bfhi(w.w); return s; }

template <bool DIFF>
__device__ __forceinline__ void unit(const Args& A, Frame& F, int l, int mode, int b, int hk, int qblk, bool is_ctx, float lam, float lam_init) {
    const int wave = F.wave, lane = lane_id(), r = lane & 31, h = lane >> 5;
    LAS unsigned char* lds = F.lds;
    const bf16* P = WSP(bf16, WS_P); const bf16* VT = WSP(bf16, WS_VT);
    const bool gqa = (mode & 1) != 0;
    const int head = gqa ? 2 * hk + (wave >> 2) : hk;
    const int pos0w = gqa ? qblk * 128 + 32 * (wave & 3) : qblk * 256 + 32 * wave;
    const int pos = pos0w + r;
    const size_t mq = (size_t)b * T + (is_ctx ? pos : CTX + pos);
    const int qcol = mode == 0 ? 64 * head : (mode == 1 ? 768 + 64 * head : (mode == 2 ? 1280 + 64 * head : 2048 + 64 * head));
    const int kcol = mode == 0 ? 256 + 64 * hk : (mode == 1 ? 1024 + 64 * hk : (mode == 2 ? 1536 + 64 * hk : 2304 + 64 * hk));
    const int vh = mode == 0 ? hk : (mode == 1 ? 4 + hk : (mode == 2 ? 6 + hk : 10 + hk));
    const int kid = mode == 0 ? 2 * hk : (mode == 1 ? 8 + hk : (mode == 2 ? 10 + hk : 14 + hk));
    const int ocol = mode * 256 + 64 * head;
    bf16x8 qf[4];
#pragma unroll
    for (int ks = 0; ks < 4; ++ks) qf[ks] = *(const bf16x8*)(P + mq * INW + qcol + 16 * ks + 8 * h);
    const unsigned* km = F.ctl + CW_KMAX + (l * NB + b) * 16;
    float negM[2];
    float bias_max = 0.f;
    LAS float* rpbL = (LAS float*)(lds + RPB_OFF);
    if (mode == 2 && !is_ctx) {
        const float* rp = A.in[I_RPB] + (size_t)(l * 4 + hk) * 465;
        for (int i = wave * 64 + lane; i < 465; i += NWAVES * 64) { const float v = rp[i] * LOG2E; rpbL[(i / 31) * 32 + (i % 31)] = v; }
        float mx = 0.f; for (int i = lane; i < 465; i += 64) mx = fmaxf(mx, fabsf(rp[i]) * LOG2E);
#pragma unroll
        for (int o = 0; o < 1; ++o) { mx = fmaxf(mx, sx<1>(mx)); mx = fmaxf(mx, sx<2>(mx)); mx = fmaxf(mx, sx<4>(mx)); mx = fmaxf(mx, sx<8>(mx)); mx = fmaxf(mx, sx<16>(mx)); mx = max32(mx); }
        bias_max = mx;
    }
    if (DIFF) {
        float s0 = sumsq8(qf[0]) + sumsq8(qf[1]), s1 = sumsq8(qf[2]) + sumsq8(qf[3]);
        s0 = sum32(s0); s1 = sum32(s1);
        negM[0] = -sqrtf(s0 * __builtin_bit_cast(float, __hip_atomic_load(km + kid, RLX_AGENT))) * 1.0001f;
        negM[1] = -sqrtf(s1 * __builtin_bit_cast(float, __hip_atomic_load(km + kid + 1, RLX_AGENT))) * 1.0001f;
    } else {
        float s0 = sumsq8(qf[0]) + sumsq8(qf[1]) + sumsq8(qf[2]) + sumsq8(qf[3]);
        s0 = sum32(s0);
        negM[0] = -(sqrtf(s0 * __builtin_bit_cast(float, __hip_atomic_load(km + kid, RLX_AGENT))) * 1.0001f + bias_max); negM[1] = 0.f;
    }
    int lt0 = 0, lt1 = 0;
    if (!is_ctx) {
        if (mode <= 1) { lt0 = 4; lt1 = 68; }
        else if (mode == 2) { const int R = 4 * qblk; lt0 = 4 + min(max(R - 4, 0), 56); lt1 = 4 + min(max(R + 3 - 4, 0), 56) + 8; }
        else { const int s0 = qblk * 128; lt0 = 4 + max(0, (s0 - 128) >> 6); lt1 = 4 + min(63, (s0 + 255) >> 6) + 1; }
    }
    const int ntiles = 4 + (lt1 - lt0);
    const int pidx = wave * 64 + lane, rho = pidx >> 3, cch = (pidx & 7) ^ ((rho >> 1) & 7);
    const char* ksrc = (const char*)(P + ((size_t)b * T + rho) * INW + kcol + cch * 8);
    const char* vsrc = (const char*)(VT + (((size_t)b * 12 + vh) * 64 + rho) * T + cch * 8);
#define ATT_ISSUE(ti_) ATT_ISSUE_AT(ti_, (ti_) % 3)
#define ATT_ISSUE_AT(ti_, bufi_) do { const int kt_ = (ti_) < 4 ? (ti_) : lt0 + (ti_) - 4; const int bf_ = (bufi_); \
        __builtin_amdgcn_global_load_lds((const unsigned*)(ksrc + (size_t)kt_ * (64 * INW * 2)), (LAS unsigned*)(lds + K_RING + bf_ * 8192 + wave * 1024), 16, 0, 0); \
        __builtin_amdgcn_global_load_lds((const unsigned*)(vsrc + (size_t)kt_ * 128), (LAS unsigned*)(lds + V_RING + bf_ * 8192 + wave * 1024), 16, 0, 0); } while (0)
    const int xk = swap23(r), gk = (xk >> 1) & 7, gv = (r >> 1) & 7;
    int kofs[4], vofs[4];
#pragma unroll
    for (int i = 0; i < 4; ++i) { kofs[i] = xk * 128 + (((2 * i + h) ^ gk) << 4); vofs[i] = r * 128 + (((2 * i + h) ^ gv) << 4); }
    const int rw = pos0w >> 6, r0w = min(max(rw - 4, 0), 56), cq = pos & 63, c0 = min(max(cq - 8, 0), 48);
    f32x16 O[DIFF ? 4 : 2];
#pragma unroll
    for (int i = 0; i < (DIFF ? 4 : 2); ++i)
#pragma unroll
        for (int j = 0; j < 16; ++j) O[i][j] = 0.f;
    float lsum[2] = {0.f, 0.f};
    ATT_ISSUE(0); ATT_ISSUE(1);
#pragma clang loop unroll(disable)
    for (int ti = 0; ti < ntiles; ++ti) {
        asm volatile("s_waitcnt vmcnt(2)" ::: "memory");
        __builtin_amdgcn_s_barrier(); asm volatile("" ::: "memory");
        { const int tn = min(ti + 2, ntiles - 1); ATT_ISSUE_AT(tn, (ti + 2) % 3); }
        const int kt = ti < 4 ? ti : lt0 + ti - 4, bf = ti % 3;
        const bool latt = ti >= 4;
        bool active = true; int msk = 0;
        if (latt && mode == 2) { const int kr = kt - 4; active = (kr >= r0w) && (kr < r0w + 8); msk = 2; }
        if (latt && mode == 3) { const int k0 = 64 * (kt - 4); active = (k0 + 63 >= pos0w - 128) && (k0 <= pos0w + 31 + 128); msk = 3; }
        if (!active) continue;
        const LAS unsigned char* kb = lds + K_RING + bf * 8192; const LAS unsigned char* vb = lds + V_RING + bf * 8192;
#pragma unroll
        for (int mp = 0; mp < (DIFF ? 2 : 1); ++mp) {
            f32x16 p0, p1;
#pragma unroll
            for (int j = 0; j < 16; ++j) { p0[j] = DIFF ? 0.f : negM[mp]; p1[j] = DIFF ? 0.f : negM[mp]; }
#pragma unroll
            for (int kk = 0; kk < (DIFF ? 2 : 4); ++kk) { const int ks = DIFF ? 2 * mp + kk : kk;
                const bf16x8 a0 = *(const LAS bf16x8*)(kb + kofs[ks]), a1 = *(const LAS bf16x8*)(kb + 4096 + kofs[ks]);
                p0 = __builtin_amdgcn_mfma_f32_32x32x16_bf16(a0, qf[ks], p0, 0, 0, 0);
                p1 = __builtin_amdgcn_mfma_f32_32x32x16_bf16(a1, qf[ks], p1, 0, 0, 0); }
            __builtin_amdgcn_sched_barrier(0);
            float ps = 0.f;
            if (msk == 0) {
#pragma unroll
                for (int j = 0; j < 16; ++j) { p0[j] = __builtin_amdgcn_exp2f(DIFF ? p0[j] + negM[mp] : p0[j]); p1[j] = __builtin_amdgcn_exp2f(DIFF ? p1[j] + negM[mp] : p1[j]); ps += p0[j] + p1[j]; }
            } else if (msk == 2) {
                const LAS float* brow = rpbL + (kt - 4 - rw + 7) * 32 + (15 - cq);
#pragma unroll
                for (int j = 0; j < 16; ++j) { const int kc0 = 16 * (j >> 3) + 8 * h + (j & 7), kc1 = kc0 + 32;
                    const bool ok0 = (kc0 >= c0) && (kc0 < c0 + 16), ok1 = (kc1 >= c0) && (kc1 < c0 + 16);
                    const float b0 = ok0 ? brow[kc0] : 0.f, b1 = ok1 ? brow[kc1] : 0.f;
                    p0[j] = ok0 ? __builtin_amdgcn_exp2f(p0[j] + b0) : 0.f; p1[j] = ok1 ? __builtin_amdgcn_exp2f(p1[j] + b1) : 0.f; ps += p0[j] + p1[j]; }
            } else {
                const int d0 = 64 * (kt - 4) - pos;
#pragma unroll
                for (int j = 0; j < 16; ++j) { const int kc0 = 16 * (j >> 3) + 8 * h + (j & 7), dd0 = d0 + kc0, dd1 = dd0 + 32;
                    const bool ok0 = (dd0 <= 128) && (dd0 >= -128), ok1 = (dd1 <= 128) && (dd1 >= -128);
                    p0[j] = ok0 ? __builtin_amdgcn_exp2f(p0[j]) : 0.f; p1[j] = ok1 ? __builtin_amdgcn_exp2f(p1[j]) : 0.f; ps += p0[j] + p1[j]; }
            }
            lsum[mp] += ps;
            __builtin_amdgcn_sched_barrier(0);
            bf16x8 pa[4]; pa[0] = pack8(p0, 0); pa[1] = pack8(p0, 8); pa[2] = pack8(p1, 0); pa[3] = pack8(p1, 8);
            __builtin_amdgcn_sched_barrier(0);
#pragma unroll
            for (int dvb = 0; dvb < 2; ++dvb)
#pragma unroll
                for (int s4 = 0; s4 < 4; ++s4) { const bf16x8 vf = *(const LAS bf16x8*)(vb + dvb * 4096 + vofs[s4]);
                    O[(DIFF ? 2 * mp : 0) + dvb] = __builtin_amdgcn_mfma_f32_32x32x16_bf16(vf, pa[s4], O[(DIFF ? 2 * mp : 0) + dvb], 0, 0, 0); }
            __builtin_amdgcn_sched_barrier(0);
        }
    }
#undef ATT_ISSUE
#undef ATT_ISSUE_AT
    asm volatile("s_waitcnt vmcnt(0)" ::: "memory");
    bf16* orow = WSP(bf16, WS_CAT) + mq * D + ocol;
    float l0 = sum32(lsum[0]);
    if (mode == 3) l0 += __builtin_amdgcn_exp2f(A.in[I_SINK][l * 4 + head] * LOG2E + negM[0]);
    const float inv0 = 1.0f / l0;
    if (DIFF) {
        const float l1 = sum32(lsum[1]); const float inv1 = lam / l1;
        float ss = 0.f;
#pragma unroll
        for (int dvb = 0; dvb < 2; ++dvb)
#pragma unroll
            for (int j = 0; j < 16; ++j) { const float v = O[dvb][j] * inv0 - O[2 + dvb][j] * inv1; O[dvb][j] = v; ss += v * v; }
        ss = sum32(ss);
        const float rs = (1.0f - lam_init) / sqrtf(ss * (1.0f / 64.0f) + EPS);
        const float* dg = A.in[I_DG] + l * 64;
#pragma unroll
        for (int dvb = 0; dvb < 2; ++dvb)
#pragma unroll
            for (int g = 0; g < 4; ++g) { const int dv = 32 * dvb + 8 * g + 4 * h; const f32x4 gg = *(const f32x4*)(dg + dv);
                v2u w; w.x = pk2(O[dvb][4 * g] * rs * gg[0], O[dvb][4 * g + 1] * rs * gg[1]); w.y = pk2(O[dvb][4 * g + 2] * rs * gg[2], O[dvb][4 * g + 3] * rs * gg[3]);
                *(v2u*)(orow + dv) = w; }
    } else {
#pragma unroll
        for (int dvb = 0; dvb < 2; ++dvb)
#pragma unroll
            for (int g = 0; g < 4; ++g) { const int dv = 32 * dvb + 8 * g + 4 * h;
                v2u w; w.x = pk2(O[dvb][4 * g] * inv0, O[dvb][4 * g + 1] * inv0); w.y = pk2(O[dvb][4 * g + 2] * inv0, O[dvb][4 * g + 3] * inv0);
                *(v2u*)(orow + dv) = w; }
    }
}
}

__device__ __forceinline__ void phase_attn(const Args& A, Frame& F, int l, int ctr_off = 0) {
    const int wave = F.wave, lane0 = lane_id();
    const float lam_init = 0.8f - 0.6f * expf(-0.3f * (float)l);
    float lam;
    { const float* lf = A.in[I_DLAM] + l * 128; float a = 0.f, bq = 0.f; if (lane0 < 32) { a = lf[lane0] * lf[32 + lane0]; bq = lf[64 + lane0] * lf[96 + lane0]; }
      a = wave_sum(a); bq = wave_sum(bq); lam = expf(a) - expf(bq) + lam_init; }
    const int NU = (l < NL - 1) ? 2048 + 128 : 2048;
    unsigned* ctr = F.ctl + CW_WORK + 64 * l + ctr_off;
    volatile LAS int* uw = (volatile LAS int*)(F.lds + att::UW_OFF);
    for (;;) {
        if (wave == 0 && lane0 == 0) uw[0] = (int)__hip_atomic_fetch_add(ctr, 1u, RLX_AGENT);
        __syncthreads();
        const int u = __builtin_amdgcn_readfirstlane(uw[0]);
        if (u >= NU) break;
        int mode, b, hk, qblk; bool is_ctx = false;
        if (u < 2048) { mode = u >> 9; const int v = u & 511; b = v >> 6;
            if (mode & 1) { hk = (v >> 5) & 1; qblk = v & 31; } else { hk = (v >> 4) & 3; qblk = v & 15; } }
        else { const int v = u - 2048; mode = v >> 5; const int w = v & 31; b = w >> 2; is_ctx = true;
            if (mode & 1) { hk = (w >> 1) & 1; qblk = w & 1; } else { hk = w & 3; qblk = 0; } }
        if (mode == 0) att::unit<true>(A, F, l, 0, b, hk, qblk, is_ctx, lam, lam_init);
        else att::unit<false>(A, F, l, mode, b, hk, qblk, is_ctx, lam, lam_init);
    }
}

__device__ __forceinline__ void router_pick(float (&acc)[32], int lane, const float* rb, unsigned* cnt, int m, int* rinfo, float* rgate) {
#pragma unroll
    for (int i = 0; i < 16; ++i) { const bool hi = lane & 32; const float send = hi ? acc[i] : acc[i + 16], keep = hi ? acc[i + 16] : acc[i]; acc[i] = keep + other32(send, hi); }
#pragma unroll
    for (int i = 0; i < 8; ++i) { const bool hi = lane & 16; const float send = hi ? acc[i] : acc[i + 8], keep = hi ? acc[i + 8] : acc[i]; acc[i] = keep + sx<16>(send); }
#pragma unroll
    for (int i = 0; i < 4; ++i) { const bool hi = lane & 8; const float send = hi ? acc[i] : acc[i + 4], keep = hi ? acc[i + 4] : acc[i]; acc[i] = keep + sx<8>(send); }
#pragma unroll
    for (int i = 0; i < 2; ++i) { const bool hi = lane & 4; const float send = hi ? acc[i] : acc[i + 2], keep = hi ? acc[i + 2] : acc[i]; acc[i] = keep + sx<4>(send); }
    { const bool hi = lane & 2; const float send = hi ? acc[0] : acc[1], keep = hi ? acc[1] : acc[0]; acc[0] = keep + sx<2>(send); }
    const int my_e = lane >> 1;
    float logit = acc[0] + sx<1>(acc[0]) + rb[my_e];
    float tv[4]; int te[4];
#pragma unroll
    for (int k = 0; k < 4; ++k) {
        float bv = logit; int be = my_e;
#define AMX(ov_, oe_) do { const float ov = (ov_); const int oe = (oe_); const bool take = (ov > bv) || (ov == bv && oe < be); bv = take ? ov : bv; be = take ? oe : be; } while (0)
        AMX(sx<2>(bv), sxi<2>(be)); AMX(sx<4>(bv), sxi<4>(be)); AMX(sx<8>(bv), sxi<8>(be)); AMX(sx<16>(bv), sxi<16>(be)); AMX(other32(bv, lane >= 32), other32i(be, lane >= 32));
#undef AMX
        tv[k] = bv; te[k] = be; if (my_e == be) logit = -INFINITY;
    }
    const float e1 = __expf(tv[1] - tv[0]), e2 = __expf(tv[2] - tv[0]), e3 = __expf(tv[3] - tv[0]); const float inv = 1.0f / (1.0f + e1 + e2 + e3);
    if (lane < 4) { const int ee = lane == 0 ? te[0] : (lane == 1 ? te[1] : (lane == 2 ? te[2] : te[3])); const float gg = (lane == 0 ? 1.0f : (lane == 1 ? e1 : (lane == 2 ? e2 : e3))) * inv;
        const unsigned pos = __hip_atomic_fetch_add(cnt + ee, 1u, RLX_AGENT);
        rinfo[(size_t)ee * M + pos] = m * 4 + lane; rgate[(size_t)m * 4 + lane] = gg; }
}
__device__ __forceinline__ void phase_post_out(const Args& A, Frame& F, int l) {
    const int wave = F.wave, lane0 = lane_id(), tid = wave * 64 + lane0;
    LAS unsigned char* wl = F.lds;
    { const float* rw = A.in[I_RW] + (size_t)l * D * NE;
      for (int idx = tid; idx < D * 8; idx += NWAVES * 64) { const int k = idx >> 3, c = idx & 7, ln = (k & 255) >> 2, j = k >> 8, i = k & 3, kap = (j * 4 + i) * 64 + ln;
          *(LAS f32x4*)(wl + kap * 128 + ((c ^ ((kap >> 1) & 7)) << 4)) = *(const GAS f32x4*)(rw + (size_t)k * NE + 4 * c); } }
    __syncthreads();
    const int gw = F.vcu * NWAVES + wave, NGW = F.G * NWAVES;
    const float* mod = WSP(float, WS_MOD);
    const float* rb = A.in[I_RB] + l * NE;
    unsigned* cnt = F.ctl + CW_CNT + 64 * l;
    for (int pr = gw; pr < M / 2; pr += NGW) {
        const int m0 = 2 * pr, b = m0 / T, t = m0 % T; if (l == NL - 1 && t < CTX) continue;
        const int lane = lane_id(), sw = (lane >> 1) & 7;
        const int r = t < CTX ? 8 : b;
        const float* md = mod + (size_t)(l * 9 + r) * 6144;
        Row x0, x1, o0, o1;
        float* xp = WSP(float, WS_X) + (size_t)m0 * D;
        row_load_f32(x0, xp, lane); row_load_f32(x1, xp + D, lane);
        row_load_bf16(o0, WSP(bf16, WS_O) + (size_t)m0 * D, lane); row_load_bf16(o1, WSP(bf16, WS_O) + (size_t)(m0 + 1) * D, lane);
#pragma unroll
        for (int j = 0; j < 4; ++j) { const f32x4 g1 = ((const GAS f32x4*)(md + 2048))[lane + 64 * j]; x0.v[j] += g1 * o0.v[j]; x1.v[j] += g1 * o1.v[j]; }
        row_store_f32(x0, xp, lane); row_store_f32(x1, xp + D, lane);
        const float r0 = row_rstd(x0), r1 = row_rstd(x1);
        row_modulate(o0, x0, r0, A.in[I_N2G] + l * D, md + 4096, md + 3072, lane); row_modulate(o1, x1, r1, A.in[I_N2G] + l * D, md + 4096, md + 3072, lane);
        row_store_bf16(o0, WSP(bf16, WS_H) + (size_t)m0 * D, lane); row_store_bf16(o1, WSP(bf16, WS_H) + (size_t)(m0 + 1) * D, lane);
#pragma unroll
        for (int rr = 0; rr < 2; ++rr) {
            __builtin_amdgcn_sched_barrier(0);
            float a0[32];
#pragma unroll
            for (int e = 0; e < 32; ++e) a0[e] = 0.f;
#pragma unroll
            for (int j = 0; j < 4; ++j)
#pragma unroll
                for (int i = 0; i < 4; ++i) { const float xa = rr ? o1.v[j][i] : o0.v[j][i]; const LAS unsigned char* wp = wl + ((j * 4 + i) * 64 + lane) * 128;
#pragma unroll
                    for (int c = 0; c < 8; ++c) { const f32x4 w4 = *(const LAS f32x4*)(wp + ((c ^ sw) << 4));
#pragma unroll
                        for (int q = 0; q < 4; ++q) a0[4 * c + q] += xa * w4[q]; }
                    __builtin_amdgcn_sched_barrier(0); }
            router_pick(a0, lane, rb, cnt, m0 + rr, WSP(int, WS_RINFO), WSP(float, WS_RGATE));
        }
    }
}

__device__ __forceinline__ int moe_setup(Frame& F, int l, int nN) {
    const int wave = F.wave, lane = lane_id(), tid = wave * 64 + lane;
    LAS int* tb = (LAS int*)(F.lds + MOE_TAB_OFF); LAS int* ut = (LAS int*)(F.lds + MOE_UT_OFF); LAS int* idx = (LAS int*)(F.lds + MOE_IDX_OFF);
    if (tid < NE) tb[40 + tid] = (int)__hip_atomic_load(F.ctl + CW_CNT + 64 * l + tid, RLX_AGENT);
    __syncthreads();
    if (tid == 0) { int acc = 0; for (int e = 0; e < NE; ++e) { tb[e] = acc; acc += (tb[40 + e] + 255) >> 8; } tb[NE] = acc; }
    __syncthreads();
    const int total = tb[NE] * nN, c = (int)blockIdx.x, G = F.G;
    int n = total > c ? (total - c + G - 1) / G : 0; n = n > MOE_MAX_UNITS ? MOE_MAX_UNITS : n;
    const int* rinfo = WSP(int, WS_RINFO);
    for (int i = wave; i < n; i += NWAVES) {
        const int L = i * G + c, blk = L / nN, pn = L % nN;
        int e = 0;
#pragma unroll 1
        for (int j = 1; j < NE; ++j) e += (tb[j] <= blk) ? 1 : 0;
        const int jb = blk - tb[e], ce = tb[40 + e];
        if (lane == 0) { ut[4 * i] = blk; ut[4 * i + 1] = pn; ut[4 * i + 2] = e; }
#pragma unroll
        for (int q = 0; q < 4; ++q) { const int R = q * 64 + lane, pos = jb * 256 + R; idx[i * 256 + R] = pos < ce ? rinfo[(size_t)e * M + pos] : -1; }
    }
    __syncthreads();
    return __builtin_amdgcn_readfirstlane(n);
}

__device__ __forceinline__ void combine_row(const Args& A, Frame& F, int l, int m, int b, int t, const float* md, int lane) {
    Row x, y, yk;
    float* xp = WSP(float, WS_X) + (size_t)m * D;
    row_load_f32(x, xp, lane);
    const f32x4 gates = *(const GAS f32x4*)(WSP(float, WS_RGATE) + (size_t)m * 4);
    const bf16* Y = WSP(bf16, WS_YT) + (size_t)m * 4 * D;
#pragma unroll
    for (int j = 0; j < 4; ++j) y.v[j] = (f32x4){0.f, 0.f, 0.f, 0.f};
#pragma unroll
    for (int k = 0; k < 4; ++k) { row_load_bf16(yk, Y + (size_t)k * D, lane);
#pragma unroll
        for (int j = 0; j < 4; ++j) y.v[j] += yk.v[j] * gates[k]; }
#pragma unroll
    for (int j = 0; j < 4; ++j) x.v[j] += ((const GAS f32x4*)(md + 5120))[lane + 64 * j] * y.v[j];
    const float rstd = row_rstd(x);
    if (l < NL - 1) {
        row_store_f32(x, xp, lane);
        const float* md2 = md + 9 * 6144;
        Row h; row_modulate(h, x, rstd, A.in[I_N1G] + (l + 1) * D, md2 + 1024, md2, lane);
        row_store_bf16(h, WSP(bf16, WS_H) + (size_t)m * D, lane);
    } else {
        float* op = A.out + ((size_t)b * SEQ + (t - CTX)) * D;
#pragma unroll
        for (int j = 0; j < 4; ++j) ((GAS f32x4*)op)[lane + 64 * j] = x.v[j] * rstd * ((const GAS f32x4*)A.in[I_FG])[lane + 64 * j];
    }
}
__device__ __forceinline__ void phase_combine(const Args& A, Frame& F, int l) {
    const int wave = F.wave, lane = lane_id();
    const int gw = F.vcu * NWAVES + wave, NGW = F.G * NWAVES;
    const float* mod = WSP(float, WS_MOD);
    for (int pr = gw; pr < M / 2; pr += NGW) {
        const int m0 = 2 * pr, b = m0 / T, t = m0 % T; if (l == NL - 1 && t < CTX) continue;
        const int r = t < CTX ? 8 : b;
        const float* md = mod + (size_t)(l * 9 + r) * 6144;
        combine_row(A, F, l, m0, b, t, md, lane);
        combine_row(A, F, l, m0 + 1, b, t + 1, md, lane);
    }
}

constexpr int PH_PER_LAYER = 8, N_PHASES = 2 + NL * PH_PER_LAYER;
__global__ void __launch_bounds__(NWAVES * 64, 2) fwd(Args A) {
    extern __shared__ __attribute__((aligned(16))) unsigned char lds_raw[];
    Frame F;
    F.lds = (LAS unsigned char*)lds_raw; F.ws = A.ws; F.ctl = (unsigned*)(A.ws + WS_CTL);
    F.wave = __builtin_amdgcn_readfirstlane((int)threadIdx.x >> 6);
    F.G = gridDim.x; { const int bx = blockIdx.x; F.vcu = (F.G % 8 == 0) ? (bx % 8) * (F.G / 8) + bx / 8 : bx; }
    for (int u = threadIdx.x; u < (LDS_BYTES - LDSCTL_OFF) / 4; u += NWAVES * 64) ((LAS unsigned*)(F.lds + LDSCTL_OFF))[u] = 0u;
    __syncthreads();
    const int lo = A.ph_lo, hi = A.ph_hi;
    XcdBarrier bar; bar.bar = F.ctl + CW_BAR; bar.x = 0; bar.st = nullptr; bar.wave = F.wave;
    if (hi - lo > 1) bar = xcd_barrier_post(F.ctl + CW_BAR, (volatile LAS unsigned*)(F.lds + MISC_OFF) + 8, F.wave);
#define IN(k) (lo <= (k) && (k) < hi)
#define SEAM(k) do { if (IN(k) && IN((k) + 1)) xcd_barrier(bar); } while (0)
    if (IN(0)) { phase_proA(A, F);
#if REP_MASK & 8
        xcd_barrier(bar); phase_proA(A, F);
#endif
        SEAM(0); }
    if (IN(1)) { phase_proB(A, F); SEAM(1); }
    for (int l = 0; l < NL; ++l) {
        F.ws = opq(F.ws); F.ctl = opq(F.ctl); asm volatile("" : "+s"(F.wave), "+s"(F.vcu), "+s"(F.G));
        const int pb = 2 + PH_PER_LAYER * l;
        if (IN(pb + 0)) {
            pg8::Gemm g{WSP(bf16, WS_H), WSP(bf16, WS_WIN) + (size_t)l * INW * D, D}; pg8::StaticOrder S; S.init(M, INW, F.G, (int)blockIdx.x);
            pg8::EpiStore E{WSP(bf16, WS_P), INW, nullptr, 0};
            pg8::gemm_phase<pg8::EpiStore, pg8::StaticOrder>(F.lds, g, S, E, F.wave);
#if REP_MASK & 4
            xcd_barrier(bar); pg8::gemm_phase<pg8::EpiStore, pg8::StaticOrder>(F.lds, g, S, E, F.wave);
#endif
            SEAM(pb + 0);
        }
        if (IN(pb + 1)) { phase_post_proj(A, F, l); SEAM(pb + 1); }
        if (IN(pb + 2)) { phase_attn(A, F, l);
#if REP_MASK & 1
            xcd_barrier(bar); phase_attn(A, F, l, 16);
#endif
            SEAM(pb + 2); }
        if (IN(pb + 3)) {
            pg8::Gemm g{WSP(bf16, WS_CAT), WSP(bf16, WS_WOUT) + (size_t)l * D * D, D}; pg8::StaticOrder S; S.init(M, D, F.G, (int)blockIdx.x);
            pg8::EpiStore E{WSP(bf16, WS_O), D, nullptr, 0};
            pg8::gemm_phase<pg8::EpiStore, pg8::StaticOrder>(F.lds, g, S, E, F.wave);
#if REP_MASK & 4
            xcd_barrier(bar); pg8::gemm_phase<pg8::EpiStore, pg8::StaticOrder>(F.lds, g, S, E, F.wave);
#endif
            SEAM(pb + 3);
        }
        if (IN(pb + 4)) { phase_post_out(A, F, l); SEAM(pb + 4); }
        if (IN(pb + 5)) {
            pg8::MoeOrder S; S.n = moe_setup(F, l, GU / 256); S.nN = GU / 256; S.ut = (const LAS int*)(F.lds + MOE_UT_OFF);
            pg8::Gemm g{WSP(bf16, WS_H), WSP(bf16, WS_WGU) + (size_t)l * NE * GU * D, D};
            pg8::EpiSwiglu E{WSP(bf16, WS_ACT), A.in[I_BGU] + (size_t)l * NE * GU};
            pg8::gemm_phase<pg8::EpiSwiglu, pg8::MoeOrder, true>(F.lds, g, S, E, F.wave, (const LAS int*)(F.lds + MOE_IDX_OFF));
#if REP_MASK & 2
            xcd_barrier(bar); pg8::gemm_phase<pg8::EpiSwiglu, pg8::MoeOrder, true>(F.lds, g, S, E, F.wave, (const LAS int*)(F.lds + MOE_IDX_OFF));
#endif
            SEAM(pb + 5);
        }
        if (IN(pb + 6)) {
            pg8::MoeOrder S; S.n = moe_setup(F, l, D / 256); S.nN = D / 256; S.ut = (const LAS int*)(F.lds + MOE_UT_OFF);
            pg8::Gemm g{WSP(bf16, WS_ACT), WSP(bf16, WS_WDN) + (size_t)l * NE * D * FF, FF};
            pg8::EpiYT E{WSP(bf16, WS_YT), A.in[I_BDN] + (size_t)l * NE * D, (const LAS int*)(F.lds + MOE_IDX_OFF)};
            pg8::gemm_phase<pg8::EpiYT, pg8::MoeOrder>(F.lds, g, S, E, F.wave);
#if REP_MASK & 2
            xcd_barrier(bar); pg8::gemm_phase<pg8::EpiYT, pg8::MoeOrder>(F.lds, g, S, E, F.wave);
#endif
            SEAM(pb + 6);
        }
        if (IN(pb + 7)) { phase_combine(A, F, l); SEAM(pb + 7); }
    }
#undef IN
#undef SEAM
}

extern "C" void kernel_launch(void* const* d_in, const int* in_sizes, int n_in, void* d_out, int out_size, void* d_ws, size_t ws_size, hipStream_t stream) {
    static int grid = 0;
    if (grid == 0) {
        if (n_in != 22 || out_size != NB * SEQ * D || ws_size < WS_END) { fprintf(stderr, "kernel_launch: unexpected shapes (n_in %d out %d ws %zu)\n", n_in, out_size, ws_size); grid = -1; return; }
        int dev = 0, cus = 0, per_cu = 0;
        if (hipGetDevice(&dev) != hipSuccess || hipDeviceGetAttribute(&cus, hipDeviceAttributeMultiprocessorCount, dev) != hipSuccess) { grid = -1; return; }
        if (hipFuncSetAttribute((const void*)fwd, hipFuncAttributeMaxDynamicSharedMemorySize, LDS_BYTES) != hipSuccess) { fprintf(stderr, "kernel_launch: hipFuncSetAttribute failed\n"); grid = -1; return; }
        if (hipOccupancyMaxActiveBlocksPerMultiprocessor(&per_cu, (const void*)fwd, NWAVES * 64, LDS_BYTES) != hipSuccess || per_cu < 1) fprintf(stderr, "kernel_launch: occupancy query reports %d\n", per_cu);
        (void)hipGetLastError();
        grid = cus;
    }
    if (grid < 0) return;
    if (hipMemsetAsync((char*)d_ws + WS_CTL, 0, CTL_ZERO_BYTES, stream) != hipSuccess) return;
    Args a{};
    for (int i = 0; i < 22; ++i) a.in[i] = (const float*)d_in[i];
    a.out = (float*)d_out; a.ws = (unsigned char*)d_ws;
#if MK_PER_PHASE
    for (int p = 0; p < N_PHASES; ++p) { a.ph_lo = p; a.ph_hi = p + 1; hipLaunchKernelGGL(fwd, dim3(grid), dim3(NWAVES * 64), LDS_BYTES, stream, a); }
#else
    a.ph_lo = 0; a.ph_hi = N_PHASES;
    hipLaunchKernelGGL(fwd, dim3(grid), dim3(NWAVES * 64), LDS_BYTES, stream, a);
#endif
}
```

```cpp
#include <hip/hip_runtime.h>
#include <cstdio>
#include <cstdint>

#ifndef REP_MASK
#define REP_MASK 0
#endif
#ifndef TPROBE
#define TPROBE -1
#endif
#ifndef MK_PER_PHASE
#define MK_PER_PHASE 0
#endif

#define GAS __attribute__((address_space(1)))
#define LAS __attribute__((address_space(3)))
typedef unsigned short bf16;
typedef unsigned v4u __attribute__((ext_vector_type(4)));
typedef unsigned v2u __attribute__((ext_vector_type(2)));
typedef float f32x4 __attribute__((ext_vector_type(4)));
typedef short bf16x8 __attribute__((ext_vector_type(8)));
typedef GAS unsigned gu32;

constexpr int NB = 8, SEQ = 4096, CTX = 256, T = CTX + SEQ, D = 1024, NL = 4;
constexpr int M = NB * T;
constexpr int INW = 2560;
constexpr int NE = 32, FF = 1024, GU = 2048;
constexpr int MOE_BLKS = M * 4 / 256 + NE;
constexpr int MOE_ROWS = MOE_BLKS * 256;
constexpr float EPS = 1e-6f;

namespace pg8 {
constexpr int BM = 256, BK = 64, HALF = 128, HTB = HALF * BK * 2, STAGE_BYTES = 8 * HTB, NXCD = 8, WGM = 8;
__host__ __device__ __forceinline__ int lds_byte(int r, int c) { const int st = (r >> 4) * 2 + (c >> 5), rr = r & 15, cc = c & 31, ob = rr * 64 + cc * 2; return st * 1024 + (ob ^ (((ob >> 9) & 1) << 5)); }
__host__ __device__ __forceinline__ void stage_rc(int b, int& R, int& C) { const int st = b / 1024, sb = b % 1024, swz = sb ^ (((sb >> 9) & 1) << 5); R = (st >> 1) * 16 + swz / 64; C = (st & 1) * 32 + (swz % 64) / 2; }
__host__ __device__ __forceinline__ int perm32(int rho) { const int n = rho >> 4, i = rho & 15; return 8 * (i >> 2) + 4 * n + (i & 3); }

struct Unit { int pm, pn, pb, e, ui; };
struct Gemm { const bf16* A; const bf16* Bt; int K; };

struct StaticOrder {
    int nM, nN, nwg, G, c; bool skipctx;
    __device__ void init(int M_, int N_, int G_, int c_, bool skipctx_ = false) { nM = M_ / BM; nN = N_ / BM; nwg = nM * nN; G = G_; c = c_; skipctx = skipctx_; }
    __device__ bool next(int i, Unit& u) const {
        const long L = (long)i * G + c; if (L >= nwg) return false;
        int wgid = (int)L; { const int q = nwg / NXCD, r = nwg % NXCD, xcd = wgid % NXCD, off = wgid / NXCD; wgid = (xcd < r ? xcd * (q + 1) : r * (q + 1) + (xcd - r) * q) + off; }
        const int nig = WGM * nN, gid = wgid / nig, fm = gid * WGM, gsz = (nM - fm) < WGM ? (nM - fm) : WGM;
        u.pm = fm + ((wgid % nig) % gsz); if (skipctx) u.pm += u.pm / 16 + 1; u.pn = (wgid % nig) / gsz; u.pb = u.pn; u.e = 0; u.ui = i; return true;
    }
};
struct MoeOrder {
    const LAS int* ut; int n, nN;
    __device__ bool next(int i, Unit& u) const {
        if (i >= n) return false;
        const int blk = __builtin_amdgcn_readfirstlane(ut[4 * i]), pn = __builtin_amdgcn_readfirstlane(ut[4 * i + 1]), e = __builtin_amdgcn_readfirstlane(ut[4 * i + 2]);
        u.pm = blk; u.pn = pn; u.pb = e * nN + pn; u.e = e; u.ui = i; return true;
    }
};

__device__ __forceinline__ void glds16s(const char* sbase, unsigned voff, unsigned lds_dst) {
    unsigned keep;
    asm volatile("s_mov_b32 %0, m0\n\ts_mov_b32 m0, %3\n\ts_nop 0\n\tglobal_load_lds_dwordx4 %1, %2\n\ts_mov_b32 m0, %0" : "=&s"(keep) : "v"(voff), "s"(sbase), "s"(lds_dst) : "memory");
}
typedef int v8i __attribute__((ext_vector_type(8)));
typedef int v4i __attribute__((ext_vector_type(4)));
__device__ __forceinline__ v8i cat8(bf16x8 lo, bf16x8 hi) { const v4i a = __builtin_bit_cast(v4i, lo), b = __builtin_bit_cast(v4i, hi); return __builtin_shufflevector(a, b, 0, 1, 2, 3, 4, 5, 6, 7); }
__device__ __forceinline__ unsigned cvt4_fp8(float a, float b, float c, float d) { int v = __builtin_amdgcn_cvt_pk_fp8_f32(a, b, 0, false); v = __builtin_amdgcn_cvt_pk_fp8_f32(c, d, v, true); return (unsigned)v; }
__device__ __forceinline__ unsigned cvt_pk_bf16(float lo, float hi) { unsigned r; asm volatile("v_cvt_pk_bf16_f32 %0, %1, %2" : "=v"(r) : "v"(lo), "v"(hi)); return r; }

struct EpiStore {
    bf16* O; int ldc; const float* bias; int bias_stride; float scale;
    __device__ __forceinline__ void operator()(const f32x4 (&acc)[2][2][4][2], const Unit& u, int wr, int wc, int fr, int fq) const {
        asm volatile("" : "+v"(fr), "+v"(fq));
        const int row0 = u.pm * BM + wr * 64 + fr, col0 = u.pn * BM + wc * 32 + 8 * fq;
        f32x4 bv[2][2];
#pragma unroll
        for (int bj = 0; bj < 2; ++bj)
#pragma unroll
            for (int n = 0; n < 2; ++n) bv[bj][n] = bias ? *(const f32x4*)(bias + (size_t)u.e * bias_stride + col0 + bj * HALF + 4 * n) : (f32x4){0.f, 0.f, 0.f, 0.f};
#pragma unroll
        for (int ai = 0; ai < 2; ++ai)
#pragma unroll
            for (int m = 0; m < 4; ++m) { bf16* rowp = O + (size_t)(row0 + ai * HALF + m * 16) * ldc + col0;
#pragma unroll
                for (int bj = 0; bj < 2; ++bj) { const f32x4 v0 = acc[ai][bj][m][0] * scale + bv[bj][0], v1 = acc[ai][bj][m][1] * scale + bv[bj][1];
                    v4u w; w.x = cvt_pk_bf16(v0[0], v0[1]); w.y = cvt_pk_bf16(v0[2], v0[3]); w.z = cvt_pk_bf16(v1[0], v1[1]); w.w = cvt_pk_bf16(v1[2], v1[3]);
                    *(v4u*)(rowp + bj * HALF) = w; } }
    }
};
__device__ __forceinline__ float swiglu1(float g, float u) {
    g = fminf(g, 7.0f); u = fminf(fmaxf(u, -7.0f), 7.0f);
    const float sg = __builtin_amdgcn_rcpf(1.0f + __expf(-1.702f * g));
    return g * sg * (u + 1.0f);
}
struct EpiSwiglu {
    unsigned char* O; const float* bias;
    __device__ __forceinline__ void operator()(const f32x4 (&acc)[2][2][4][2], const Unit& u, int wr, int wc, int fr, int fq) const {
        asm volatile("" : "+v"(fr), "+v"(fq));
        const int row0 = u.pm * BM + wr * 64 + fr, colA = u.pn * HALF + wc * 32 + 8 * fq;
        f32x4 bg[2], bu[2];
#pragma unroll
        for (int n = 0; n < 2; ++n) { bg[n] = *(const f32x4*)(bias + (size_t)u.e * GU + colA + 4 * n); bu[n] = *(const f32x4*)(bias + (size_t)u.e * GU + FF + colA + 4 * n); }
#pragma unroll
        for (int ai = 0; ai < 2; ++ai)
#pragma unroll
            for (int m = 0; m < 4; ++m) { unsigned char* rowp = O + (size_t)(row0 + ai * HALF + m * 16) * FF + colA;
                float a[8];
#pragma unroll
                for (int n = 0; n < 2; ++n)
#pragma unroll
                    for (int q = 0; q < 2; ++q) {
                        typedef float f32x2 __attribute__((ext_vector_type(2)));
                        f32x2 g = (f32x2){acc[ai][0][m][n][2 * q], acc[ai][0][m][n][2 * q + 1]} * (1.0f / 64.0f) + (f32x2){bg[n][2 * q], bg[n][2 * q + 1]};
                        f32x2 u = (f32x2){acc[ai][1][m][n][2 * q], acc[ai][1][m][n][2 * q + 1]} * (1.0f / 64.0f) + (f32x2){bu[n][2 * q], bu[n][2 * q + 1]};
                        g.x = fminf(g.x, 7.0f); g.y = fminf(g.y, 7.0f);
                        u.x = __builtin_amdgcn_fmed3f(u.x, -7.0f, 7.0f); u.y = __builtin_amdgcn_fmed3f(u.y, -7.0f, 7.0f);
                        const f32x2 t = g * (-1.702f * 1.4426950408889634f);
                        f32x2 e; e.x = __builtin_amdgcn_exp2f(t.x); e.y = __builtin_amdgcn_exp2f(t.y);
                        const f32x2 d = e + 1.0f;
                        f32x2 rr; rr.x = __builtin_amdgcn_rcpf(d.x); rr.y = __builtin_amdgcn_rcpf(d.y);
                        const f32x2 o = (g * rr) * (u * 4.0f + 4.0f);
                        a[4 * n + 2 * q] = o.x; a[4 * n + 2 * q + 1] = o.y; }
                v2u w; w.x = cvt4_fp8(a[0], a[1], a[2], a[3]); w.y = cvt4_fp8(a[4], a[5], a[6], a[7]);
                *(v2u*)rowp = w; }
    }
};
struct EpiYT {
    unsigned char* YT; const float* bias; const LAS int* idx;
    __device__ __forceinline__ void operator()(const f32x4 (&acc)[2][2][4][2], const Unit& u, int wr, int wc, int fr, int fq) const {
        asm volatile("" : "+v"(fr), "+v"(fq));
        const int col0 = u.pn * BM + wc * 32 + 8 * fq;
        f32x4 bv[2][2];
#pragma unroll
        for (int bj = 0; bj < 2; ++bj)
#pragma unroll
            for (int n = 0; n < 2; ++n) bv[bj][n] = *(const f32x4*)(bias + (size_t)u.e * D + col0 + bj * HALF + 4 * n);
#pragma unroll
        for (int ai = 0; ai < 2; ++ai)
#pragma unroll
            for (int m = 0; m < 4; ++m) { const int info = idx[u.ui * 256 + ai * HALF + wr * 64 + m * 16 + fr];
                if (info >= 0) { unsigned char* rowp = YT + (size_t)info * D + col0;
#pragma unroll
                    for (int bj = 0; bj < 2; ++bj) { const f32x4 v0 = acc[ai][bj][m][0] * (8.0f / 256.0f) + bv[bj][0] * 8.0f, v1 = acc[ai][bj][m][1] * (8.0f / 256.0f) + bv[bj][1] * 8.0f;
                        v2u w; w.x = cvt4_fp8(v0[0], v0[1], v0[2], v0[3]); w.y = cvt4_fp8(v1[0], v1[1], v1[2], v1[3]);
                        *(v2u*)(rowp + bj * HALF) = w; } } }
    }
};

template <class Epi, class Sched, bool GATHER = false, bool FP8 = false>
__device__ __forceinline__ void gemm_phase(LAS unsigned char* lds, const Gemm g, const Sched& S, const Epi& E, int wid, const LAS int* gidx = nullptr) {
    int lane; asm volatile("v_mbcnt_lo_u32_b32 %0, -1, 0\n\tv_mbcnt_hi_u32_b32 %0, -1, %0" : "=&v"(lane));
    const int tid = wid * 64 + lane, wr = wid >> 2, wc = wid & 3, fr = lane & 15, fq = lane >> 4;
    const int K = g.K, nt = K / BK;
    unsigned voffA[2], voffB[2];
#pragma unroll
    for (int i = 0; i < 2; ++i) { int R, C; stage_rc(tid * 16 + i * 8192, R, C); const int Rb = (R & ~31) + perm32(R & 31);
        voffA[i] = GATHER ? 0u : (unsigned)(R * K + C) * 2u; voffB[i] = (unsigned)(Rb * K + C) * 2u; }
    unsigned vgc[2][2];
#define PG8_GOFF(dst, ui_) do { int _t = tid; asm volatile("" : "+v"(_t)); _Pragma("unroll") for (int _i = 0; _i < 2; ++_i) { int _R, _C; stage_rc(_t * 16 + _i * 8192, _R, _C); _Pragma("unroll") for (int _h = 0; _h < 2; ++_h) { \
        const int _inf = gidx[(ui_) * 256 + _h * HALF + _R]; dst[_h][_i] = (unsigned)((_inf < 0 ? 0 : (_inf >> 2)) * K + _C) * 2u; } } } while (0)
    const size_t kstep = (size_t)(BK * 2);
    const size_t hstep = (size_t)HALF * K * 2;
    const size_t tstep = 2 * hstep;
    const unsigned ldsw = (unsigned)wid * 1024u;
    const int aoff = lds_byte(wr * 64 + fr, fq * 8), boff = lds_byte(wc * 32 + fr, fq * 8);
#define PG8_SA(b, h) (((b) * 2 + (h)) * HTB)
#define PG8_SB(b, h) ((4 + (b) * 2 + (h)) * HTB)
#define PG8_STAGE(bufoff, gbase, voff) do { _Pragma("unroll") for (int _i = 0; _i < 2; ++_i) \
        glds16s((const char*)(gbase), (voff)[_i], (unsigned)(size_t)(lds + (bufoff) + ldsw + _i * 8192)); } while (0)
#define PG8_LDA(dst, b, h) do { _Pragma("unroll") for (int m = 0; m < 4; ++m) _Pragma("unroll") for (int k = 0; k < 2; ++k) dst[m][k] = *(const LAS bf16x8*)(lds + PG8_SA(b, h) + aoff + m * 2048 + k * 1024); } while (0)
#define PG8_LDB(dst, b, h) do { _Pragma("unroll") for (int n = 0; n < 2; ++n) _Pragma("unroll") for (int k = 0; k < 2; ++k) dst[n][k] = *(const LAS bf16x8*)(lds + PG8_SB(b, h) + boff + n * 2048 + k * 1024); } while (0)
#define PG8_MMA(ai, bj, At, Bt) do { __builtin_amdgcn_s_setprio(1); if constexpr (FP8) { _Pragma("unroll") for (int m = 0; m < 4; ++m) _Pragma("unroll") for (int n = 0; n < 2; ++n) \
        acc[ai][bj][m][n] = __builtin_amdgcn_mfma_scale_f32_16x16x128_f8f6f4(cat8(Bt[n][0], Bt[n][1]), cat8(At[m][0], At[m][1]), acc[ai][bj][m][n], 0, 0, 0, 0, 0, 0); } else { \
        _Pragma("unroll") for (int m = 0; m < 4; ++m) _Pragma("unroll") for (int n = 0; n < 2; ++n) _Pragma("unroll") for (int k = 0; k < 2; ++k) \
        acc[ai][bj][m][n] = __builtin_amdgcn_mfma_f32_16x16x32_bf16(Bt[n][k], At[m][k], acc[ai][bj][m][n], 0, 0, 0); } __builtin_amdgcn_s_setprio(0); } while (0)
#define PG8_WAIT_V(n) asm volatile("s_waitcnt vmcnt(" #n ")" ::: "memory")
#define PG8_WAIT_L(n) asm volatile("s_waitcnt lgkmcnt(" #n ")" ::: "memory")
#define PG8_BAR __builtin_amdgcn_s_barrier()
#define PG8_SCHED __builtin_amdgcn_sched_barrier(0)
    Unit cur, nxt; int ui = 0;
    if (!S.next(0, cur)) return;
    f32x4 acc[2][2][4][2];
#pragma unroll
    for (int a = 0; a < 2; ++a)
#pragma unroll
        for (int b = 0; b < 2; ++b)
#pragma unroll
            for (int m = 0; m < 4; ++m)
#pragma unroll
                for (int n = 0; n < 2; ++n) acc[a][b][m][n] = (f32x4){0.f, 0.f, 0.f, 0.f};
    bf16x8 At[4][2], B0[2][2], B1[2][2];
    const char* cA = GATHER ? (const char*)g.A : (const char*)g.A + (size_t)cur.pm * tstep; const char* cB = (const char*)g.Bt + (size_t)cur.pb * tstep;
    if constexpr (GATHER) { PG8_GOFF(vgc, cur.ui); }
#define PG8_STAGE_A(bufoff, base, h, vg) do { if constexpr (GATHER) PG8_STAGE(bufoff, base, vg[h]); else PG8_STAGE(bufoff, (base) + (h) * hstep, voffA); } while (0)
    PG8_STAGE(PG8_SB(0, 0), cB, voffB); PG8_STAGE(PG8_SB(0, 1), cB + hstep, voffB); PG8_STAGE_A(PG8_SA(0, 0), cA, 0, vgc); PG8_STAGE_A(PG8_SA(0, 1), cA, 1, vgc);
    if (wr == 1) PG8_BAR;
    PG8_WAIT_V(2); PG8_BAR;
    PG8_STAGE(PG8_SB(1, 0), cB + kstep, voffB); PG8_STAGE_A(PG8_SA(1, 0), cA + kstep, 0, vgc); PG8_STAGE(PG8_SB(1, 1), cB + hstep + kstep, voffB);
    PG8_WAIT_V(6); PG8_BAR;
    for (;;) {
        const bool has_next = S.next(ui + 1, nxt);
        const char* nA = GATHER ? cA : (has_next ? (const char*)g.A + (size_t)nxt.pm * tstep : cA); const char* nB = has_next ? (const char*)g.Bt + (size_t)nxt.pb * tstep : cB;
        for (int t = 0; t < nt; t += 2) {
            const bool last = (t == nt - 2);
            const char* a1 = cA + (size_t)(t + 1) * kstep;
            const char* a2 = last ? nA : cA + (size_t)(t + 2) * kstep; const char* b2 = last ? nB : cB + (size_t)(t + 2) * kstep;
            const char* a3 = a2 + kstep; const char* b3 = b2 + kstep;
            PG8_LDB(B0, 0, 0); PG8_LDB(B1, 0, 1); PG8_SCHED; PG8_LDA(At, 0, 0); PG8_STAGE_A(PG8_SA(1, 1), a1, 1, vgc);
            if constexpr (GATHER) { if (last && has_next) { PG8_GOFF(vgc, nxt.ui); } }
            PG8_WAIT_V(8); PG8_WAIT_L(0); PG8_BAR; PG8_MMA(0, 0, At, B0); PG8_MMA(0, 1, At, B1); PG8_BAR; PG8_SCHED;
            PG8_LDA(At, 0, 1); PG8_STAGE(PG8_SB(0, 0), b2, voffB); PG8_STAGE(PG8_SB(0, 1), b2 + hstep, voffB); PG8_STAGE_A(PG8_SA(0, 0), a2, 0, vgc);
            PG8_WAIT_V(8); PG8_WAIT_L(0); PG8_BAR; PG8_MMA(1, 0, At, B0); PG8_MMA(1, 1, At, B1); PG8_BAR; PG8_SCHED;
            PG8_LDB(B0, 1, 0); PG8_LDB(B1, 1, 1); PG8_SCHED; PG8_LDA(At, 1, 0); PG8_STAGE_A(PG8_SA(0, 1), a2, 1, vgc);
            PG8_WAIT_V(8); PG8_WAIT_L(0); PG8_BAR; PG8_MMA(0, 0, At, B0); PG8_MMA(0, 1, At, B1); PG8_BAR; PG8_SCHED;
            PG8_LDA(At, 1, 1); PG8_STAGE(PG8_SB(1, 0), b3, voffB); PG8_STAGE(PG8_SB(1, 1), b3 + hstep, voffB); PG8_STAGE_A(PG8_SA(1, 0), a3, 0, vgc);
            PG8_WAIT_V(8); PG8_WAIT_L(0); PG8_BAR; PG8_MMA(1, 0, At, B0); PG8_MMA(1, 1, At, B1); PG8_BAR; PG8_SCHED;
        }
        if (wr == 0) PG8_BAR;
        { int ln_; asm volatile("v_mbcnt_lo_u32_b32 %0, -1, 0\n\tv_mbcnt_hi_u32_b32 %0, -1, %0" : "=&v"(ln_)); E(acc, cur, wr, wc, ln_ & 15, ln_ >> 4); }
        if (!has_next) break;
#pragma unroll
        for (int a = 0; a < 2; ++a)
#pragma unroll
            for (int b = 0; b < 2; ++b)
#pragma unroll
                for (int m = 0; m < 4; ++m)
#pragma unroll
                    for (int n = 0; n < 2; ++n) acc[a][b][m][n] = (f32x4){0.f, 0.f, 0.f, 0.f};
        cur = nxt; cA = nA; cB = nB; ++ui;
        if (wr == 1) PG8_BAR;
    }
    PG8_WAIT_V(0);
    PG8_BAR;
#undef PG8_SA
#undef PG8_SB
#undef PG8_STAGE
#undef PG8_STAGE_A
#undef PG8_GOFF
#undef PG8_LDA
#undef PG8_LDB
#undef PG8_MMA
#undef PG8_WAIT_V
#undef PG8_WAIT_L
#undef PG8_BAR
#undef PG8_SCHED
}
}

constexpr size_t MiB = 1u << 20;
constexpr size_t WS_CTL = 0, CTL_ZERO_BYTES = 1 * MiB;
constexpr size_t WS_MOD = 2 * MiB;
constexpr size_t WS_RGATE = 3 * MiB;
constexpr size_t WS_WIN = 8 * MiB;
constexpr size_t WS_WOUT = 28 * MiB;
constexpr size_t WS_WGU = 36 * MiB;
constexpr size_t WS_WDN = 548 * MiB;
constexpr size_t WS_X = 804 * MiB;
constexpr size_t WS_H = 940 * MiB;
constexpr size_t WS_P = 1008 * MiB;
constexpr size_t WS_VT = 1178 * MiB;
constexpr size_t WS_CAT = 1229 * MiB;
constexpr size_t WS_O = 1297 * MiB;
constexpr size_t WS_YT = 1365 * MiB;
constexpr size_t WS_ACT = 1653 * MiB;
constexpr size_t WS_RINFO = 1941 * MiB;
constexpr size_t WS_H8 = 1946 * MiB;
constexpr size_t WS_END = 1980 * MiB;
constexpr int CW_TMO = 0, CW_CODE = 1, CW_BAR = 4096, CW_CNT = 8192, CW_WORK = 8192 + 1024, CW_KMAX = 8192 + 2048;

constexpr int NWAVES = 8;
constexpr int RING_BYTES = 131072;
constexpr int LDSCTL_OFF = RING_BYTES, MISC_OFF = LDSCTL_OFF + 320;
constexpr int MOE_TAB_OFF = LDSCTL_OFF + 512, MOE_UT_OFF = LDSCTL_OFF + 1024, MOE_IDX_OFF = LDSCTL_OFF + 2048, MOE_MAX_UNITS = 18;
constexpr int LDS_BYTES = 163840;

#define RLX_AGENT __ATOMIC_RELAXED, __HIP_MEMORY_SCOPE_AGENT
#define LDS_WAIT() asm volatile("s_waitcnt lgkmcnt(0)" ::: "memory")
__device__ __forceinline__ unsigned f2bf(float f) { unsigned u = __builtin_bit_cast(unsigned, f); return (u + 0x7fffu + ((u >> 16) & 1u)) >> 16; }
__device__ __forceinline__ unsigned pk2(float lo, float hi) { return f2bf(lo) | (f2bf(hi) << 16); }
__device__ __forceinline__ float bflo(unsigned w) { return __builtin_bit_cast(float, w << 16); }
__device__ __forceinline__ float bfhi(unsigned w) { return __builtin_bit_cast(float, w & 0xffff0000u); }
__device__ __forceinline__ float bf2f(bf16 h) { return __builtin_bit_cast(float, (unsigned)h << 16); }
template <class Tp> __device__ __forceinline__ Tp* opq(Tp* p) { asm volatile("" : "+s"(p)); return p; }
__device__ __forceinline__ int lane_id() { int x; asm volatile("v_mbcnt_lo_u32_b32 %0, -1, 0\n\tv_mbcnt_hi_u32_b32 %0, -1, %0" : "=&v"(x)); return x; }
template <int MASK> __device__ __forceinline__ float sx(float v) {
    static_assert(MASK >= 1 && MASK < 32, "sx: xor mask inside a 32-lane half");
    return __builtin_bit_cast(float, __builtin_amdgcn_ds_swizzle(__builtin_bit_cast(int, v), (MASK << 10) | 0x1f));
}
template <int MASK> __device__ __forceinline__ int sxi(int v) { return __builtin_amdgcn_ds_swizzle(v, (MASK << 10) | 0x1f); }
__device__ __forceinline__ void swap32(unsigned& a, unsigned& b) { asm volatile("s_nop 1\n\tv_permlane32_swap_b32 %0, %1\n\ts_nop 1" : "+v"(a), "+v"(b)); }
__device__ __forceinline__ float sum32(float v) { unsigned a = __builtin_bit_cast(unsigned, v), b = a; swap32(a, b); return __builtin_bit_cast(float, a) + __builtin_bit_cast(float, b); }
__device__ __forceinline__ float max32(float v) { unsigned a = __builtin_bit_cast(unsigned, v), b = a; swap32(a, b); return fmaxf(__builtin_bit_cast(float, a), __builtin_bit_cast(float, b)); }
__device__ __forceinline__ float other32(float v, bool) { const unsigned u = __builtin_bit_cast(unsigned, v); unsigned a = u, b = u; swap32(a, b); return __builtin_bit_cast(float, a ^ b ^ u); }
__device__ __forceinline__ int other32i(int v, bool) { unsigned a = (unsigned)v, b = a; swap32(a, b); return (int)(a ^ b ^ (unsigned)v); }
__device__ __forceinline__ void swap16(unsigned& a, unsigned& b) { asm volatile("s_nop 1\n\tv_permlane16_swap_b32 %0, %1\n\ts_nop 1" : "+v"(a), "+v"(b)); }
__device__ __forceinline__ float other16(float v) { const unsigned u = __builtin_bit_cast(unsigned, v); unsigned a = u, b = u; swap16(a, b); return __builtin_bit_cast(float, a ^ b ^ u); }
__device__ __forceinline__ int other16i(int v) { unsigned a = (unsigned)v, b = a; swap16(a, b); return (int)(a ^ b ^ (unsigned)v); }
template <int CTRL> __device__ __forceinline__ float dppf(float v) { return __builtin_bit_cast(float, __builtin_amdgcn_update_dpp(0, __builtin_bit_cast(int, v), CTRL, 0xF, 0xF, false)); }
template <int CTRL> __device__ __forceinline__ int dppi(int v) { return __builtin_amdgcn_update_dpp(0, v, CTRL, 0xF, 0xF, false); }
constexpr int DPP_XOR1 = 0xB1, DPP_XOR2 = 0x4E, DPP_HMIRROR = 0x141, DPP_MIRROR = 0x140;
__device__ __forceinline__ float half_sum(float v) { v += sx<1>(v); v += sx<2>(v); v += sx<4>(v); v += sx<8>(v); v += sx<16>(v); return v; }
__device__ __forceinline__ float wave_sum(float v) { return sum32(half_sum(v)); }

#define XB_TMO      128
#define XB_XCNT(j)  (256  + 64 * (j))
#define XB_XSUB(j)  (1280 + 64 * (j))
#define XB_XGEN(j)  (2304 + 64 * (j))
#define XB_TOP      3328
#define XB_TOPGEN   3392
#define XCD_BAR_WORDS 3456
#define XB_SPIN_CAP (1u << 18)
__device__ __forceinline__ unsigned xb_ld(unsigned* p)              { return __hip_atomic_load(p, __ATOMIC_RELAXED, __HIP_MEMORY_SCOPE_AGENT); }
__device__ __forceinline__ unsigned xb_add(unsigned* p, unsigned v) { return __hip_atomic_fetch_add(p, v, __ATOMIC_RELAXED, __HIP_MEMORY_SCOPE_AGENT); }
__device__ __forceinline__ unsigned xb_xcc_id() { return (unsigned)__builtin_amdgcn_s_getreg((3 << 11) | 20) & 0xFu; }
#define XB_SPIN(cond, bar) do { unsigned _sp = 0; while (cond) { __builtin_amdgcn_s_sleep(1); \
    if ((++_sp & 255u) == 0u) { if (xb_ld(&(bar)[XB_TMO])) break; if (_sp > XB_SPIN_CAP) { atomicAdd(&(bar)[XB_TMO], 1u); break; } } } } while (0)
struct XcdBarrier { unsigned* bar; unsigned x; volatile LAS unsigned* st; int wave; };
__device__ __forceinline__ XcdBarrier xcd_barrier_post(unsigned* bar, volatile LAS unsigned* st, int wave) {
    XcdBarrier b; b.bar = bar; b.x = xb_xcc_id(); b.st = st; b.wave = wave;
    if (wave == 0 && lane_id() == 0) (void)xb_add(&bar[XB_XCNT(b.x)], 1u);
    return b;
}
__device__ __forceinline__ void xcd_barrier_complete(unsigned* bar, unsigned x, unsigned& nloc, unsigned& nx) {
    const unsigned G = gridDim.x * gridDim.y * gridDim.z;
    unsigned sum, cnt, mine, sp = 0u;
    for (;;) {
        sum = 0u; cnt = 0u; mine = 0u;
#pragma unroll
        for (unsigned j = 0; j < 16; ++j) { const unsigned c = xb_ld(&bar[XB_XCNT(j)]); sum += c; cnt += (c > 0u) ? 1u : 0u; mine = (j == x) ? c : mine; }
        if (sum == G) break;
        __builtin_amdgcn_s_sleep(1);
        if ((++sp & 255u) == 0u) { if (xb_ld(&bar[XB_TMO])) break; if (sp > XB_SPIN_CAP) { atomicAdd(&bar[XB_TMO], 1u); break; } }
    }
    nloc = mine > 0u ? mine : 1u; nx = cnt > 0u ? cnt : 1u;
}
__device__ __forceinline__ void xcd_barrier(const XcdBarrier& b) {
    asm volatile("s_waitcnt vmcnt(0)" ::: "memory");
    __syncthreads();
    if (b.wave == 0 && lane_id() == 0) {
        unsigned* bar = opq(b.bar);
        __builtin_amdgcn_s_waitcnt(0);
        unsigned nloc = b.st[0], nx = b.st[1];
        if (nloc == 0u) { xcd_barrier_complete(bar, b.x, nloc, nx); b.st[0] = nloc; b.st[1] = nx; }
        const unsigned old = xb_add(&bar[XB_XSUB(b.x)], 1u);
        const unsigned gen = old / nloc;
        if (old + 1u == (gen + 1u) * nloc) {
            __builtin_amdgcn_fence(__ATOMIC_RELEASE, "agent");
            asm volatile("s_waitcnt vmcnt(0)" ::: "memory");
            const unsigned og = xb_add(&bar[XB_TOP], 1u);
            const unsigned tg = og / nx;
            if (og + 1u == (tg + 1u) * nx) xb_add(&bar[XB_TOPGEN], 1u);
            else XB_SPIN(xb_ld(&bar[XB_TOPGEN]) == tg, bar);
            __builtin_amdgcn_fence(__ATOMIC_ACQUIRE, "agent");
            xb_add(&bar[XB_XGEN(b.x)], 1u);
            asm volatile("s_waitcnt vmcnt(0)" ::: "memory");
        } else {
            XB_SPIN(xb_ld(&bar[XB_XGEN(b.x)]) == gen, bar);
            __builtin_amdgcn_fence(__ATOMIC_ACQUIRE, "agent");
            asm volatile("s_waitcnt vmcnt(0)" ::: "memory");
        }
    }
    __syncthreads();
}

struct Args { const float* in[22]; float* out; unsigned char* ws; int ph_lo, ph_hi; };
enum { I_X = 0, I_C, I_CTX, I_CCTX, I_WADA, I_BADA, I_N1G, I_N2G, I_WIN, I_WOUT, I_DLAM, I_DG, I_QKG, I_RPB, I_SINK, I_RW, I_RB, I_WGU, I_BGU, I_WDN, I_BDN, I_FG };
struct Frame {
    LAS unsigned char* lds; unsigned char* ws; unsigned* ctl;
    int vcu, G, wave;
};
#define WSP(type, off) ((type*)(F.ws + (off)))

struct Row { f32x4 v[4]; };
__device__ __forceinline__ void row_load_f32(Row& r, const float* p, int lane) {
#pragma unroll
    for (int j = 0; j < 4; ++j) r.v[j] = ((const GAS f32x4*)p)[lane + 64 * j];
}
__device__ __forceinline__ void row_store_f32(const Row& r, float* p, int lane) {
#pragma unroll
    for (int j = 0; j < 4; ++j) ((GAS f32x4*)p)[lane + 64 * j] = r.v[j];
}
__device__ __forceinline__ void row_load_bf16(Row& r, const bf16* p, int lane) {
#pragma unroll
    for (int j = 0; j < 4; ++j) { const v2u w = ((const GAS v2u*)p)[lane + 64 * j]; r.v[j] = (f32x4){bflo(w.x), bfhi(w.x), bflo(w.y), bfhi(w.y)}; }
}
__device__ __forceinline__ void row_store_bf16(const Row& r, bf16* p, int lane) {
#pragma unroll
    for (int j = 0; j < 4; ++j) { v2u w; w.x = pk2(r.v[j][0], r.v[j][1]); w.y = pk2(r.v[j][2], r.v[j][3]); ((GAS v2u*)p)[lane + 64 * j] = w; }
}
__device__ __forceinline__ void row_store_fp8(const Row& r, unsigned char* p, int lane) {
#pragma unroll
    for (int j = 0; j < 4; ++j) ((GAS unsigned*)p)[lane + 64 * j] = pg8::cvt4_fp8(r.v[j][0], r.v[j][1], r.v[j][2], r.v[j][3]);
}
__device__ __forceinline__ float row_rstd(const Row& r) {
    float s = 0.f;
#pragma unroll
    for (int j = 0; j < 4; ++j) s += (r.v[j][0] * r.v[j][0] + r.v[j][1] * r.v[j][1]) + (r.v[j][2] * r.v[j][2] + r.v[j][3] * r.v[j][3]);
    return 1.0f / sqrtf(wave_sum(s) * (1.0f / D) + EPS);
}
__device__ __forceinline__ void row_modulate(Row& h, const Row& x, float rstd, const float* g, const float* sc, const float* sh, int lane) {
#pragma unroll
    for (int j = 0; j < 4; ++j) { const f32x4 gg = ((const GAS f32x4*)g)[lane + 64 * j], s1 = ((const GAS f32x4*)sc)[lane + 64 * j], s0 = ((const GAS f32x4*)sh)[lane + 64 * j];
        h.v[j] = x.v[j] * rstd * gg * (s1 + 1.0f) + s0; }
}

__device__ __forceinline__ void transpose_item(const float* W, int K, int N, bf16* WT, int k0, int n0, int dest_row0, LAS float* scr, int lane) {
    float tv[32];
#pragma unroll
    for (int i = 0; i < 32; ++i) { const int kk = 2 * i + (lane >> 5); tv[i] = W[(size_t)(k0 + kk) * N + n0 + (lane & 31)]; }
#pragma unroll
    for (int i = 0; i < 32; ++i) { const int kk = 2 * i + (lane >> 5); scr[kk * 33 + (lane & 31)] = tv[i]; }
    LDS_WAIT(); asm volatile("" ::: "memory");
    const int c = lane & 7;
#pragma unroll
    for (int j = 0; j < 4; ++j) { const int n = (lane >> 3) + 8 * j; const LAS float* s = scr + (8 * c) * 33 + n;
        v4u o; o.x = pk2(s[0 * 33], s[1 * 33]); o.y = pk2(s[2 * 33], s[3 * 33]); o.z = pk2(s[4 * 33], s[5 * 33]); o.w = pk2(s[6 * 33], s[7 * 33]);
        *(v4u*)(WT + (size_t)(dest_row0 + n) * K + k0 + 8 * c) = o; }
    LDS_WAIT(); asm volatile("" ::: "memory");
}
__device__ __forceinline__ void transpose_item8(const float* W, int K, int N, unsigned char* W8, int k0, int n0, int dest_row0, float scale, LAS float* scr, int lane) {
    float tv[32];
#pragma unroll
    for (int i = 0; i < 32; ++i) { const int kk = 2 * i + (lane >> 5); tv[i] = W[(size_t)(k0 + kk) * N + n0 + (lane & 31)]; }
#pragma unroll
    for (int i = 0; i < 32; ++i) { const int kk = 2 * i + (lane >> 5); scr[kk * 33 + (lane & 31)] = tv[i]; }
    LDS_WAIT(); asm volatile("" ::: "memory");
    const int n = lane >> 1, hf = lane & 1; const LAS float* sp = scr + (32 * hf) * 33 + n;
    v4u o0, o1;
    o0.x = pg8::cvt4_fp8(sp[0 * 33] * scale, sp[1 * 33] * scale, sp[2 * 33] * scale, sp[3 * 33] * scale); o0.y = pg8::cvt4_fp8(sp[4 * 33] * scale, sp[5 * 33] * scale, sp[6 * 33] * scale, sp[7 * 33] * scale);
    o0.z = pg8::cvt4_fp8(sp[8 * 33] * scale, sp[9 * 33] * scale, sp[10 * 33] * scale, sp[11 * 33] * scale); o0.w = pg8::cvt4_fp8(sp[12 * 33] * scale, sp[13 * 33] * scale, sp[14 * 33] * scale, sp[15 * 33] * scale);
    o1.x = pg8::cvt4_fp8(sp[16 * 33] * scale, sp[17 * 33] * scale, sp[18 * 33] * scale, sp[19 * 33] * scale); o1.y = pg8::cvt4_fp8(sp[20 * 33] * scale, sp[21 * 33] * scale, sp[22 * 33] * scale, sp[23 * 33] * scale);
    o1.z = pg8::cvt4_fp8(sp[24 * 33] * scale, sp[25 * 33] * scale, sp[26 * 33] * scale, sp[27 * 33] * scale); o1.w = pg8::cvt4_fp8(sp[28 * 33] * scale, sp[29 * 33] * scale, sp[30 * 33] * scale, sp[31 * 33] * scale);
    v4u* dst = (v4u*)(W8 + (size_t)(dest_row0 + n) * K + k0 + 32 * hf);
    dst[0] = o0; dst[1] = o1;
    LDS_WAIT(); asm volatile("" ::: "memory");
}
template <bool FP8>
__device__ __forceinline__ void convert_item64(const float* W, int K, int N, void* dst, int k0, int n0, int dest_row0, float scale, int lane) {
    float v[64];
    const GAS float* wp = (const GAS float*)W + (size_t)k0 * N + n0 + lane;
#pragma unroll
    for (int k = 0; k < 64; ++k) v[k] = wp[(size_t)k * N];
    if (FP8) { GAS v4u* o = (GAS v4u*)((unsigned char*)dst + (size_t)(dest_row0 + lane) * K + k0);
#pragma unroll
        for (int q = 0; q < 4; ++q) { v4u w; w.x = pg8::cvt4_fp8(v[16 * q] * scale, v[16 * q + 1] * scale, v[16 * q + 2] * scale, v[16 * q + 3] * scale); w.y = pg8::cvt4_fp8(v[16 * q + 4] * scale, v[16 * q + 5] * scale, v[16 * q + 6] * scale, v[16 * q + 7] * scale);
            w.z = pg8::cvt4_fp8(v[16 * q + 8] * scale, v[16 * q + 9] * scale, v[16 * q + 10] * scale, v[16 * q + 11] * scale); w.w = pg8::cvt4_fp8(v[16 * q + 12] * scale, v[16 * q + 13] * scale, v[16 * q + 14] * scale, v[16 * q + 15] * scale); o[q] = w; }
    } else { GAS v4u* o = (GAS v4u*)((bf16*)dst + (size_t)(dest_row0 + lane) * K + k0);
#pragma unroll
        for (int q = 0; q < 8; ++q) { v4u w; w.x = pk2(v[8 * q], v[8 * q + 1]); w.y = pk2(v[8 * q + 2], v[8 * q + 3]); w.z = pk2(v[8 * q + 4], v[8 * q + 5]); w.w = pk2(v[8 * q + 6], v[8 * q + 7]); o[q] = w; } }
}
constexpr int IT_IN = 16 * 40, IT_OUT = 16 * 16, IT_GU = 16 * 32, IT_DN = 16 * 16;
constexpr int IT_LAYER = IT_IN + IT_OUT + NE * IT_GU + NE * IT_DN;
constexpr int CONV_UNITS = IT_LAYER / 16;
struct ConvItem { const float* src; unsigned char* dst; int K, N; };
__device__ __forceinline__ ConvItem conv_decode(const Args& A, Frame& F, int l, int r) {
    ConvItem c;
    if (r < IT_IN) { const int kb = r / 40, nb = r % 40; c.K = D; c.N = INW; c.src = A.in[I_WIN] + (size_t)l * D * INW + (size_t)(64 * kb) * INW + 64 * nb; c.dst = WSP(unsigned char, WS_WIN) + (size_t)l * INW * D + (size_t)(64 * nb) * D + 64 * kb; return c; } r -= IT_IN;
    if (r < IT_OUT) { const int kb = r / 16, nb = r % 16; c.K = D; c.N = D; c.src = A.in[I_WOUT] + (size_t)l * D * D + (size_t)(64 * kb) * D + 64 * nb; c.dst = WSP(unsigned char, WS_WOUT) + (size_t)l * D * D + (size_t)(64 * nb) * D + 64 * kb; return c; } r -= IT_OUT;
    if (r < NE * IT_GU) { const int e = r / IT_GU, q = r % IT_GU, kb = q / 32, nb = q % 32, n0 = 64 * nb;
        const int dest = n0 < FF ? (n0 >> 7) * 256 + (n0 & 127) : ((n0 - FF) >> 7) * 256 + 128 + ((n0 - FF) & 127);
        c.K = D; c.N = GU; c.src = A.in[I_WGU] + (size_t)(l * NE + e) * D * GU + (size_t)(64 * kb) * GU + n0; c.dst = WSP(unsigned char, WS_WGU) + (size_t)(l * NE + e) * GU * D + (size_t)dest * D + 64 * kb; return c; } r -= NE * IT_GU;
    { const int e = r / IT_DN, q = r % IT_DN, kb = q / 16, nb = q % 16;
        c.K = FF; c.N = D; c.src = A.in[I_WDN] + (size_t)(l * NE + e) * FF * D + (size_t)(64 * kb) * D + 64 * nb; c.dst = WSP(unsigned char, WS_WDN) + (size_t)(l * NE + e) * D * FF + (size_t)(64 * nb) * FF + 64 * kb; return c; }
}
__device__ __forceinline__ void conv_load(const ConvItem& c, int lane, float (&v)[64]) { const GAS float* wp = (const GAS float*)c.src + lane;
#pragma unroll
    for (int k = 0; k < 64; ++k) v[k] = wp[(size_t)k * c.N]; }
__device__ __forceinline__ void conv_store(const ConvItem& c, int lane, const float (&v)[64]) { GAS v4u* o = (GAS v4u*)(c.dst + (size_t)lane * c.K);
#pragma unroll
    for (int q = 0; q < 4; ++q) { v4u w; w.x = pg8::cvt4_fp8(v[16 * q] * 64.0f, v[16 * q + 1] * 64.0f, v[16 * q + 2] * 64.0f, v[16 * q + 3] * 64.0f); w.y = pg8::cvt4_fp8(v[16 * q + 4] * 64.0f, v[16 * q + 5] * 64.0f, v[16 * q + 6] * 64.0f, v[16 * q + 7] * 64.0f);
        w.z = pg8::cvt4_fp8(v[16 * q + 8] * 64.0f, v[16 * q + 9] * 64.0f, v[16 * q + 10] * 64.0f, v[16 * q + 11] * 64.0f); w.w = pg8::cvt4_fp8(v[16 * q + 12] * 64.0f, v[16 * q + 13] * 64.0f, v[16 * q + 14] * 64.0f, v[16 * q + 15] * 64.0f); o[q] = w; } }
__device__ __forceinline__ void phase_proA(const Args& A, Frame& F) {
    const int wave = F.wave, lane = lane_id(), tid = wave * 64 + lane; (void)tid;
    LAS float* sl = (LAS float*)F.lds;
    LAS float* scr = (LAS float*)(F.lds + 40960 + wave * 8704);
    LAS float* red = (LAS float*)(F.lds + 110592);
    for (int i = tid; i < 9 * D; i += NWAVES * 64) { const int r = i >> 10, k = i & 1023; const float v = r < 8 ? A.in[I_C][r * D + k] : A.in[I_CCTX][k]; sl[i] = v / (1.0f + __expf(-v)); }
    __syncthreads();
    const bool ada = F.vcu < 192;
    const int item = F.vcu * 2 + (wave >> 2), al = item / 96, an = (item % 96) * 64 + lane, kq = wave & 3;
    if (ada) {
        const float* w = A.in[I_WADA] + (size_t)al * D * 6144 + (size_t)(kq * 256) * 6144 + an;
        float acc[9];
#pragma unroll
        for (int r = 0; r < 9; ++r) acc[r] = 0.f;
#pragma unroll 1
        for (int k0 = 0; k0 < 256; k0 += 16) { float wv[16];
#pragma unroll
            for (int kk = 0; kk < 16; ++kk) wv[kk] = w[(size_t)(k0 + kk) * 6144];
#pragma unroll
            for (int kk = 0; kk < 16; ++kk)
#pragma unroll
                for (int r = 0; r < 9; ++r) acc[r] += sl[r * D + kq * 256 + k0 + kk] * wv[kk]; }
#pragma unroll
        for (int r = 0; r < 9; ++r) red[(wave * 9 + r) * 64 + lane] = acc[r];
    }
    __syncthreads();
    if (ada && kq == 0) {
        const float bb = A.in[I_BADA][al * 6144 + an];
        float* mod = WSP(float, WS_MOD);
#pragma unroll
        for (int r = 0; r < 9; ++r) mod[(size_t)(al * 9 + r) * 6144 + an] = ((red[((wave + 0) * 9 + r) * 64 + lane] + red[((wave + 1) * 9 + r) * 64 + lane]) + (red[((wave + 2) * 9 + r) * 64 + lane] + red[((wave + 3) * 9 + r) * 64 + lane])) + bb;
    }
    const int gw = F.vcu * NWAVES + wave, NGW = F.G * NWAVES;
    for (int it = gw; it < IT_LAYER; it += NGW) { const ConvItem c = conv_decode(A, F, 0, it); float v[64]; conv_load(c, lane, v); conv_store(c, lane, v); }
}

__device__ __forceinline__ void phase_proB(const Args& A, Frame& F) {
    const int wave = F.wave, lane = lane_id();
    const int gw = F.vcu * NWAVES + wave, NGW = F.G * NWAVES;
    const float* mod = WSP(float, WS_MOD);
    for (int pr = gw; pr < M / 2; pr += NGW) {
        const int m0 = 2 * pr, b = m0 / T, t = m0 % T; const int r = t < CTX ? 8 : b;
        const float* src = t < CTX ? A.in[I_CTX] + ((size_t)b * CTX + t) * D : A.in[I_X] + ((size_t)b * SEQ + (t - CTX)) * D;
        Row x0, x1, h; row_load_f32(x0, src, lane); row_load_f32(x1, src + D, lane);
        row_store_bf16(x0, WSP(bf16, WS_X) + (size_t)m0 * D, lane); row_store_bf16(x1, WSP(bf16, WS_X) + (size_t)(m0 + 1) * D, lane);
        const float* md = mod + (size_t)(0 * 9 + r) * 6144;
        const float r0 = row_rstd(x0), r1 = row_rstd(x1);
        row_modulate(h, x0, r0, A.in[I_N1G], md + 1024, md, lane); row_store_fp8(h, WSP(unsigned char, WS_H) + (size_t)m0 * D, lane);
        row_modulate(h, x1, r1, A.in[I_N1G], md + 1024, md, lane); row_store_fp8(h, WSP(unsigned char, WS_H) + (size_t)(m0 + 1) * D, lane);
    }
}

constexpr float LOG2E = 1.4426950408889634f;
constexpr float QS32 = 0.17677669529663687f * LOG2E, QS64 = 0.125f * LOG2E;
__device__ __forceinline__ float rnd_bf(float x) { return __builtin_bit_cast(float, f2bf(x) << 16); }
__device__ __forceinline__ void unpack8(const v4u w, float (&x)[8]) { x[0] = bflo(w.x); x[1] = bfhi(w.x); x[2] = bflo(w.y); x[3] = bfhi(w.y); x[4] = bflo(w.z); x[5] = bfhi(w.z); x[6] = bflo(w.w); x[7] = bfhi(w.w); }
__device__ __forceinline__ v4u pack8f(const float (&x)[8]) { v4u w; w.x = pk2(x[0], x[1]); w.y = pk2(x[2], x[3]); w.z = pk2(x[4], x[5]); w.w = pk2(x[6], x[7]); return w; }
__device__ __forceinline__ float sumsq_rounded(const v4u w) { return bflo(w.x) * bflo(w.x) + bfhi(w.x) * bfhi(w.x) + bflo(w.y) * bflo(w.y) + bfhi(w.y) * bfhi(w.y) + bflo(w.z) * bflo(w.z) + bfhi(w.z) * bfhi(w.z) + bflo(w.w) * bflo(w.w) + bfhi(w.w) * bfhi(w.w); }
__device__ __forceinline__ void pp_token(bf16* prow, bool lat, int grow, int gcol, int lane, int tl, const LAS float* t64, const LAS float* t32, LAS bf16* vt,
                                         const float (&g0)[8], const float (&g1)[8], float& km0, float& km2, float& km3, float& km4) {
    const int sub = lane & 7, sg = lane >> 3;
    v4u w[5];
#pragma unroll
    for (int ld = 0; ld < 5; ++ld) { const bool isq = (ld == 0 || ld == 4) ? sg < 4 : ((ld == 1 || ld == 2) ? sg >= 4 : false);
        w[ld] = (v4u){0u, 0u, 0u, 0u}; if (!isq) w[ld] = ((const GAS v4u*)prow)[ld * 64 + lane]; }
    { float x[8], cs[8], sn[8]; unpack8(w[0], x);
      const int pos = (sub & 2) ? gcol : grow;
#pragma unroll
      for (int q = 0; q < 4; ++q) { const f32x4 tv = lat ? *(const LAS f32x4*)(t32 + pos * 16 + 4 * q) : (f32x4){1.f, 0.f, 1.f, 0.f}; cs[2 * q] = tv[0]; sn[2 * q] = tv[1]; cs[2 * q + 1] = tv[2]; sn[2 * q + 1] = tv[3]; }
      const float sc = sg < 4 ? QS32 : 1.0f; const bool second = sub & 1;
#pragma unroll
      for (int e = 0; e < 8; ++e) { const float pr = dppf<DPP_XOR1>(x[e]); x[e] = (second ? x[e] * cs[e] + pr * sn[e] : x[e] * cs[e] - pr * sn[e]) * sc; }
      const v4u o = pack8f(x); if (sg >= 4) ((GAS v4u*)prow)[lane] = o;
      float ss = sumsq_rounded(o); ss += dppf<DPP_XOR1>(ss); ss += dppf<DPP_XOR2>(ss); if (sg >= 4) km0 = fmaxf(km0, ss); }
    float c64[8], s64[8];
    { const int pos = (sub & 4) ? gcol : grow;
#pragma unroll
      for (int q = 0; q < 4; ++q) { const f32x4 tv = lat ? *(const LAS f32x4*)(t64 + (pos * 16 + 8 * (sub & 1)) * 2 + 4 * q) : (f32x4){1.f, 0.f, 1.f, 0.f}; c64[2 * q] = tv[0]; s64[2 * q] = tv[1]; c64[2 * q + 1] = tv[2]; s64[2 * q + 1] = tv[3]; } }
    const bool second64 = sub & 2;
    { float x[8]; unpack8(w[1], x);
      float ss = 0.f;
#pragma unroll
      for (int e = 0; e < 8; ++e) ss += x[e] * x[e];
      ss += dppf<DPP_XOR1>(ss); ss += dppf<DPP_XOR2>(ss); ss += dppf<DPP_HMIRROR>(ss);
      const float rs = 1.0f / sqrtf(ss * (1.0f / 64.0f) + EPS);
      if (sg >= 4) {
#pragma unroll
          for (int e = 0; e < 8; ++e) x[e] *= rs * g0[e]; }
#pragma unroll
      for (int e = 0; e < 8; ++e) { const float pr = dppf<DPP_XOR2>(x[e]); x[e] = (second64 ? x[e] * c64[e] + pr * s64[e] : x[e] * c64[e] - pr * s64[e]) * QS64; }
      if (sg < 4) { const int vh = sg; const unsigned short* hv = (const unsigned short*)&w[1];
#pragma unroll
          for (int e = 0; e < 8; ++e) vt[(vh * 64 + 8 * sub + e) * 66 + tl] = hv[e]; } }
    { float x[8]; unpack8(w[2], x);
      float ss = 0.f;
#pragma unroll
      for (int e = 0; e < 8; ++e) ss += x[e] * x[e];
      ss += dppf<DPP_XOR1>(ss); ss += dppf<DPP_XOR2>(ss); ss += dppf<DPP_HMIRROR>(ss);
      const float rs = 1.0f / sqrtf(ss * (1.0f / 64.0f) + EPS);
      if (sg < 2) {
#pragma unroll
          for (int e = 0; e < 8; ++e) x[e] *= rs * g1[e]; }
      const bool rope = sg < 2; const float sc = sg >= 4 ? QS64 : 1.0f;
#pragma unroll
      for (int e = 0; e < 8; ++e) { const float pr = dppf<DPP_XOR2>(x[e]); const float cc = rope ? c64[e] : 1.f, sv = rope ? s64[e] : 0.f; x[e] = (second64 ? x[e] * cc + pr * sv : x[e] * cc - pr * sv) * sc; }
      const v4u o = pack8f(x);
      if (sg < 2) ((GAS v4u*)prow)[128 + lane] = o;
      else if (sg < 4) { const int vh = 4 + (sg - 2); const unsigned short* hv = (const unsigned short*)&w[2];
#pragma unroll
          for (int e = 0; e < 8; ++e) vt[(vh * 64 + 8 * sub + e) * 66 + tl] = hv[e]; }
      float s2 = sumsq_rounded(o); s2 += dppf<DPP_XOR1>(s2); s2 += dppf<DPP_XOR2>(s2); s2 += dppf<DPP_HMIRROR>(s2); if (sg < 2) km2 = fmaxf(km2, s2); }
    { float s2 = sumsq_rounded(w[3]); s2 += dppf<DPP_XOR1>(s2); s2 += dppf<DPP_XOR2>(s2); s2 += dppf<DPP_HMIRROR>(s2); if (sg < 4) km3 = fmaxf(km3, s2);
      if (sg >= 4) { const int vh = 6 + (sg - 4); const unsigned short* hv = (const unsigned short*)&w[3];
#pragma unroll
          for (int e = 0; e < 8; ++e) vt[(vh * 64 + 8 * sub + e) * 66 + tl] = hv[e]; } }
    { float x[8]; unpack8(w[4], x);
      const float sc = sg < 4 ? QS64 : 1.0f;
#pragma unroll
      for (int e = 0; e < 8; ++e) { const float pr = dppf<DPP_XOR2>(x[e]); x[e] = (second64 ? x[e] * c64[e] + pr * s64[e] : x[e] * c64[e] - pr * s64[e]) * sc; }
      const v4u o = pack8f(x);
      if (sg == 4 || sg == 5) ((GAS v4u*)prow)[256 + lane] = o;
      else if (sg >= 6) { const int vh = 10 + (sg - 6); const unsigned short* hv = (const unsigned short*)&w[4];
#pragma unroll
          for (int e = 0; e < 8; ++e) vt[(vh * 64 + 8 * sub + e) * 66 + tl] = hv[e]; }
      float s2 = sumsq_rounded(o); s2 += dppf<DPP_XOR1>(s2); s2 += dppf<DPP_XOR2>(s2); s2 += dppf<DPP_HMIRROR>(s2); if (sg == 4 || sg == 5) km4 = fmaxf(km4, s2); }
}
__device__ __forceinline__ void phase_post_proj(const Args& A, Frame& F, int l) {
    const int wave = F.wave, lane0 = lane_id(), tid = wave * 64 + lane0;
    LAS bf16* vt = (LAS bf16*)F.lds;
    LAS float* t64 = (LAS float*)(F.lds + 102400);
    LAS float* t32 = (LAS float*)(F.lds + 102400 + 8192);
    LAS unsigned* kmx = (LAS unsigned*)(F.lds + 102400 + 8192 + 4096);
    for (int i = tid; i < 64 * 16; i += NWAVES * 64) { const int pos = i >> 4, f = i & 15; const float inv = exp2f(-(float)f * (13.287712379549449f / 16.0f)); const float a = (float)pos * inv; t64[2 * i] = cosf(a); t64[2 * i + 1] = sinf(a); }
    for (int i = tid; i < 64 * 8; i += NWAVES * 64) { const int pos = i >> 3, f = i & 7; const float inv = exp2f(-(float)f * (13.287712379549449f / 8.0f)); const float a = (float)pos * inv; t32[2 * i] = cosf(a); t32[2 * i + 1] = sinf(a); }
    if (tid < 16) kmx[tid] = 0u;
    __syncthreads();
    bf16* P = WSP(bf16, WS_P); bf16* VT = WSP(bf16, WS_VT);
    for (int ps = 0; ps < 3; ++ps) {
        const int base = F.vcu * 136 + 64 * ps, nch = ps < 2 ? 8 : 1;
        const int lane = lane_id(), sub = lane & 7, sg = lane >> 3;
        float g0[8], g1[8];
#pragma unroll
        for (int e = 0; e < 8; ++e) { g0[e] = A.in[I_QKG][l * 128 + 8 * sub + e]; g1[e] = A.in[I_QKG][l * 128 + 64 + 8 * sub + e]; }
        float km0 = 0.f, km2 = 0.f, km3 = 0.f, km4 = 0.f;
        if (ps < 2) {
#pragma unroll 2
            for (int tk = 0; tk < 8; ++tk) {
                const int tl = wave * 8 + tk, m = base + tl, t = m % T;
                const bool lat = t >= CTX; const int sp = t - CTX;
                pp_token(P + (size_t)m * INW, lat, sp >> 6, sp & 63, lane, tl, t64, t32, vt, g0, g1, km0, km2, km3, km4);
            }
        } else {
            const int tl = wave, m = base + tl, t = m % T;
            const bool lat = t >= CTX; const int sp = t - CTX;
            pp_token(P + (size_t)m * INW, lat, sp >> 6, sp & 63, lane, tl, t64, t32, vt, g0, g1, km0, km2, km3, km4);
        }
        if (sg >= 4 && (sub & 3) == 0) __hip_atomic_fetch_max(kmx + 2 * (sg - 4) + (sub >> 2), __builtin_bit_cast(unsigned, km0), __ATOMIC_RELAXED, __HIP_MEMORY_SCOPE_WORKGROUP);
        if (sub == 0) { if (sg < 2) __hip_atomic_fetch_max(kmx + 8 + sg, __builtin_bit_cast(unsigned, km2), __ATOMIC_RELAXED, __HIP_MEMORY_SCOPE_WORKGROUP);
                        if (sg < 4) __hip_atomic_fetch_max(kmx + 10 + sg, __builtin_bit_cast(unsigned, km3), __ATOMIC_RELAXED, __HIP_MEMORY_SCOPE_WORKGROUP);
                        if (sg == 4 || sg == 5) __hip_atomic_fetch_max(kmx + 14 + (sg - 4), __builtin_bit_cast(unsigned, km4), __ATOMIC_RELAXED, __HIP_MEMORY_SCOPE_WORKGROUP); }
        const int b = base / T, t0 = base % T;
        __syncthreads();
        for (int idx = tid; idx < 768 * nch; idx += NWAVES * 64) { const int row = ps < 2 ? idx >> 3 : idx, ch = ps < 2 ? idx & 7 : 0;
            const LAS unsigned* sp = (const LAS unsigned*)((const LAS unsigned char*)vt + row * 132 + ch * 16);
            v4u w; w.x = sp[0]; w.y = sp[1]; w.z = sp[2]; w.w = sp[3];
            *(GAS v4u*)(VT + ((size_t)b * 768 + row) * T + t0 + ch * 8) = w; }
        __syncthreads();
    }
    if (tid < 16) { unsigned* gp = F.ctl + CW_KMAX + (l * NB + (F.vcu * 136) / T) * 16 + tid; const unsigned mine = kmx[tid];
        if (mine > __hip_atomic_load(gp, RLX_AGENT)) __hip_atomic_fetch_max(gp, mine, RLX_AGENT); }
}

namespace att {
typedef float f32x16 __attribute__((ext_vector_type(16)));
constexpr float CAT_SCALE = 8.0f;
constexpr int NSLOT = 6, K_RING = 0, V_RING = NSLOT * 8192, RPB_OFF = 2 * NSLOT * 8192, UW_OFF = RPB_OFF + 2048, ZB_OFF = RPB_OFF + 2304;
__device__ __forceinline__ int swap23(int r) { return (r & ~12) | ((r & 4) << 1) | ((r & 8) >> 1); }
__device__ __forceinline__ bf16x8 pack8(const f32x16& p, int base) {
    v4u w; w.x = pg8::cvt_pk_bf16(p[base + 0], p[base + 1]); w.y = pg8::cvt_pk_bf16(p[base + 2], p[base + 3]); w.z = pg8::cvt_pk_bf16(p[base + 4], p[base + 5]); w.w = pg8::cvt_pk_bf16(p[base + 6], p[base + 7]);
    return __builtin_bit_cast(bf16x8, w);
}
__device__ __forceinline__ float sumsq8(bf16x8 q) { const v4u w = __builtin_bit_cast(v4u, q); float s = 0.f;
    s += bflo(w.x) * bflo(w.x) + bfhi(w.x) * bfhi(w.x) + bflo(w.y) * bflo(w.y) + bfhi(w.y) * bfhi(w.y) + bflo(w.z) * bflo(w.z) + bfhi(w.z) * bfhi(w.z) + bflo(w.w) * bflo(w.w) + bfhi(w.w) * bfhi(w.w); return s; }

template <bool SHIFT>
__device__ __forceinline__ void sm_chunk(f32x16& pc, int c, float negm, float& ps, bf16x8 (&pq)[2]) {
#pragma unroll
    for (int j = 4 * c; j < 4 * c + 4; ++j) { float x = pc[j]; if (SHIFT) x += negm; pc[j] = __builtin_amdgcn_exp2f(x); }
    ps += (pc[4 * c] + pc[4 * c + 1]) + (pc[4 * c + 2] + pc[4 * c + 3]); asm volatile("" : "+v"(ps));
    if (c == 1) pq[0] = pack8(pc, 0);
    if (c == 3) pq[1] = pack8(pc, 8);
}
template <int NK>
__device__ __forceinline__ void mf_qk(f32x16& pn, const bf16x8 (&kf)[NK], const bf16x8 (&qfq)[NK], int kk) {
    if (kk == 0) { f32x16 z;
#pragma unroll
        for (int j = 0; j < 16; ++j) z[j] = 0.f;
        pn = __builtin_amdgcn_mfma_f32_32x32x16_bf16(kf[0], qfq[0], z, 0, 0, 0); }
    else pn = __builtin_amdgcn_mfma_f32_32x32x16_bf16(kf[kk], qfq[kk], pn, 0, 0, 0);
}
__device__ __forceinline__ void mf_pv(f32x16 (&Oq)[2], const bf16x8 (&vf)[2][2], const bf16x8 (&pp)[2], int pv) { const int s2 = pv >> 1, dvb = pv & 1;
    Oq[dvb] = __builtin_amdgcn_mfma_f32_32x32x16_bf16(vf[dvb][s2], pp[s2], Oq[dvb], 0, 0, 0); }
template <int NK>
__device__ __forceinline__ void attn_pro(const LAS unsigned char* k0, const int (&kofs)[NK], const bf16x8 (&qf)[2][NK], f32x16& pn, bf16x8 (&pp)[2], bf16x8 (&kf)[NK], bf16x8 (&vf)[2][2]) {
#pragma unroll
    for (int kk = 0; kk < NK; ++kk) kf[kk] = *(const LAS bf16x8*)(k0 + kofs[kk]);
    const bf16x8 zb = __builtin_bit_cast(bf16x8, (v4u){0u, 0u, 0u, 0u});
    pp[0] = zb; pp[1] = zb; vf[0][0] = zb; vf[0][1] = zb; vf[1][0] = zb; vf[1][1] = zb;
    __builtin_amdgcn_sched_barrier(0);
#pragma unroll
    for (int kk = 0; kk < NK; ++kk) mf_qk<NK>(pn, kf, qf[0], kk);
    __builtin_amdgcn_sched_barrier(0);
}
template <int NK, bool SHIFT>
__device__ __forceinline__ void attn_r06(const LAS unsigned char* k0, const LAS unsigned char* v0, const int (&kofs)[NK], const int (&vofs)[4], const bf16x8 (&qf)[2][NK], const float (&negM)[2], f32x16 (&O)[2][2],
                                         f32x16& pn, bf16x8 (&pp)[2], bf16x8 (&kf)[NK], bf16x8 (&vf)[2][2], float (&ps)[2]) {
#pragma unroll
    for (int it = 0; it < 7; ++it) {
        const int q = it & 1, qn = (it + 1) & 1, qp = (it - 1) & 1;
        f32x16 pc = pn; bf16x8 pq[2];
        if (it & 1) {
            const LAS unsigned char* kn = k0 + 8192 * ((it + 1) >> 2) + 4096 * (((it + 1) >> 1) & 1);
#pragma unroll
            for (int kk = 0; kk < NK; ++kk) kf[kk] = *(const LAS bf16x8*)(kn + kofs[kk]);
            const LAS unsigned char* vp = v0 + 8192 * ((it - 1) >> 2); const int sp = 2 * (((it - 1) >> 1) & 1);
#pragma unroll
            for (int dvb = 0; dvb < 2; ++dvb)
#pragma unroll
                for (int s2 = 0; s2 < 2; ++s2) vf[dvb][s2] = *(const LAS bf16x8*)(vp + dvb * 4096 + vofs[sp + s2]);
        }
        __builtin_amdgcn_sched_barrier(0);
        constexpr int M = NK + 4;
#pragma unroll
        for (int c = 0; c < 4; ++c) {
            sm_chunk<SHIFT>(pc, c, negM[q], ps[q], pq);
            __builtin_amdgcn_sched_barrier(0);
#pragma unroll
            for (int m = (c * M) / 4; m < ((c + 1) * M) / 4; ++m) {
                int kq = -1, pv = -1;
                if (NK == 2) { if (m % 3 == 0) kq = m / 3; else pv = (m / 3) * 2 + (m % 3) - 1; } else { if ((m & 1) == 0) kq = m >> 1; else pv = m >> 1; }
                if (kq >= 0) mf_qk<NK>(pn, kf, qf[qn], kq); else mf_pv(O[qp], vf, pp, pv);
            }
            __builtin_amdgcn_sched_barrier(0);
        }
        pp[0] = pq[0]; pp[1] = pq[1];
    }
}
template <bool SHIFT>
__device__ __forceinline__ void attn_r7a(const LAS unsigned char* v0, const int (&vofs)[4], const float (&negM)[2], f32x16 (&O)[2][2],
                                         const f32x16& pn, f32x16& pc, const bf16x8 (&pp)[2], bf16x8 (&pq)[2], bf16x8 (&vf)[2][2], float (&ps)[2]) {
    pc = pn;
#pragma unroll
    for (int dvb = 0; dvb < 2; ++dvb)
#pragma unroll
        for (int s2 = 0; s2 < 2; ++s2) vf[dvb][s2] = *(const LAS bf16x8*)(v0 + 8192 + dvb * 4096 + vofs[2 + s2]);
    __builtin_amdgcn_sched_barrier(0);
    sm_chunk<SHIFT>(pc, 0, negM[1], ps[1], pq);
    __builtin_amdgcn_sched_barrier(0);
    mf_pv(O[0], vf, pp, 0);
    __builtin_amdgcn_sched_barrier(0);
    asm volatile("s_waitcnt lgkmcnt(0)" ::: "memory");
}
template <int NK, bool SHIFT>
__device__ __forceinline__ void attn_r7b(const LAS unsigned char* kn, const int (&kofs)[NK], const bf16x8 (&qf)[2][NK], const float (&negM)[2], f32x16 (&O)[2][2],
                                         f32x16& pn, f32x16& pc, bf16x8 (&pp)[2], bf16x8 (&pq)[2], bf16x8 (&kf)[NK], const bf16x8 (&vf)[2][2], float (&ps)[2]) {
#pragma unroll
    for (int kk = 0; kk < NK; ++kk) kf[kk] = *(const LAS bf16x8*)(kn + kofs[kk]);
    __builtin_amdgcn_sched_barrier(0);
    sm_chunk<SHIFT>(pc, 1, negM[1], ps[1], pq);
    __builtin_amdgcn_sched_barrier(0);
    mf_pv(O[0], vf, pp, 1); if (NK == 4) mf_qk<NK>(pn, kf, qf[0], 0);
    __builtin_amdgcn_sched_barrier(0);
    sm_chunk<SHIFT>(pc, 2, negM[1], ps[1], pq);
    __builtin_amdgcn_sched_barrier(0);
    if (NK == 4) { mf_qk<NK>(pn, kf, qf[0], 1); mf_qk<NK>(pn, kf, qf[0], 2); } else { mf_qk<NK>(pn, kf, qf[0], 0); mf_qk<NK>(pn, kf, qf[0], 1); }
    __builtin_amdgcn_sched_barrier(0);
    sm_chunk<SHIFT>(pc, 3, negM[1], ps[1], pq);
    __builtin_amdgcn_sched_barrier(0);
    if (NK == 4) mf_qk<NK>(pn, kf, qf[0], 3);
    mf_pv(O[0], vf, pp, 2); mf_pv(O[0], vf, pp, 3);
    __builtin_amdgcn_sched_barrier(0);
    pp[0] = pq[0]; pp[1] = pq[1];
}

template <int MSK>
__device__ __forceinline__ void sm_chunk_m(LAS unsigned char* lds, f32x16& pc, int c, int kbk, int q, float negm, float& ps, bf16x8 (&pq)[2], int ma, int mb, unsigned lim, bool nbr) {
    const bool dead = MSK != 0 && nbr && ((q == 0 && kbk == 1 && c >= 2) || (q == 1 && kbk == 0 && c < 2));
#pragma unroll
    for (int i = 0; i < 4; ++i) { const int j = 4 * c + i, C = 16 * (c >> 1) + 4 * (c & 1) + i + 32 * kbk;
        if (dead) pc[j] = 0.f;
        else if (MSK == 0) pc[j] = __builtin_amdgcn_exp2f(pc[j] + negm);
        else { const float x = pc[j] + negm + *(const LAS float*)(lds + mb + 4 * C);
            const float e = __builtin_amdgcn_exp2f(x);
            pc[j] = ((unsigned)(ma + C) <= lim) ? e : 0.f; } }
    if (!dead) ps += (pc[4 * c] + pc[4 * c + 1]) + (pc[4 * c + 2] + pc[4 * c + 3]); asm volatile("" : "+v"(ps));
    if (c == 1) pq[0] = pack8(pc, 0);
    if (c == 3) pq[1] = pack8(pc, 8);
}
template <int MSK>
__device__ __forceinline__ void attn_tile_m(LAS unsigned char* lds, const LAS unsigned char* kb, const LAS unsigned char* vb, const int (&kofs)[4], const int (&vofs)[4], const bf16x8 (&qf)[2][4], const float (&negM)[2],
                                            f32x16 (&O)[2][2], float (&lsum)[2], const int (&ma)[2], const int (&mb)[2], unsigned lim, bool nbr) {
    f32x16 pn; bf16x8 pp[2], kf[4], vf[2][2];
#pragma unroll
    for (int kk = 0; kk < 4; ++kk) kf[kk] = *(const LAS bf16x8*)(kb + kofs[kk]);
    __builtin_amdgcn_sched_barrier(0);
#pragma unroll
    for (int kk = 0; kk < 4; ++kk) mf_qk<4>(pn, kf, qf[0], kk);
    __builtin_amdgcn_sched_barrier(0);
    float ps[2] = {0.f, 0.f};
#pragma unroll
    for (int it = 0; it < 4; ++it) {
        const int kbk = it >> 1, q = it & 1, qn = (it + 1) & 1, qp = (it - 1) & 1;
        f32x16 pc = pn; bf16x8 pq[2];
        if (it == 1) {
#pragma unroll
            for (int kk = 0; kk < 4; ++kk) kf[kk] = *(const LAS bf16x8*)(kb + 4096 + kofs[kk]); }
        if (it & 1) {
#pragma unroll
            for (int dvb = 0; dvb < 2; ++dvb)
#pragma unroll
                for (int s2 = 0; s2 < 2; ++s2) vf[dvb][s2] = *(const LAS bf16x8*)(vb + dvb * 4096 + vofs[(it == 3 ? 2 : 0) + s2]); }
        __builtin_amdgcn_sched_barrier(0);
        const bool hasq = it < 3, hasp = it >= 1; const int M = (hasq ? 4 : 0) + (hasp ? 4 : 0);
#pragma unroll
        for (int c = 0; c < 4; ++c) {
            sm_chunk_m<MSK>(lds, pc, c, kbk, q, negM[q], ps[q], pq, ma[q], mb[q], lim, nbr);
            __builtin_amdgcn_sched_barrier(0);
#pragma unroll
            for (int m = (c * M) / 4; m < ((c + 1) * M) / 4; ++m) {
                int kq = -1, pv = -1;
                if (hasq && hasp) { if ((m & 1) == 0) kq = m >> 1; else pv = m >> 1; } else if (hasq) kq = m; else pv = m;
                if (kq >= 0) mf_qk<4>(pn, kf, qf[qn], kq); else mf_pv(O[qp], vf, pp, pv);
            }
            __builtin_amdgcn_sched_barrier(0);
        }
        pp[0] = pq[0]; pp[1] = pq[1];
    }
#pragma unroll
    for (int pv = 0; pv < 4; ++pv) mf_pv(O[1], vf, pp, pv);
    __builtin_amdgcn_sched_barrier(0);
    lsum[0] += ps[0]; lsum[1] += ps[1];
}

template <bool DIFF>
__device__ __forceinline__ void unit(const Args& A, Frame& F, int l, int mode, int b, int hk, int qblk, bool is_ctx, float lam, float lam_init) {
    const int wave = F.wave, lane = lane_id(), r = lane & 31, h = lane >> 5;
    LAS unsigned char* lds = F.lds;
    const bf16* P = WSP(bf16, WS_P); const bf16* VT = WSP(bf16, WS_VT);
    const bool gqa = (mode & 1) != 0;
    const int mp = DIFF ? (wave >> 2) : 0;
    const int head = gqa ? 2 * hk + (wave >> 2) : hk;
    const bool wave_on = !(mode == 2 && is_ctx && wave >= 4);
    const int pos0w = (mode == 2 && !is_ctx) ? qblk * 512 + 64 * wave : qblk * 256 + 64 * (wave & 3);
    const int qcol = mode == 0 ? 64 * head + 32 * mp : (mode == 1 ? 768 + 64 * head : (mode == 2 ? 1280 + 64 * head : 2048 + 64 * head));
    const int kcol = mode == 0 ? 256 + 64 * hk : (mode == 1 ? 1024 + 64 * hk : (mode == 2 ? 1536 + 64 * hk : 2304 + 64 * hk));
    const int vh = mode == 0 ? hk : (mode == 1 ? 4 + hk : (mode == 2 ? 6 + hk : 10 + hk));
    const int kid = mode == 0 ? 2 * hk + mp : (mode == 1 ? 8 + hk : (mode == 2 ? 10 + hk : 14 + hk));
    const int ocol = mode * 256 + 64 * head;
    constexpr int NK = DIFF ? 2 : 4;
    size_t mq[2];
    bf16x8 qf[2][NK];
#pragma unroll
    for (int qb = 0; qb < 2; ++qb) { const int pos = pos0w + 32 * qb + r; mq[qb] = (size_t)b * T + (is_ctx ? pos : CTX + pos);
#pragma unroll
        for (int kk = 0; kk < NK; ++kk) qf[qb][kk] = *(const bf16x8*)(P + mq[qb] * INW + qcol + 16 * kk + 8 * h); }
#pragma unroll
    for (int qb = 0; qb < 2; ++qb) {
        const int pos = pos0w + 32 * qb + r, grow = pos >> 6, gcol = pos & 63;
        float x[NK][8];
#pragma unroll
        for (int kk = 0; kk < NK; ++kk) unpack8(__builtin_bit_cast(v4u, qf[qb][kk]), x[kk]);
        if (!DIFF && mode == 1) {
            float ss = 0.f;
#pragma unroll
            for (int kk = 0; kk < NK; ++kk)
#pragma unroll
                for (int e = 0; e < 8; ++e) ss += x[kk][e] * x[kk][e];
            ss = sum32(ss);
            const float rs = 1.0f / sqrtf(ss * (1.0f / 64.0f) + EPS);
#pragma unroll
            for (int kk = 0; kk < NK; ++kk)
#pragma unroll
                for (int e = 0; e < 8; ++e) x[kk][e] *= rs * A.in[I_QKG][l * 128 + 16 * kk + 8 * h + e];
        }
        if (!is_ctx && mode != 2) {
            if (DIFF) {
#pragma unroll
                for (int kk = 0; kk < 2; ++kk) { const float pv = (float)(kk ? gcol : grow);
#pragma unroll
                    for (int e = 0; e < 8; ++e) { const float a = pv * exp2f(-(float)e * (13.287712379549449f / 8.0f)); const float c = __cosf(a), sn = __sinf(a);
                        const float pr = other32(x[kk][e], false); x[kk][e] = h ? x[kk][e] * c + pr * sn : x[kk][e] * c - pr * sn; } }
            } else {
#pragma unroll
                for (int hf = 0; hf < 2; ++hf) { const float pv = (float)(hf ? gcol : grow);
#pragma unroll
                    for (int e = 0; e < 8; ++e) { const float a = pv * exp2f(-(float)(8 * h + e) * (13.287712379549449f / 16.0f)); const float c = __cosf(a), sn = __sinf(a);
                        const float x1 = x[(2 * hf) % NK][e], x2 = x[(2 * hf + 1) % NK][e]; x[(2 * hf) % NK][e] = x1 * c - x2 * sn; x[(2 * hf + 1) % NK][e] = x2 * c + x1 * sn; } }
            }
        }
        const float qsc = DIFF ? QS32 : QS64;
#pragma unroll
        for (int kk = 0; kk < NK; ++kk) {
#pragma unroll
            for (int e = 0; e < 8; ++e) x[kk][e] *= qsc;
            qf[qb][kk] = __builtin_bit_cast(bf16x8, pack8f(x[kk])); }
    }
    const unsigned* km = F.ctl + CW_KMAX + (l * NB + b) * 16;
    float bias_max = 0.f;
    LAS float* rpbL = (LAS float*)(lds + RPB_OFF);
    if (!DIFF && wave == 0) ((LAS float*)(lds + ZB_OFF))[lane] = 0.f;
    if (mode == 2 && !is_ctx) {
        const float* rp = A.in[I_RPB] + (size_t)(l * 4 + hk) * 465;
        for (int i = wave * 64 + lane; i < 465; i += NWAVES * 64) { const float v = rp[i] * LOG2E; rpbL[(i / 31) * 32 + (i % 31)] = v; }
        float mx = 0.f; for (int i = lane; i < 465; i += 64) mx = fmaxf(mx, fabsf(rp[i]) * LOG2E);
        mx = fmaxf(mx, sx<1>(mx)); mx = fmaxf(mx, sx<2>(mx)); mx = fmaxf(mx, sx<4>(mx)); mx = fmaxf(mx, sx<8>(mx)); mx = fmaxf(mx, sx<16>(mx)); mx = max32(mx);
        bias_max = mx;
    }
    const float kmx = __builtin_bit_cast(float, __hip_atomic_load(km + kid, RLX_AGENT));
    float negM[2];
#pragma unroll
    for (int qb = 0; qb < 2; ++qb) { float s0 = 0.f;
#pragma unroll
        for (int kk = 0; kk < NK; ++kk) s0 += sumsq8(qf[qb][kk]);
        s0 = sum32(s0); negM[qb] = -(sqrtf(s0 * kmx) * 1.0001f + bias_max); }
    const bool shift = __any((negM[0] < -96.f) || (negM[1] < -96.f)) != 0;
    if (!shift) { negM[0] = 0.f; negM[1] = 0.f; }
    int lt0 = 0, lt1 = 0;
    if (!is_ctx) {
        if (mode <= 1) { lt0 = 4; lt1 = 68; }
        else if (mode == 2) { const int R = 8 * qblk; lt0 = 4 + min(max(R - 4, 0), 56); lt1 = 4 + min(max(R + 7 - 4, 0), 56) + 8; }
        else { const int s0 = qblk * 256; lt0 = 4 + max(0, (s0 - 128) >> 6); lt1 = 4 + min(63, (s0 + 255 + 128) >> 6) + 1; }
    }
    const int ntiles = 4 + (lt1 - lt0);
    const int pidx = wave * 64 + lane, rho = pidx >> 3, cch = (pidx & 7) ^ ((rho >> 1) & 7);
    const char* kbase = (const char*)(P + (size_t)b * T * INW + kcol);
    const char* vbase = (const char*)(VT + ((size_t)b * 12 + vh) * 64 * T);
    const unsigned koff = (unsigned)(rho * INW + cch * 8) * 2u, voff = (unsigned)(rho * T + cch * 8) * 2u;
#define ATT_ISSUE(ti_) ATT_ISSUE_AT(min((int)(ti_), ntiles - 1), (ti_) % NSLOT)
#define ATT_ISSUE_AT(ti_, bufi_) do { const int kt_ = (ti_) < 4 ? (ti_) : lt0 + (ti_) - 4; const int bf_ = (bufi_); \
        pg8::glds16s(kbase + (size_t)kt_ * (64 * INW * 2), koff, (unsigned)(size_t)(lds + K_RING + bf_ * 8192 + wave * 1024)); \
        pg8::glds16s(vbase + (size_t)kt_ * 128, voff, (unsigned)(size_t)(lds + V_RING + bf_ * 8192 + wave * 1024)); } while (0)
    const int xk = swap23(r), gk = (xk >> 1) & 7, gv = (r >> 1) & 7;
    int kofs[NK], vofs[4];
#pragma unroll
    for (int i = 0; i < NK; ++i) kofs[i] = xk * 128 + (((2 * (i + NK * mp) + h) ^ gk) << 4);
#pragma unroll
    for (int i = 0; i < 4; ++i) vofs[i] = r * 128 + (((2 * i + h) ^ gv) << 4);
    const int rw = pos0w >> 6, r0w = min(max(rw - 4, 0), 56);
    f32x16 O[2][2];
#pragma unroll
    for (int qb = 0; qb < 2; ++qb)
#pragma unroll
        for (int i = 0; i < 2; ++i)
#pragma unroll
            for (int j = 0; j < 16; ++j) O[qb][i][j] = 0.f;
    float lsum[2] = {0.f, 0.f};
    ATT_ISSUE(0); ATT_ISSUE(1); ATT_ISSUE(2); ATT_ISSUE(3);
    const int npairs = (ntiles + 1) >> 1;
    if (DIFF || mode == 1) {
#define PIPE_LOOP(SH_) { f32x16 pn_; bf16x8 pp_[2], kf_[NK], vf_[2][2]; float ps_[2] = {0.f, 0.f}; \
        asm volatile("s_waitcnt vmcnt(4)" ::: "memory"); __builtin_amdgcn_s_barrier(); asm volatile("" ::: "memory"); \
        ATT_ISSUE(4); ATT_ISSUE(5); \
        attn_pro<NK>(lds + K_RING, kofs, qf, pn_, pp_, kf_, vf_); \
        _Pragma("clang loop unroll(disable)") for (int tp = 0; tp < npairs; ++tp) { \
            const int b0_ = (2 * tp) % NSLOT; const LAS unsigned char* k0_ = lds + K_RING + b0_ * 8192; const LAS unsigned char* v0_ = lds + V_RING + b0_ * 8192; \
            f32x16 pc_; bf16x8 pq_[2]; \
            attn_r06<NK, SH_>(k0_, v0_, kofs, vofs, qf, negM, O, pn_, pp_, kf_, vf_, ps_); \
            attn_r7a<SH_>(v0_, vofs, negM, O, pn_, pc_, pp_, pq_, vf_, ps_); \
            asm volatile("s_waitcnt vmcnt(4)" ::: "memory"); __builtin_amdgcn_s_barrier(); asm volatile("" ::: "memory");     \
            ATT_ISSUE(2 * tp + 6); ATT_ISSUE(2 * tp + 7); \
            attn_r7b<NK, SH_>(lds + K_RING + ((2 * tp + 2) % NSLOT) * 8192, kofs, qf, negM, O, pn_, pc_, pp_, pq_, kf_, vf_, ps_); } \
        _Pragma("unroll") for (int pv_ = 0; pv_ < 4; ++pv_) mf_pv(O[1], vf_, pp_, pv_);     \
        __builtin_amdgcn_sched_barrier(0); lsum[0] += ps_[0]; lsum[1] += ps_[1]; }
        if (shift) PIPE_LOOP(true) else PIPE_LOOP(false)
#undef PIPE_LOOP
    } else if constexpr (!DIFF) {
#define MASK_LOOP(TP0_, TP1_, MT_) _Pragma("clang loop unroll(disable)") for (int tp = (TP0_); tp < (TP1_); ++tp) { \
        asm volatile("s_waitcnt vmcnt(4)" ::: "memory"); __builtin_amdgcn_s_barrier(); asm volatile("" ::: "memory"); \
        ATT_ISSUE(2 * tp + 4); ATT_ISSUE(2 * tp + 5); \
        _Pragma("clang loop unroll(disable)") for (int sub = 0; sub < 2; ++sub) { \
            const int ti = 2 * tp + sub; if (ti >= ntiles) break; \
            const int kt = ti < 4 ? ti : lt0 + ti - 4, bf = ti % NSLOT; const bool latt = ti >= 4; \
            bool active = wave_on; int msk = 0; \
            if (latt && mode == 2) { const int kr = kt - 4; active = active && (kr >= r0w) && (kr < r0w + 8); msk = 2; } \
            if (latt && mode == 3) { const int k0 = 64 * (kt - 4); active = (k0 + 63 >= pos0w - 128) && (k0 <= pos0w + 63 + 128); msk = ((k0 >= pos0w + 63 - 128) && (k0 + 63 <= pos0w + 128)) ? 0 : 3; } \
            if (!active) continue; \
            const LAS unsigned char* kb = lds + K_RING + bf * 8192; const LAS unsigned char* vb = lds + V_RING + bf * 8192; \
            int r_ = r, h_ = h; asm volatile("" : "+v"(r_), "+v"(h_)); \
            int ma[2] = {0, 0}, mb[2] = {ZB_OFF, ZB_OFF}; unsigned lim = 0xffffffffu; \
            if (msk == 2) { lim = 15u; const int brow_i = (kt - 4 - rw + 7) * 32; \
                _Pragma("unroll") for (int qb = 0; qb < 2; ++qb) { const int cq = 32 * qb + r_, c0 = min(max(cq - 8, 0), 48); ma[qb] = 8 * h_ - c0; mb[qb] = RPB_OFF + (brow_i + 8 * h_ - cq + 15) * 4; } } \
            else if (msk == 3) { lim = 256u; \
                _Pragma("unroll") for (int qb = 0; qb < 2; ++qb) ma[qb] = 64 * (kt - 4) - (pos0w + 32 * qb + r_) + 8 * h_ + 128; } \
            attn_tile_m<MT_>(lds, kb, vb, kofs, vofs, qf, negM, O, lsum, ma, mb, lim, msk == 2); } }
        MASK_LOOP(0, min(2, npairs), 0)
        MASK_LOOP(2, npairs, 1)
#undef MASK_LOOP
    }
#undef ATT_ISSUE
#undef ATT_ISSUE_AT
    asm volatile("s_waitcnt vmcnt(0)" ::: "memory");
    float linv[2];
#pragma unroll
    for (int qb = 0; qb < 2; ++qb) { float lq = sum32(lsum[qb]);
        if (mode == 3) lq += __builtin_amdgcn_exp2f(A.in[I_SINK][l * 4 + head] * LOG2E + negM[qb]);
        linv[qb] = 1.0f / lq; }
    if (DIFF) {
        LAS float* xch = (LAS float*)lds + (wave & 3) * 4096;
        __syncthreads();
        if (wave >= 4) {
#pragma unroll
            for (int qb = 0; qb < 2; ++qb)
#pragma unroll
                for (int dvb = 0; dvb < 2; ++dvb)
#pragma unroll
                    for (int j = 0; j < 16; ++j) xch[((qb * 2 + dvb) * 16 + j) * 64 + lane] = O[qb][dvb][j] * (lam * linv[qb]);
        }
        __syncthreads();
        if (wave < 4) {
            const float* dg = A.in[I_DG] + l * 64;
#pragma unroll
            for (int qb = 0; qb < 2; ++qb) { float ss = 0.f;
#pragma unroll
                for (int dvb = 0; dvb < 2; ++dvb)
#pragma unroll
                    for (int j = 0; j < 16; ++j) { const float v = O[qb][dvb][j] * linv[qb] - xch[((qb * 2 + dvb) * 16 + j) * 64 + lane]; O[qb][dvb][j] = v; ss += v * v; }
                ss = sum32(ss);
                const float rs = (1.0f - lam_init) / sqrtf(ss * (1.0f / 64.0f) + EPS);
                unsigned char* orow = WSP(unsigned char, WS_CAT) + mq[qb] * D + ocol; const float rs8 = rs * CAT_SCALE;
#pragma unroll
                for (int dvb = 0; dvb < 2; ++dvb)
#pragma unroll
                    for (int g = 0; g < 4; ++g) { const int dv = 32 * dvb + 8 * g + 4 * h; const f32x4 gg = *(const f32x4*)(dg + dv);
                        *(unsigned*)(orow + dv) = pg8::cvt4_fp8(O[qb][dvb][4 * g] * rs8 * gg[0], O[qb][dvb][4 * g + 1] * rs8 * gg[1], O[qb][dvb][4 * g + 2] * rs8 * gg[2], O[qb][dvb][4 * g + 3] * rs8 * gg[3]); } }
        }
    } else if (wave_on) {
#pragma unroll
        for (int qb = 0; qb < 2; ++qb) { unsigned char* orow = WSP(unsigned char, WS_CAT) + mq[qb] * D + ocol; const float inv0 = linv[qb] * CAT_SCALE;
#pragma unroll
            for (int dvb = 0; dvb < 2; ++dvb)
#pragma unroll
                for (int g = 0; g < 4; ++g) { const int dv = 32 * dvb + 8 * g + 4 * h;
                    *(unsigned*)(orow + dv) = pg8::cvt4_fp8(O[qb][dvb][4 * g] * inv0, O[qb][dvb][4 * g + 1] * inv0, O[qb][dvb][4 * g + 2] * inv0, O[qb][dvb][4 * g + 3] * inv0); } }
    }
}
}

__device__ __forceinline__ void phase_attn(const Args& A, Frame& F, int l, int ctr_off = 0) {
    const int wave = F.wave, lane0 = lane_id();
    float lam_init = 0.8f - 0.6f * expf(-0.3f * (float)l);
    float lam;
    { const float* lf = A.in[I_DLAM] + l * 128; float a = 0.f, bq = 0.f; if (lane0 < 32) { a = lf[lane0] * lf[32 + lane0]; bq = lf[64 + lane0] * lf[96 + lane0]; }
      a = wave_sum(a); bq = wave_sum(bq); lam = expf(a) - expf(bq) + lam_init; }
    lam = __builtin_bit_cast(float, __builtin_amdgcn_readfirstlane(__builtin_bit_cast(int, lam))); lam_init = __builtin_bit_cast(float, __builtin_amdgcn_readfirstlane(__builtin_bit_cast(int, lam_init)));
    const bool conv = l < NL - 1;
    constexpr int NMIX = 608 + (CONV_UNITS - 128);
    const int NA = conv ? 1280 + 96 : 1280, NQ = conv ? 768 + 608 + CONV_UNITS : NA;
    unsigned* ctr = F.ctl + CW_WORK + 64 * l + ctr_off;
    volatile LAS int* uw = (volatile LAS int*)(F.lds + att::UW_OFF);
    for (;;) {
        if (wave == 0 && lane0 == 0) uw[0] = (int)__hip_atomic_fetch_add(ctr, 1u, RLX_AGENT);
        __syncthreads();
        const int uq = __builtin_amdgcn_readfirstlane(uw[0]);
        if (uq >= NQ) break;
        int u = uq;
        if (conv && uq >= 768) { const int v = uq - 768;
            const int a0 = v < NMIX ? (v * 608) / NMIX : 608, a1 = v < NMIX ? ((v + 1) * 608) / NMIX : 608;
            if (a1 == a0) {
                const int cu = v - a0; const int ln = lane_id(); const int r0 = 16 * cu + 2 * wave;
                const ConvItem c0 = conv_decode(A, F, l + 1, r0), c1 = conv_decode(A, F, l + 1, r0 + 1);
                float v0[64], v1[64]; conv_load(c0, ln, v0); conv_load(c1, ln, v1); conv_store(c0, ln, v0); conv_store(c1, ln, v1);
                continue; }
            u = 768 + a0; }
        int mode, b, hk, qblk; bool is_ctx = false;
        if (u < 512) { mode = 0; b = u >> 6; hk = (u >> 4) & 3; qblk = u & 15; }
        else if (u < 1280) { const int v = (u - 512) & 255; mode = 1 + ((u - 512) >> 8); b = v >> 5;
            if (mode == 2) { hk = (v >> 3) & 3; qblk = v & 7; } else { hk = (v >> 4) & 1; qblk = v & 15; } }
        else { int v = u - 1280; is_ctx = true; qblk = 0;
            if (v < 32) { mode = 0; b = v >> 2; hk = v & 3; } else if (v < 48) { v -= 32; mode = 1; b = v >> 1; hk = v & 1; }
            else if (v < 80) { v -= 48; mode = 2; b = v >> 2; hk = v & 3; } else { v -= 80; mode = 3; b = v >> 1; hk = v & 1; } }
        if (mode == 0) att::unit<true>(A, F, l, 0, b, hk, qblk, is_ctx, lam, lam_init);
        else att::unit<false>(A, F, l, mode, b, hk, qblk, is_ctx, lam, lam_init);
    }
}

__device__ __forceinline__ void router_pick(float (&acc)[32], int lane, const float* rb, LAS unsigned* lc, LAS int* ent, int m, float* rgate) {
#pragma unroll
    for (int i = 0; i < 16; ++i) { const bool hi = lane & 32; const float send = hi ? acc[i] : acc[i + 16], keep = hi ? acc[i + 16] : acc[i]; acc[i] = keep + other32(send, hi); }
#pragma unroll
    for (int i = 0; i < 8; ++i) { const bool hi = lane & 16; const float send = hi ? acc[i] : acc[i + 8], keep = hi ? acc[i + 8] : acc[i]; acc[i] = keep + other16(send); }
#pragma unroll
    for (int i = 0; i < 4; ++i) { const bool hi = lane & 8; const float send = hi ? acc[i] : acc[i + 4], keep = hi ? acc[i + 4] : acc[i]; acc[i] = keep + dppf<DPP_MIRROR>(send); }
#pragma unroll
    for (int i = 0; i < 2; ++i) { const bool hi = lane & 4; const float send = hi ? acc[i] : acc[i + 2], keep = hi ? acc[i + 2] : acc[i]; acc[i] = keep + dppf<DPP_HMIRROR>(send); }
    { const bool hi = lane & 2; const float send = hi ? acc[0] : acc[1], keep = hi ? acc[1] : acc[0]; acc[0] = keep + dppf<DPP_XOR2>(send); }
    const int my_e = lane >> 1;
    float logit = acc[0] + dppf<DPP_XOR1>(acc[0]) + rb[my_e];
    float tv[4]; int te[4];
#pragma unroll
    for (int k = 0; k < 4; ++k) {
        float bv = logit; int be = my_e;
#define AMX(ov_, oe_) do { const float ov = (ov_); const int oe = (oe_); const bool take = (ov > bv) || (ov == bv && oe < be); bv = take ? ov : bv; be = take ? oe : be; } while (0)
        AMX(dppf<DPP_XOR2>(bv), dppi<DPP_XOR2>(be)); AMX(dppf<DPP_HMIRROR>(bv), dppi<DPP_HMIRROR>(be)); AMX(dppf<DPP_MIRROR>(bv), dppi<DPP_MIRROR>(be));
        AMX(other16(bv), other16i(be)); AMX(other32(bv, false), other32i(be, false));
#undef AMX
        tv[k] = bv; te[k] = be; if (my_e == be) logit = -INFINITY;
    }
    const float e1 = __expf(tv[1] - tv[0]), e2 = __expf(tv[2] - tv[0]), e3 = __expf(tv[3] - tv[0]); const float inv = 1.0f / (1.0f + e1 + e2 + e3);
    if (lane < 4) { const int ee = lane == 0 ? te[0] : (lane == 1 ? te[1] : (lane == 2 ? te[2] : te[3])); const float gg = (lane == 0 ? 1.0f : (lane == 1 ? e1 : (lane == 2 ? e2 : e3))) * inv;
        const unsigned lp = __hip_atomic_fetch_add(lc + ee, 1u, __ATOMIC_RELAXED, __HIP_MEMORY_SCOPE_WORKGROUP);
        ent[2 * lane] = m * 4 + lane; ent[2 * lane + 1] = (int)((lp << 5) | (unsigned)ee); rgate[(size_t)m * 4 + lane] = gg; }
}
__device__ __forceinline__ void phase_post_out(const Args& A, Frame& F, int l) {
    const int wave = F.wave, lane0 = lane_id(), tid = wave * 64 + lane0;
    LAS unsigned char* wl = F.lds;
    LAS float* mv = (LAS float*)(F.lds + LDSCTL_OFF + 8192);
    const int wg = F.vcu, bq = (wg * 136) / T;
    { const float* rw = A.in[I_RW] + (size_t)l * D * NE;
      for (int idx = tid; idx < D * 8; idx += NWAVES * 64) { const int k = idx >> 3, c = idx & 7, ln = (k & 255) >> 2, j = k >> 8, i = k & 3, kap = (j * 4 + i) * 64 + ln;
          *(LAS f32x4*)(wl + kap * 128 + ((c ^ ((kap >> 1) & 7)) << 4)) = *(const GAS f32x4*)(rw + (size_t)k * NE + 4 * c); }
      const float* mod = WSP(float, WS_MOD); const float* n2 = A.in[I_N2G] + l * D;
      for (int idx = tid; idx < 2 * D; idx += NWAVES * 64) { const int st = idx >> 10, k = idx & 1023; const float* md = mod + (size_t)(l * 9 + (st ? bq : 8)) * 6144;
          mv[(st * 3 + 0) * D + k] = md[2048 + k]; mv[(st * 3 + 1) * D + k] = n2[k] * (1.0f + md[4096 + k]); mv[(st * 3 + 2) * D + k] = md[3072 + k]; } }
    LAS unsigned* lc = (LAS unsigned*)(F.lds + MOE_TAB_OFF);
    LAS int* ent = (LAS int*)(F.lds + MOE_IDX_OFF) + wave * 160;
    if (tid < 64) lc[tid] = 0u;
    __syncthreads();
    const float* rb = A.in[I_RB] + l * NE;
    unsigned* cnt = F.ctl + CW_CNT + 64 * l;
    int nrow = 0;
    const int mbase = wg * 136;
    Row xn0, xn1; v2u on0[4], on1[4];
#define PO_LOAD(pp_) do { const size_t m_ = (size_t)(mbase + 2 * (pp_)); const int lane0 = lane_id(); row_load_bf16(xn0, WSP(bf16, WS_X) + m_ * D, lane0); row_load_bf16(xn1, WSP(bf16, WS_X) + (m_ + 1) * D, lane0); \
        _Pragma("unroll") for (int j_ = 0; j_ < 4; ++j_) { on0[j_] = ((const GAS v2u*)(WSP(bf16, WS_O) + m_ * D))[lane0 + 64 * j_]; on1[j_] = ((const GAS v2u*)(WSP(bf16, WS_O) + (m_ + 1) * D))[lane0 + 64 * j_]; } } while (0)
    if (wave < 68) PO_LOAD(wave);
    for (int pp = wave; pp < 68; pp += NWAVES) {
        const int m0 = mbase + 2 * pp, t = m0 % T;
        Row x0 = xn0, x1 = xn1, o0, o1;
#pragma unroll
        for (int j = 0; j < 4; ++j) { o0.v[j] = (f32x4){bflo(on0[j].x), bfhi(on0[j].x), bflo(on0[j].y), bfhi(on0[j].y)}; o1.v[j] = (f32x4){bflo(on1[j].x), bfhi(on1[j].x), bflo(on1[j].y), bfhi(on1[j].y)}; }
        if (pp + NWAVES < 68) PO_LOAD(pp + NWAVES);
        if (l == NL - 1 && t < CTX) continue;
        const int lane = lane_id(), sw = (lane >> 1) & 7;
        const LAS float* ms = mv + (t < CTX ? 0 : 3 * D);
        bf16* xp = WSP(bf16, WS_X) + (size_t)m0 * D;
#pragma unroll
        for (int j = 0; j < 4; ++j) { const f32x4 g1 = ((const LAS f32x4*)ms)[lane + 64 * j]; x0.v[j] += g1 * o0.v[j]; x1.v[j] += g1 * o1.v[j]; }
        row_store_bf16(x0, xp, lane); row_store_bf16(x1, xp + D, lane);
        const float r0 = row_rstd(x0), r1 = row_rstd(x1);
#pragma unroll
        for (int j = 0; j < 4; ++j) { const f32x4 a2 = ((const LAS f32x4*)(ms + D))[lane + 64 * j], s2 = ((const LAS f32x4*)(ms + 2 * D))[lane + 64 * j];
            o0.v[j] = x0.v[j] * r0 * a2 + s2; o1.v[j] = x1.v[j] * r1 * a2 + s2; }
        { GAS unsigned* h8 = (GAS unsigned*)(WSP(unsigned char, WS_H8) + (size_t)m0 * D);
#pragma unroll
          for (int j = 0; j < 4; ++j) { h8[lane + 64 * j] = pg8::cvt4_fp8(o0.v[j][0], o0.v[j][1], o0.v[j][2], o0.v[j][3]); h8[256 + lane + 64 * j] = pg8::cvt4_fp8(o1.v[j][0], o1.v[j][1], o1.v[j][2], o1.v[j][3]); } }
#pragma unroll
        for (int rr = 0; rr < 2; ++rr) {
            __builtin_amdgcn_sched_barrier(0);
            float a0[32];
#pragma unroll
            for (int e = 0; e < 32; ++e) a0[e] = 0.f;
            {
                f32x4 wa[4], wb[4];
                const LAS unsigned char* wp0 = wl + lane * 128;
#pragma unroll
                for (int c = 0; c < 4; ++c) wa[c] = *(const LAS f32x4*)(wp0 + ((c ^ sw) << 4));
#pragma unroll
                for (int hs = 0; hs < 32; ++hs) {
                    const int st = hs >> 1, hf = hs & 1;
                    const float xa = rr ? o1.v[st >> 2][st & 3] : o0.v[st >> 2][st & 3];
                    if (hs + 1 < 32) { const int st1 = (hs + 1) >> 1, hf1 = (hs + 1) & 1;
#pragma unroll
                        for (int c = 0; c < 4; ++c) { const f32x4 t = *(const LAS f32x4*)(wp0 + st1 * 8192 + (((4 * hf1 + c) ^ sw) << 4)); if (hs & 1) wa[c] = t; else wb[c] = t; } }
                    __builtin_amdgcn_sched_barrier(0);
#pragma unroll
                    for (int c = 0; c < 4; ++c) { const f32x4 w4 = (hs & 1) ? wb[c] : wa[c];
#pragma unroll
                        for (int q = 0; q < 4; ++q) a0[16 * hf + 4 * c + q] += xa * w4[q]; }
                    __builtin_amdgcn_sched_barrier(0);
                } }
            router_pick(a0, lane, rb, lc, ent + 8 * nrow, m0 + rr, WSP(float, WS_RGATE)); ++nrow;
        }
    }
#undef PO_LOAD
    __syncthreads();
    if (tid < NE) lc[32 + tid] = __hip_atomic_fetch_add(cnt + tid, lc[tid], RLX_AGENT);
    __syncthreads();
    { const int lane = lane_id(); int* rinfo = WSP(int, WS_RINFO);
      for (int i = lane; i < 4 * nrow; i += 64) { const int info = ent[2 * i], pe = ent[2 * i + 1], e = pe & 31, lp = pe >> 5; rinfo[(size_t)e * M + lc[32 + e] + lp] = info; } }
}

__device__ __forceinline__ int moe_setup(Frame& F, int l, int nN, bool xcd_rows) {
    const int wave = F.wave, lane = lane_id(), tid = wave * 64 + lane;
    LAS int* tb = (LAS int*)(F.lds + MOE_TAB_OFF); LAS int* ut = (LAS int*)(F.lds + MOE_UT_OFF); LAS int* idx = (LAS int*)(F.lds + MOE_IDX_OFF);
    if (tid < NE) tb[40 + tid] = (int)__hip_atomic_load(F.ctl + CW_CNT + 64 * l + tid, RLX_AGENT);
    __syncthreads();
    if (tid == 0) { int acc = 0; for (int e = 0; e < NE; ++e) { tb[e] = acc; acc += (tb[40 + e] + 255) >> 8; } tb[NE] = acc; }
    __syncthreads();
    const int nblk = tb[NE], c = (int)blockIdx.x, G = F.G;
    const int xq = c & 7, jq = c >> 3, nbx = (nblk - xq + 7) >> 3;
    int n = xcd_rows ? ((nbx * nN > jq) ? (nbx * nN - jq + 31) / 32 : 0) : ((nblk * nN > c) ? (nblk * nN - c + G - 1) / G : 0);
    n = n > MOE_MAX_UNITS ? MOE_MAX_UNITS : n;
    const int* rinfo = WSP(int, WS_RINFO);
    for (int i = wave; i < n; i += NWAVES) {
        int blk, pn;
        if (xcd_rows) { const int U = i * 32 + jq; blk = (U / nN) * 8 + xq; pn = U % nN; } else { const int L = i * G + c; blk = L / nN; pn = L % nN; }
        int e = 0;
#pragma unroll 1
        for (int j = 1; j < NE; ++j) e += (tb[j] <= blk) ? 1 : 0;
        const int jb = blk - tb[e], ce = tb[40 + e];
        if (lane == 0) { ut[4 * i] = blk; ut[4 * i + 1] = pn; ut[4 * i + 2] = e; }
#pragma unroll
        for (int q = 0; q < 4; ++q) { const int R = q * 64 + lane, pos = jb * 256 + R; idx[i * 256 + R] = pos < ce ? rinfo[(size_t)e * M + pos] : -1; }
    }
    __syncthreads();
    return __builtin_amdgcn_readfirstlane(n);
}

__device__ __forceinline__ void phase_combine(const Args& A, Frame& F, int l) {
    const int wave = F.wave, lane = lane_id(), tid = wave * 64 + lane;
    LAS float* mv = (LAS float*)F.lds;
    const int wg = F.vcu, bq = (wg * 136) / T, mbase = wg * 136;
    { const float* mod = WSP(float, WS_MOD);
      for (int idx = tid; idx < 2 * D; idx += NWAVES * 64) { const int st = idx >> 10, k = idx & 1023; const int r = st ? bq : 8; const float* md = mod + (size_t)(l * 9 + r) * 6144;
          mv[(st * 3 + 0) * D + k] = md[5120 + k];
          if (l < NL - 1) { const float* md2 = md + 9 * 6144; mv[(st * 3 + 1) * D + k] = A.in[I_N1G][(l + 1) * D + k] * (1.0f + md2[1024 + k]); mv[(st * 3 + 2) * D + k] = md2[k]; }
          else { mv[(st * 3 + 1) * D + k] = A.in[I_FG][k]; mv[(st * 3 + 2) * D + k] = 0.f; } } }
    __syncthreads();
    for (int pp = wave; pp < 68; pp += NWAVES) {
        const int m0 = mbase + 2 * pp, t = m0 % T; if (l == NL - 1 && t < CTX) continue;
        const LAS float* ms = mv + (t < CTX ? 0 : 3 * D);
        bf16* xp = WSP(bf16, WS_X) + (size_t)m0 * D;
        Row x0, x1; row_load_bf16(x0, xp, lane); row_load_bf16(x1, xp + D, lane);
        const f32x4 gt0 = *(const GAS f32x4*)(WSP(float, WS_RGATE) + (size_t)m0 * 4), gt1 = *(const GAS f32x4*)(WSP(float, WS_RGATE) + (size_t)(m0 + 1) * 4);
        const unsigned char* Y = WSP(unsigned char, WS_YT) + (size_t)m0 * 4 * D;
        unsigned yv[8][4];
#pragma unroll
        for (int k = 0; k < 8; ++k)
#pragma unroll
            for (int j = 0; j < 4; ++j) yv[k][j] = ((const GAS unsigned*)(Y + (size_t)k * D))[lane + 64 * j];
        Row y0, y1;
#pragma unroll
        for (int j = 0; j < 4; ++j) { y0.v[j] = (f32x4){0.f, 0.f, 0.f, 0.f}; y1.v[j] = (f32x4){0.f, 0.f, 0.f, 0.f}; }
#pragma unroll
        for (int k = 0; k < 4; ++k)
#pragma unroll
            for (int j = 0; j < 4; ++j) { typedef float f32x2 __attribute__((ext_vector_type(2)));
                const f32x2 a0 = __builtin_amdgcn_cvt_pk_f32_fp8((int)yv[k][j], false), a1 = __builtin_amdgcn_cvt_pk_f32_fp8((int)yv[k][j], true);
                const f32x2 c0 = __builtin_amdgcn_cvt_pk_f32_fp8((int)yv[4 + k][j], false), c1 = __builtin_amdgcn_cvt_pk_f32_fp8((int)yv[4 + k][j], true);
                y0.v[j] += (f32x4){a0.x, a0.y, a1.x, a1.y} * (gt0[k] * 0.125f); y1.v[j] += (f32x4){c0.x, c0.y, c1.x, c1.y} * (gt1[k] * 0.125f); }
#pragma unroll
        for (int j = 0; j < 4; ++j) { const f32x4 g2 = ((const LAS f32x4*)ms)[lane + 64 * j]; x0.v[j] += g2 * y0.v[j]; x1.v[j] += g2 * y1.v[j]; }
        const float r0 = row_rstd(x0), r1 = row_rstd(x1);
        if (l < NL - 1) {
            row_store_bf16(x0, xp, lane); row_store_bf16(x1, xp + D, lane);
#pragma unroll
            for (int j = 0; j < 4; ++j) { const f32x4 a1 = ((const LAS f32x4*)(ms + D))[lane + 64 * j], s1 = ((const LAS f32x4*)(ms + 2 * D))[lane + 64 * j];
                y0.v[j] = x0.v[j] * r0 * a1 + s1; y1.v[j] = x1.v[j] * r1 * a1 + s1; }
            row_store_fp8(y0, WSP(unsigned char, WS_H) + (size_t)m0 * D, lane); row_store_fp8(y1, WSP(unsigned char, WS_H) + (size_t)(m0 + 1) * D, lane);
        } else {
            const int b = m0 / T;
            float* op = A.out + ((size_t)b * SEQ + (t - CTX)) * D;
#pragma unroll
            for (int j = 0; j < 4; ++j) { const f32x4 fg = ((const LAS f32x4*)(ms + D))[lane + 64 * j];
                ((GAS f32x4*)op)[lane + 64 * j] = x0.v[j] * r0 * fg; ((GAS f32x4*)(op + D))[lane + 64 * j] = x1.v[j] * r1 * fg; }
        }
    }
}

constexpr int PH_PER_LAYER = 8, N_PHASES = 2 + NL * PH_PER_LAYER;
__global__ void __launch_bounds__(NWAVES * 64, 2) fwd(Args A) {
    extern __shared__ __attribute__((aligned(16))) unsigned char lds_raw[];
    Frame F;
    F.lds = (LAS unsigned char*)lds_raw; F.ws = A.ws; F.ctl = (unsigned*)(A.ws + WS_CTL);
    F.wave = __builtin_amdgcn_readfirstlane((int)threadIdx.x >> 6);
    F.G = gridDim.x; { const int bx = blockIdx.x; F.vcu = (F.G % 8 == 0) ? (bx % 8) * (F.G / 8) + bx / 8 : bx; }
    for (int u = threadIdx.x; u < (LDS_BYTES - LDSCTL_OFF) / 4; u += NWAVES * 64) ((LAS unsigned*)(F.lds + LDSCTL_OFF))[u] = 0u;
    __syncthreads();
    const int lo = A.ph_lo, hi = A.ph_hi;
    XcdBarrier bar; bar.bar = F.ctl + CW_BAR; bar.x = 0; bar.st = nullptr; bar.wave = F.wave;
    if (hi - lo > 1) bar = xcd_barrier_post(F.ctl + CW_BAR, (volatile LAS unsigned*)(F.lds + MISC_OFF) + 8, F.wave);
#define IN(k) (lo <= (k) && (k) < hi)
#define SEAM(k) do { if (IN(k) && IN((k) + 1)) xcd_barrier(bar); } while (0)
    unsigned long long tacc = 0ull, tp0 = 0ull;
#define TPB(id) do { if (TPROBE == (id)) tp0 = __builtin_amdgcn_s_memrealtime(); } while (0)
#define TPE(id) do { if (TPROBE == (id)) tacc += __builtin_amdgcn_s_memrealtime() - tp0; } while (0)
    TPB(10);
    if (IN(0)) { TPB(0); phase_proA(A, F);
#if REP_MASK & 8
        xcd_barrier(bar); phase_proA(A, F);
#endif
        SEAM(0); TPE(0); }
    if (IN(1)) { TPB(1); phase_proB(A, F); SEAM(1); TPE(1); }
    for (int l = 0; l < NL; ++l) {
        F.ws = opq(F.ws); F.ctl = opq(F.ctl); asm volatile("" : "+s"(F.wave), "+s"(F.vcu), "+s"(F.G));
        const int pb = 2 + PH_PER_LAYER * l;
        if (IN(pb + 0)) { TPB(2);
            pg8::Gemm g{(const bf16*)WSP(unsigned char, WS_H), (const bf16*)(WSP(unsigned char, WS_WIN) + (size_t)l * INW * D), D / 2}; pg8::StaticOrder S; S.init(M, INW, F.G, (int)blockIdx.x);
            pg8::EpiStore E{WSP(bf16, WS_P), INW, nullptr, 0, 1.0f / 64.0f};
            pg8::gemm_phase<pg8::EpiStore, pg8::StaticOrder, false, true>(F.lds, g, S, E, F.wave);
#if REP_MASK & 4
            xcd_barrier(bar); pg8::gemm_phase<pg8::EpiStore, pg8::StaticOrder, false, true>(F.lds, g, S, E, F.wave);
#endif
            SEAM(pb + 0); TPE(2);
        }
        if (IN(pb + 1)) { TPB(3); phase_post_proj(A, F, l); SEAM(pb + 1); TPE(3); }
        if (IN(pb + 2)) { TPB(4); phase_attn(A, F, l);
#if REP_MASK & 1
            xcd_barrier(bar); phase_attn(A, F, l, 16);
#endif
            SEAM(pb + 2); TPE(4); }
        if (IN(pb + 3)) { TPB(5);
            pg8::Gemm g{(const bf16*)WSP(unsigned char, WS_CAT), (const bf16*)(WSP(unsigned char, WS_WOUT) + (size_t)l * D * D), D / 2}; pg8::StaticOrder S;
            if (l == NL - 1) S.init(M - NB * CTX, D, F.G, (int)blockIdx.x, true); else S.init(M, D, F.G, (int)blockIdx.x);
            pg8::EpiStore E{WSP(bf16, WS_O), D, nullptr, 0, 1.0f / (64.0f * att::CAT_SCALE)};
            pg8::gemm_phase<pg8::EpiStore, pg8::StaticOrder, false, true>(F.lds, g, S, E, F.wave);
#if REP_MASK & 4
            xcd_barrier(bar); pg8::gemm_phase<pg8::EpiStore, pg8::StaticOrder, false, true>(F.lds, g, S, E, F.wave);
#endif
            SEAM(pb + 3); TPE(5);
        }
        if (IN(pb + 4)) { TPB(6); phase_post_out(A, F, l); SEAM(pb + 4); TPE(6); }
        if (IN(pb + 5)) { TPB(7);
            pg8::MoeOrder S; S.n = moe_setup(F, l, GU / 256, true); S.nN = GU / 256; S.ut = (const LAS int*)(F.lds + MOE_UT_OFF);
            pg8::Gemm g{(const bf16*)WSP(unsigned char, WS_H8), (const bf16*)(WSP(unsigned char, WS_WGU) + (size_t)l * NE * GU * D), D / 2};
            pg8::EpiSwiglu E{WSP(unsigned char, WS_ACT), A.in[I_BGU] + (size_t)l * NE * GU};
            pg8::gemm_phase<pg8::EpiSwiglu, pg8::MoeOrder, true, true>(F.lds, g, S, E, F.wave, (const LAS int*)(F.lds + MOE_IDX_OFF));
#if REP_MASK & 2
            xcd_barrier(bar); pg8::gemm_phase<pg8::EpiSwiglu, pg8::MoeOrder, true, true>(F.lds, g, S, E, F.wave, (const LAS int*)(F.lds + MOE_IDX_OFF));
#endif
            SEAM(pb + 5); TPE(7);
        }
        if (IN(pb + 6)) { TPB(8);
            pg8::MoeOrder S; S.n = moe_setup(F, l, D / 256, true); S.nN = D / 256; S.ut = (const LAS int*)(F.lds + MOE_UT_OFF);
            pg8::Gemm g{(const bf16*)WSP(unsigned char, WS_ACT), (const bf16*)(WSP(unsigned char, WS_WDN) + (size_t)l * NE * D * FF), FF / 2};
            pg8::EpiYT E{WSP(unsigned char, WS_YT), A.in[I_BDN] + (size_t)l * NE * D, (const LAS int*)(F.lds + MOE_IDX_OFF)};
            pg8::gemm_phase<pg8::EpiYT, pg8::MoeOrder, false, true>(F.lds, g, S, E, F.wave);
#if REP_MASK & 2
            xcd_barrier(bar); pg8::gemm_phase<pg8::EpiYT, pg8::MoeOrder, false, true>(F.lds, g, S, E, F.wave);
#endif
            SEAM(pb + 6); TPE(8);
        }
        if (IN(pb + 7)) { TPB(9); phase_combine(A, F, l); SEAM(pb + 7); TPE(9); }
    }
    TPE(10);
    if (TPROBE >= 0 && blockIdx.x == 0) { const unsigned long long te = __builtin_amdgcn_s_memrealtime(); while (__builtin_amdgcn_s_memrealtime() - te < 4ull * tacc) __builtin_amdgcn_s_sleep(20); }
#undef IN
#undef SEAM
}

extern "C" void kernel_launch(void* const* d_in, const int* in_sizes, int n_in, void* d_out, int out_size, void* d_ws, size_t ws_size, hipStream_t stream) {
    static int grid = 0;
    if (grid == 0) {
        if (n_in != 22 || out_size != NB * SEQ * D || ws_size < WS_END) { fprintf(stderr, "kernel_launch: unexpected shapes (n_in %d out %d ws %zu)\n", n_in, out_size, ws_size); grid = -1; return; }
        int dev = 0, cus = 0, per_cu = 0;
        if (hipGetDevice(&dev) != hipSuccess || hipDeviceGetAttribute(&cus, hipDeviceAttributeMultiprocessorCount, dev) != hipSuccess) { grid = -1; return; }
        if (hipFuncSetAttribute((const void*)fwd, hipFuncAttributeMaxDynamicSharedMemorySize, LDS_BYTES) != hipSuccess) { fprintf(stderr, "kernel_launch: hipFuncSetAttribute failed\n"); grid = -1; return; }
        if (hipOccupancyMaxActiveBlocksPerMultiprocessor(&per_cu, (const void*)fwd, NWAVES * 64, LDS_BYTES) != hipSuccess || per_cu < 1) fprintf(stderr, "kernel_launch: occupancy query reports %d\n", per_cu);
        (void)hipGetLastError();
        grid = 256;
        if (cus != 256) fprintf(stderr, "kernel_launch: built for 256 CUs, device reports %d\n", cus);
    }
    if (grid < 0) return;
    if (hipMemsetAsync((char*)d_ws + WS_CTL, 0, CTL_ZERO_BYTES, stream) != hipSuccess) return;
    Args a{};
    for (int i = 0; i < 22; ++i) a.in[i] = (const float*)d_in[i];
    a.out = (float*)d_out; a.ws = (unsigned char*)d_ws;
#if MK_PER_PHASE
    for (int p = 0; p < N_PHASES; ++p) { a.ph_lo = p; a.ph_hi = p + 1; hipLaunchKernelGGL(fwd, dim3(grid), dim3(NWAVES * 64), LDS_BYTES, stream, a); }
#else
    a.ph_lo = 0; a.ph_hi = N_PHASES;
    hipLaunchKernelGGL(fwd, dim3(grid), dim3(NWAVES * 64), LDS_BYTES, stream, a);
#endif
}
```

```cpp
#include <hip/hip_runtime.h>
#include <cstdio>
#include <cstdint>

#ifndef REP_MASK
#define REP_MASK 0
#endif
#ifndef TPROBE
#define TPROBE -1
#endif
#ifndef MK_PER_PHASE
#define MK_PER_PHASE 0
#endif

#define GAS __attribute__((address_space(1)))
#define LAS __attribute__((address_space(3)))
typedef unsigned short bf16;
typedef unsigned v4u __attribute__((ext_vector_type(4)));
typedef unsigned v2u __attribute__((ext_vector_type(2)));
typedef float f32x4 __attribute__((ext_vector_type(4)));
typedef short bf16x8 __attribute__((ext_vector_type(8)));
typedef GAS unsigned gu32;

constexpr int NB = 8, SEQ = 4096, CTX = 256, T = CTX + SEQ, D = 1024, NL = 4;
constexpr int M = NB * T;
constexpr int INW = 2560;
constexpr int NE = 32, FF = 1024, GU = 2048;
constexpr int MOE_BLKS = M * 4 / 256 + NE;
constexpr int MOE_ROWS = MOE_BLKS * 256;
constexpr float EPS = 1e-6f;

namespace pg8 {
constexpr int BM = 256, BK = 64, HALF = 128, HTB = HALF * BK * 2, STAGE_BYTES = 8 * HTB, NXCD = 8, WGM = 8;
__host__ __device__ __forceinline__ int lds_byte(int r, int c) { const int st = (r >> 4) * 2 + (c >> 5), rr = r & 15, cc = c & 31, ob = rr * 64 + cc * 2; return st * 1024 + (ob ^ (((ob >> 9) & 1) << 5)); }
__host__ __device__ __forceinline__ void stage_rc(int b, int& R, int& C) { const int st = b / 1024, sb = b % 1024, swz = sb ^ (((sb >> 9) & 1) << 5); R = (st >> 1) * 16 + swz / 64; C = (st & 1) * 32 + (swz % 64) / 2; }
__host__ __device__ __forceinline__ int perm32(int rho) { const int n = rho >> 4, i = rho & 15; return 8 * (i >> 2) + 4 * n + (i & 3); }

struct Unit { int pm, pn, pb, e, ui; };
struct Gemm { const bf16* A; const bf16* Bt; int K; };

struct StaticOrder {
    int nM, nN, nwg, G, c; bool skipctx;
    __device__ void init(int M_, int N_, int G_, int c_, bool skipctx_ = false) { nM = M_ / BM; nN = N_ / BM; nwg = nM * nN; G = G_; c = c_; skipctx = skipctx_; }
    __device__ bool next(int i, Unit& u) const {
        const long L = (long)i * G + c; if (L >= nwg) return false;
        int wgid = (int)L; { const int q = nwg / NXCD, r = nwg % NXCD, xcd = wgid % NXCD, off = wgid / NXCD; wgid = (xcd < r ? xcd * (q + 1) : r * (q + 1) + (xcd - r) * q) + off; }
        const int nig = WGM * nN, gid = wgid / nig, fm = gid * WGM, gsz = (nM - fm) < WGM ? (nM - fm) : WGM;
        u.pm = fm + ((wgid % nig) % gsz); if (skipctx) u.pm += u.pm / 16 + 1; u.pn = (wgid % nig) / gsz; u.pb = u.pn; u.e = 0; u.ui = i; return true;
    }
};
struct MoeOrder {
    const LAS int* ut; int n, nN;
    __device__ bool next(int i, Unit& u) const {
        if (i >= n) return false;
        const int blk = __builtin_amdgcn_readfirstlane(ut[4 * i]), pn = __builtin_amdgcn_readfirstlane(ut[4 * i + 1]), e = __builtin_amdgcn_readfirstlane(ut[4 * i + 2]);
        u.pm = blk; u.pn = pn; u.pb = e * nN + pn; u.e = e; u.ui = i; return true;
    }
};

__device__ __forceinline__ void glds16s(const char* sbase, unsigned voff, unsigned lds_dst) {
    unsigned keep;
    asm volatile("s_mov_b32 %0, m0\n\ts_mov_b32 m0, %3\n\ts_nop 0\n\tglobal_load_lds_dwordx4 %1, %2\n\ts_mov_b32 m0, %0" : "=&s"(keep) : "v"(voff), "s"(sbase), "s"(lds_dst) : "memory");
}
typedef int v8i __attribute__((ext_vector_type(8)));
typedef int v4i __attribute__((ext_vector_type(4)));
__device__ __forceinline__ v8i cat8(bf16x8 lo, bf16x8 hi) { const v4i a = __builtin_bit_cast(v4i, lo), b = __builtin_bit_cast(v4i, hi); return __builtin_shufflevector(a, b, 0, 1, 2, 3, 4, 5, 6, 7); }
__device__ __forceinline__ unsigned cvt4_fp8(float a, float b, float c, float d) { int v = __builtin_amdgcn_cvt_pk_fp8_f32(a, b, 0, false); v = __builtin_amdgcn_cvt_pk_fp8_f32(c, d, v, true); return (unsigned)v; }
__device__ __forceinline__ unsigned cvt_pk_bf16(float lo, float hi) { unsigned r; asm volatile("v_cvt_pk_bf16_f32 %0, %1, %2" : "=v"(r) : "v"(lo), "v"(hi)); return r; }

struct EpiStore {
    bf16* O; int ldc; const float* bias; int bias_stride; float scale;
    __device__ __forceinline__ void operator()(const f32x4 (&acc)[2][2][4][2], const Unit& u, int wr, int wc, int fr, int fq) const {
        asm volatile("" : "+v"(fr), "+v"(fq));
        const int row0 = u.pm * BM + wr * 64 + fr, col0 = u.pn * BM + wc * 32 + 8 * fq;
        f32x4 bv[2][2];
#pragma unroll
        for (int bj = 0; bj < 2; ++bj)
#pragma unroll
            for (int n = 0; n < 2; ++n) bv[bj][n] = bias ? *(const f32x4*)(bias + (size_t)u.e * bias_stride + col0 + bj * HALF + 4 * n) : (f32x4){0.f, 0.f, 0.f, 0.f};
#pragma unroll
        for (int ai = 0; ai < 2; ++ai)
#pragma unroll
            for (int m = 0; m < 4; ++m) { bf16* rowp = O + (size_t)(row0 + ai * HALF + m * 16) * ldc + col0;
#pragma unroll
                for (int bj = 0; bj < 2; ++bj) { const f32x4 v0 = acc[ai][bj][m][0] * scale + bv[bj][0], v1 = acc[ai][bj][m][1] * scale + bv[bj][1];
                    v4u w; w.x = cvt_pk_bf16(v0[0], v0[1]); w.y = cvt_pk_bf16(v0[2], v0[3]); w.z = cvt_pk_bf16(v1[0], v1[1]); w.w = cvt_pk_bf16(v1[2], v1[3]);
                    *(v4u*)(rowp + bj * HALF) = w; } }
    }
};
__device__ __forceinline__ float swiglu1(float g, float u) {
    g = fminf(g, 7.0f); u = fminf(fmaxf(u, -7.0f), 7.0f);
    const float sg = __builtin_amdgcn_rcpf(1.0f + __expf(-1.702f * g));
    return g * sg * (u + 1.0f);
}
struct EpiSwiglu {
    unsigned char* O; const float* bias;
    __device__ __forceinline__ void operator()(const f32x4 (&acc)[2][2][4][2], const Unit& u, int wr, int wc, int fr, int fq) const {
        asm volatile("" : "+v"(fr), "+v"(fq));
        const int row0 = u.pm * BM + wr * 64 + fr, colA = u.pn * HALF + wc * 32 + 8 * fq;
        f32x4 bg[2], bu[2];
#pragma unroll
        for (int n = 0; n < 2; ++n) { bg[n] = *(const f32x4*)(bias + (size_t)u.e * GU + colA + 4 * n); bu[n] = *(const f32x4*)(bias + (size_t)u.e * GU + FF + colA + 4 * n); }
#pragma unroll
        for (int ai = 0; ai < 2; ++ai)
#pragma unroll
            for (int m = 0; m < 4; ++m) { unsigned char* rowp = O + (size_t)(row0 + ai * HALF + m * 16) * FF + colA;
                float a[8];
#pragma unroll
                for (int n = 0; n < 2; ++n)
#pragma unroll
                    for (int q = 0; q < 2; ++q) {
                        typedef float f32x2 __attribute__((ext_vector_type(2)));
                        f32x2 g = (f32x2){acc[ai][0][m][n][2 * q], acc[ai][0][m][n][2 * q + 1]} * (1.0f / 64.0f) + (f32x2){bg[n][2 * q], bg[n][2 * q + 1]};
                        f32x2 u = (f32x2){acc[ai][1][m][n][2 * q], acc[ai][1][m][n][2 * q + 1]} * (1.0f / 64.0f) + (f32x2){bu[n][2 * q], bu[n][2 * q + 1]};
                        g.x = fminf(g.x, 7.0f); g.y = fminf(g.y, 7.0f);
                        u.x = __builtin_amdgcn_fmed3f(u.x, -7.0f, 7.0f); u.y = __builtin_amdgcn_fmed3f(u.y, -7.0f, 7.0f);
                        const f32x2 t = g * (-1.702f * 1.4426950408889634f);
                        f32x2 e; e.x = __builtin_amdgcn_exp2f(t.x); e.y = __builtin_amdgcn_exp2f(t.y);
                        const f32x2 d = e + 1.0f;
                        f32x2 rr; rr.x = __builtin_amdgcn_rcpf(d.x); rr.y = __builtin_amdgcn_rcpf(d.y);
                        const f32x2 o = (g * rr) * (u * 4.0f + 4.0f);
                        a[4 * n + 2 * q] = o.x; a[4 * n + 2 * q + 1] = o.y; }
                v2u w; w.x = cvt4_fp8(a[0], a[1], a[2], a[3]); w.y = cvt4_fp8(a[4], a[5], a[6], a[7]);
                *(v2u*)rowp = w; }
    }
};
struct EpiYT {
    unsigned char* YT; const float* bias; const LAS int* idx;
    __device__ __forceinline__ void operator()(const f32x4 (&acc)[2][2][4][2], const Unit& u, int wr, int wc, int fr, int fq) const {
        asm volatile("" : "+v"(fr), "+v"(fq));
        const int col0 = u.pn * BM + wc * 32 + 8 * fq;
        f32x4 bv[2][2];
#pragma unroll
        for (int bj = 0; bj < 2; ++bj)
#pragma unroll
            for (int n = 0; n < 2; ++n) bv[bj][n] = *(const f32x4*)(bias + (size_t)u.e * D + col0 + bj * HALF + 4 * n);
#pragma unroll
        for (int ai = 0; ai < 2; ++ai)
#pragma unroll
            for (int m = 0; m < 4; ++m) { const int info = idx[u.ui * 256 + ai * HALF + wr * 64 + m * 16 + fr];
                if (info >= 0) { unsigned char* rowp = YT + (size_t)info * D + col0;
#pragma unroll
                    for (int bj = 0; bj < 2; ++bj) { const f32x4 v0 = acc[ai][bj][m][0] * (8.0f / 256.0f) + bv[bj][0] * 8.0f, v1 = acc[ai][bj][m][1] * (8.0f / 256.0f) + bv[bj][1] * 8.0f;
                        v2u w; w.x = cvt4_fp8(v0[0], v0[1], v0[2], v0[3]); w.y = cvt4_fp8(v1[0], v1[1], v1[2], v1[3]);
                        *(v2u*)(rowp + bj * HALF) = w; } } }
    }
};

template <class Epi, class Sched, bool GATHER = false, bool FP8 = false>
__device__ __forceinline__ void gemm_phase(LAS unsigned char* lds, const Gemm g, const Sched& S, const Epi& E, int wid, const LAS int* gidx = nullptr) {
    int lane; asm volatile("v_mbcnt_lo_u32_b32 %0, -1, 0\n\tv_mbcnt_hi_u32_b32 %0, -1, %0" : "=&v"(lane));
    const int tid = wid * 64 + lane, wr = wid >> 2, wc = wid & 3, fr = lane & 15, fq = lane >> 4;
    const int K = g.K, nt = K / BK;
    unsigned voffA[2], voffB[2];
#pragma unroll
    for (int i = 0; i < 2; ++i) { int R, C; stage_rc(tid * 16 + i * 8192, R, C); const int Rb = (R & ~31) + perm32(R & 31);
        voffA[i] = GATHER ? 0u : (unsigned)(R * K + C) * 2u; voffB[i] = (unsigned)(Rb * K + C) * 2u; }
    unsigned vgc[2][2];
#define PG8_GOFF(dst, ui_) do { int _t = tid; asm volatile("" : "+v"(_t)); _Pragma("unroll") for (int _i = 0; _i < 2; ++_i) { int _R, _C; stage_rc(_t * 16 + _i * 8192, _R, _C); _Pragma("unroll") for (int _h = 0; _h < 2; ++_h) { \
        const int _inf = gidx[(ui_) * 256 + _h * HALF + _R]; dst[_h][_i] = (unsigned)((_inf < 0 ? 0 : (_inf >> 2)) * K + _C) * 2u; } } } while (0)
    const size_t kstep = (size_t)(BK * 2);
    const size_t hstep = (size_t)HALF * K * 2;
    const size_t tstep = 2 * hstep;
    const unsigned ldsw = (unsigned)wid * 1024u;
    const int aoff = lds_byte(wr * 64 + fr, fq * 8), boff = lds_byte(wc * 32 + fr, fq * 8);
#define PG8_SA(b, h) (((b) * 2 + (h)) * HTB)
#define PG8_SB(b, h) ((4 + (b) * 2 + (h)) * HTB)
#define PG8_STAGE(bufoff, gbase, voff) do { _Pragma("unroll") for (int _i = 0; _i < 2; ++_i) \
        glds16s((const char*)(gbase), (voff)[_i], (unsigned)(size_t)(lds + (bufoff) + ldsw + _i * 8192)); } while (0)
#define PG8_LDA(dst, b, h) do { _Pragma("unroll") for (int m = 0; m < 4; ++m) _Pragma("unroll") for (int k = 0; k < 2; ++k) dst[m][k] = *(const LAS bf16x8*)(lds + PG8_SA(b, h) + aoff + m * 2048 + k * 1024); } while (0)
#define PG8_LDB(dst, b, h) do { _Pragma("unroll") for (int n = 0; n < 2; ++n) _Pragma("unroll") for (int k = 0; k < 2; ++k) dst[n][k] = *(const LAS bf16x8*)(lds + PG8_SB(b, h) + boff + n * 2048 + k * 1024); } while (0)
#define PG8_MMA(ai, bj, At, Bt) do { __builtin_amdgcn_s_setprio(1); if constexpr (FP8) { _Pragma("unroll") for (int m = 0; m < 4; ++m) _Pragma("unroll") for (int n = 0; n < 2; ++n) \
        acc[ai][bj][m][n] = __builtin_amdgcn_mfma_scale_f32_16x16x128_f8f6f4(cat8(Bt[n][0], Bt[n][1]), cat8(At[m][0], At[m][1]), acc[ai][bj][m][n], 0, 0, 0, 0, 0, 0); } else { \
        _Pragma("unroll") for (int m = 0; m < 4; ++m) _Pragma("unroll") for (int n = 0; n < 2; ++n) _Pragma("unroll") for (int k = 0; k < 2; ++k) \
        acc[ai][bj][m][n] = __builtin_amdgcn_mfma_f32_16x16x32_bf16(Bt[n][k], At[m][k], acc[ai][bj][m][n], 0, 0, 0); } __builtin_amdgcn_s_setprio(0); } while (0)
#define PG8_WAIT_V(n) asm volatile("s_waitcnt vmcnt(" #n ")" ::: "memory")
#define PG8_WAIT_L(n) asm volatile("s_waitcnt lgkmcnt(" #n ")" ::: "memory")
#define PG8_BAR __builtin_amdgcn_s_barrier()
#define PG8_SCHED __builtin_amdgcn_sched_barrier(0)
    Unit cur, nxt; int ui = 0;
    if (!S.next(0, cur)) return;
    f32x4 acc[2][2][4][2];
#pragma unroll
    for (int a = 0; a < 2; ++a)
#pragma unroll
        for (int b = 0; b < 2; ++b)
#pragma unroll
            for (int m = 0; m < 4; ++m)
#pragma unroll
                for (int n = 0; n < 2; ++n) acc[a][b][m][n] = (f32x4){0.f, 0.f, 0.f, 0.f};
    bf16x8 At[4][2], B0[2][2], B1[2][2];
    const char* cA = GATHER ? (const char*)g.A : (const char*)g.A + (size_t)cur.pm * tstep; const char* cB = (const char*)g.Bt + (size_t)cur.pb * tstep;
    if constexpr (GATHER) { PG8_GOFF(vgc, cur.ui); }
#define PG8_STAGE_A(bufoff, base, h, vg) do { if constexpr (GATHER) PG8_STAGE(bufoff, base, vg[h]); else PG8_STAGE(bufoff, (base) + (h) * hstep, voffA); } while (0)
    PG8_STAGE(PG8_SB(0, 0), cB, voffB); PG8_STAGE(PG8_SB(0, 1), cB + hstep, voffB); PG8_STAGE_A(PG8_SA(0, 0), cA, 0, vgc); PG8_STAGE_A(PG8_SA(0, 1), cA, 1, vgc);
    if (wr == 1) PG8_BAR;
    PG8_WAIT_V(2); PG8_BAR;
    PG8_STAGE(PG8_SB(1, 0), cB + kstep, voffB); PG8_STAGE_A(PG8_SA(1, 0), cA + kstep, 0, vgc); PG8_STAGE(PG8_SB(1, 1), cB + hstep + kstep, voffB);
    PG8_WAIT_V(6); PG8_BAR;
    for (;;) {
        const bool has_next = S.next(ui + 1, nxt);
        const char* nA = GATHER ? cA : (has_next ? (const char*)g.A + (size_t)nxt.pm * tstep : cA); const char* nB = has_next ? (const char*)g.Bt + (size_t)nxt.pb * tstep : cB;
        for (int t = 0; t < nt; t += 2) {
            const bool last = (t == nt - 2);
            const char* a1 = cA + (size_t)(t + 1) * kstep;
            const char* a2 = last ? nA : cA + (size_t)(t + 2) * kstep; const char* b2 = last ? nB : cB + (size_t)(t + 2) * kstep;
            const char* a3 = a2 + kstep; const char* b3 = b2 + kstep;
            PG8_LDB(B0, 0, 0); PG8_LDB(B1, 0, 1); PG8_SCHED; PG8_LDA(At, 0, 0); PG8_STAGE_A(PG8_SA(1, 1), a1, 1, vgc);
            if constexpr (GATHER) { if (last && has_next) { PG8_GOFF(vgc, nxt.ui); } }
            PG8_WAIT_V(8); PG8_WAIT_L(0); PG8_BAR; PG8_MMA(0, 0, At, B0); PG8_MMA(0, 1, At, B1); PG8_BAR; PG8_SCHED;
            PG8_LDA(At, 0, 1); PG8_STAGE(PG8_SB(0, 0), b2, voffB); PG8_STAGE(PG8_SB(0, 1), b2 + hstep, voffB); PG8_STAGE_A(PG8_SA(0, 0), a2, 0, vgc);
            PG8_WAIT_V(8); PG8_WAIT_L(0); PG8_BAR; PG8_MMA(1, 0, At, B0); PG8_MMA(1, 1, At, B1); PG8_BAR; PG8_SCHED;
            PG8_LDB(B0, 1, 0); PG8_LDB(B1, 1, 1); PG8_SCHED; PG8_LDA(At, 1, 0); PG8_STAGE_A(PG8_SA(0, 1), a2, 1, vgc);
            PG8_WAIT_V(8); PG8_WAIT_L(0); PG8_BAR; PG8_MMA(0, 0, At, B0); PG8_MMA(0, 1, At, B1); PG8_BAR; PG8_SCHED;
            PG8_LDA(At, 1, 1); PG8_STAGE(PG8_SB(1, 0), b3, voffB); PG8_STAGE(PG8_SB(1, 1), b3 + hstep, voffB); PG8_STAGE_A(PG8_SA(1, 0), a3, 0, vgc);
            PG8_WAIT_V(8); PG8_WAIT_L(0); PG8_BAR; PG8_MMA(1, 0, At, B0); PG8_MMA(1, 1, At, B1); PG8_BAR; PG8_SCHED;
        }
        if (wr == 0) PG8_BAR;
        { int ln_; asm volatile("v_mbcnt_lo_u32_b32 %0, -1, 0\n\tv_mbcnt_hi_u32_b32 %0, -1, %0" : "=&v"(ln_)); E(acc, cur, wr, wc, ln_ & 15, ln_ >> 4); }
        if (!has_next) break;
#pragma unroll
        for (int a = 0; a < 2; ++a)
#pragma unroll
            for (int b = 0; b < 2; ++b)
#pragma unroll
                for (int m = 0; m < 4; ++m)
#pragma unroll
                    for (int n = 0; n < 2; ++n) acc[a][b][m][n] = (f32x4){0.f, 0.f, 0.f, 0.f};
        cur = nxt; cA = nA; cB = nB; ++ui;
        if (wr == 1) PG8_BAR;
    }
    PG8_WAIT_V(0);
    PG8_BAR;
#undef PG8_SA
#undef PG8_SB
#undef PG8_STAGE
#undef PG8_STAGE_A
#undef PG8_GOFF
#undef PG8_LDA
#undef PG8_LDB
#undef PG8_MMA
#undef PG8_WAIT_V
#undef PG8_WAIT_L
#undef PG8_BAR
#undef PG8_SCHED
}
}

constexpr size_t MiB = 1u << 20;
constexpr size_t WS_CTL = 0, CTL_ZERO_BYTES = 1 * MiB;
constexpr size_t WS_MOD = 2 * MiB;
constexpr size_t WS_RGATE = 3 * MiB;
constexpr size_t WS_WIN = 8 * MiB;
constexpr size_t WS_WOUT = 28 * MiB;
constexpr size_t WS_WGU = 36 * MiB;
constexpr size_t WS_WDN = 548 * MiB;
constexpr size_t WS_X = 804 * MiB;
constexpr size_t WS_H = 940 * MiB;
constexpr size_t WS_P = 1008 * MiB;
constexpr size_t WS_VT = 1178 * MiB;
constexpr size_t WS_CAT = 1229 * MiB;
constexpr size_t WS_O = 1297 * MiB;
constexpr size_t WS_YT = 1365 * MiB;
constexpr size_t WS_ACT = 1653 * MiB;
constexpr size_t WS_RINFO = 1941 * MiB;
constexpr size_t WS_H8 = 1946 * MiB;
constexpr size_t WS_END = 1980 * MiB;
constexpr int CW_TMO = 0, CW_CODE = 1, CW_BAR = 4096, CW_CNT = 8192, CW_WORK = 8192 + 1024, CW_KMAX = 8192 + 2048;

constexpr int NWAVES = 8;
constexpr int RING_BYTES = 131072;
constexpr int LDSCTL_OFF = RING_BYTES, MISC_OFF = LDSCTL_OFF + 320;
constexpr int MOE_TAB_OFF = LDSCTL_OFF + 512, MOE_UT_OFF = LDSCTL_OFF + 1024, MOE_IDX_OFF = LDSCTL_OFF + 2048, MOE_MAX_UNITS = 18;
constexpr int LDS_BYTES = 163840;

#define RLX_AGENT __ATOMIC_RELAXED, __HIP_MEMORY_SCOPE_AGENT
#define LDS_WAIT() asm volatile("s_waitcnt lgkmcnt(0)" ::: "memory")
__device__ __forceinline__ unsigned f2bf(float f) { unsigned u = __builtin_bit_cast(unsigned, f); return (u + 0x7fffu + ((u >> 16) & 1u)) >> 16; }
__device__ __forceinline__ unsigned pk2(float lo, float hi) { return f2bf(lo) | (f2bf(hi) << 16); }
__device__ __forceinline__ float bflo(unsigned w) { return __builtin_bit_cast(float, w << 16); }
__device__ __forceinline__ float bfhi(unsigned w) { return __builtin_bit_cast(float, w & 0xffff0000u); }
__device__ __forceinline__ float bf2f(bf16 h) { return __builtin_bit_cast(float, (unsigned)h << 16); }
template <class Tp> __device__ __forceinline__ Tp* opq(Tp* p) { asm volatile("" : "+s"(p)); return p; }
__device__ __forceinline__ int lane_id() { int x; asm volatile("v_mbcnt_lo_u32_b32 %0, -1, 0\n\tv_mbcnt_hi_u32_b32 %0, -1, %0" : "=&v"(x)); return x; }
template <int MASK> __device__ __forceinline__ float sx(float v) {
    static_assert(MASK >= 1 && MASK < 32, "sx: xor mask inside a 32-lane half");
    return __builtin_bit_cast(float, __builtin_amdgcn_ds_swizzle(__builtin_bit_cast(int, v), (MASK << 10) | 0x1f));
}
template <int MASK> __device__ __forceinline__ int sxi(int v) { return __builtin_amdgcn_ds_swizzle(v, (MASK << 10) | 0x1f); }
__device__ __forceinline__ void swap32(unsigned& a, unsigned& b) { asm volatile("s_nop 1\n\tv_permlane32_swap_b32 %0, %1\n\ts_nop 1" : "+v"(a), "+v"(b)); }
__device__ __forceinline__ float sum32(float v) { unsigned a = __builtin_bit_cast(unsigned, v), b = a; swap32(a, b); return __builtin_bit_cast(float, a) + __builtin_bit_cast(float, b); }
__device__ __forceinline__ float max32(float v) { unsigned a = __builtin_bit_cast(unsigned, v), b = a; swap32(a, b); return fmaxf(__builtin_bit_cast(float, a), __builtin_bit_cast(float, b)); }
__device__ __forceinline__ float other32(float v, bool) { const unsigned u = __builtin_bit_cast(unsigned, v); unsigned a = u, b = u; swap32(a, b); return __builtin_bit_cast(float, a ^ b ^ u); }
__device__ __forceinline__ int other32i(int v, bool) { unsigned a = (unsigned)v, b = a; swap32(a, b); return (int)(a ^ b ^ (unsigned)v); }
__device__ __forceinline__ void swap16(unsigned& a, unsigned& b) { asm volatile("s_nop 1\n\tv_permlane16_swap_b32 %0, %1\n\ts_nop 1" : "+v"(a), "+v"(b)); }
__device__ __forceinline__ float other16(float v) { const unsigned u = __builtin_bit_cast(unsigned, v); unsigned a = u, b = u; swap16(a, b); return __builtin_bit_cast(float, a ^ b ^ u); }
__device__ __forceinline__ int other16i(int v) { unsigned a = (unsigned)v, b = a; swap16(a, b); return (int)(a ^ b ^ (unsigned)v); }
template <int CTRL> __device__ __forceinline__ float dppf(float v) { return __builtin_bit_cast(float, __builtin_amdgcn_update_dpp(0, __builtin_bit_cast(int, v), CTRL, 0xF, 0xF, false)); }
template <int CTRL> __device__ __forceinline__ int dppi(int v) { return __builtin_amdgcn_update_dpp(0, v, CTRL, 0xF, 0xF, false); }
constexpr int DPP_XOR1 = 0xB1, DPP_XOR2 = 0x4E, DPP_HMIRROR = 0x141, DPP_MIRROR = 0x140;
__device__ __forceinline__ float half_sum(float v) { v += sx<1>(v); v += sx<2>(v); v += sx<4>(v); v += sx<8>(v); v += sx<16>(v); return v; }
__device__ __forceinline__ float wave_sum(float v) { return sum32(half_sum(v)); }

#define XB_TMO      128
#define XB_XCNT(j)  (256  + 64 * (j))
#define XB_XSUB(j)  (1280 + 64 * (j))
#define XB_XGEN(j)  (2304 + 64 * (j))
#define XB_TOP      3328
#define XB_TOPGEN   3392
#define XCD_BAR_WORDS 3456
#define XB_SPIN_CAP (1u << 18)
__device__ __forceinline__ unsigned xb_ld(unsigned* p)              { return __hip_atomic_load(p, __ATOMIC_RELAXED, __HIP_MEMORY_SCOPE_AGENT); }
__device__ __forceinline__ unsigned xb_add(unsigned* p, unsigned v) { return __hip_atomic_fetch_add(p, v, __ATOMIC_RELAXED, __HIP_MEMORY_SCOPE_AGENT); }
__device__ __forceinline__ unsigned xb_xcc_id() { return (unsigned)__builtin_amdgcn_s_getreg((3 << 11) | 20) & 0xFu; }
#define XB_SPIN(cond, bar) do { unsigned _sp = 0; while (cond) { __builtin_amdgcn_s_sleep(1); \
    if ((++_sp & 255u) == 0u) { if (xb_ld(&(bar)[XB_TMO])) break; if (_sp > XB_SPIN_CAP) { atomicAdd(&(bar)[XB_TMO], 1u); break; } } } } while (0)
struct XcdBarrier { unsigned* bar; unsigned x; volatile LAS unsigned* st; int wave; };
__device__ __forceinline__ XcdBarrier xcd_barrier_post(unsigned* bar, volatile LAS unsigned* st, int wave) {
    XcdBarrier b; b.bar = bar; b.x = xb_xcc_id(); b.st = st; b.wave = wave;
    if (wave == 0 && lane_id() == 0) (void)xb_add(&bar[XB_XCNT(b.x)], 1u);
    return b;
}
__device__ __forceinline__ void xcd_barrier_complete(unsigned* bar, unsigned x, unsigned& nloc, unsigned& nx) {
    const unsigned G = gridDim.x * gridDim.y * gridDim.z;
    unsigned sum, cnt, mine, sp = 0u;
    for (;;) {
        sum = 0u; cnt = 0u; mine = 0u;
#pragma unroll
        for (unsigned j = 0; j < 16; ++j) { const unsigned c = xb_ld(&bar[XB_XCNT(j)]); sum += c; cnt += (c > 0u) ? 1u : 0u; mine = (j == x) ? c : mine; }
        if (sum == G) break;
        __builtin_amdgcn_s_sleep(1);
        if ((++sp & 255u) == 0u) { if (xb_ld(&bar[XB_TMO])) break; if (sp > XB_SPIN_CAP) { atomicAdd(&bar[XB_TMO], 1u); break; } }
    }
    nloc = mine > 0u ? mine : 1u; nx = cnt > 0u ? cnt : 1u;
}
__device__ __forceinline__ void xcd_barrier(const XcdBarrier& b) {
    asm volatile("s_waitcnt vmcnt(0)" ::: "memory");
    __syncthreads();
    if (b.wave == 0 && lane_id() == 0) {
        unsigned* bar = opq(b.bar);
        __builtin_amdgcn_s_waitcnt(0);
        unsigned nloc = b.st[0], nx = b.st[1];
        if (nloc == 0u) { xcd_barrier_complete(bar, b.x, nloc, nx); b.st[0] = nloc; b.st[1] = nx; }
        const unsigned old = xb_add(&bar[XB_XSUB(b.x)], 1u);
        const unsigned gen = old / nloc;
        if (old + 1u == (gen + 1u) * nloc) {
            __builtin_amdgcn_fence(__ATOMIC_RELEASE, "agent");
            asm volatile("s_waitcnt vmcnt(0)" ::: "memory");
            const unsigned og = xb_add(&bar[XB_TOP], 1u);
            const unsigned tg = og / nx;
            if (og + 1u == (tg + 1u) * nx) xb_add(&bar[XB_TOPGEN], 1u);
            else XB_SPIN(xb_ld(&bar[XB_TOPGEN]) == tg, bar);
            __builtin_amdgcn_fence(__ATOMIC_ACQUIRE, "agent");
            xb_add(&bar[XB_XGEN(b.x)], 1u);
            asm volatile("s_waitcnt vmcnt(0)" ::: "memory");
        } else {
            XB_SPIN(xb_ld(&bar[XB_XGEN(b.x)]) == gen, bar);
            __builtin_amdgcn_fence(__ATOMIC_ACQUIRE, "agent");
            asm volatile("s_waitcnt vmcnt(0)" ::: "memory");
        }
    }
    __syncthreads();
}

struct Args { const float* in[22]; float* out; unsigned char* ws; int ph_lo, ph_hi; };
enum { I_X = 0, I_C, I_CTX, I_CCTX, I_WADA, I_BADA, I_N1G, I_N2G, I_WIN, I_WOUT, I_DLAM, I_DG, I_QKG, I_RPB, I_SINK, I_RW, I_RB, I_WGU, I_BGU, I_WDN, I_BDN, I_FG };
struct Frame {
    LAS unsigned char* lds; unsigned char* ws; unsigned* ctl;
    int vcu, G, wave;
};
#define WSP(type, off) ((type*)(F.ws + (off)))

struct Row { f32x4 v[4]; };
__device__ __forceinline__ void row_load_f32(Row& r, const float* p, int lane) {
#pragma unroll
    for (int j = 0; j < 4; ++j) r.v[j] = ((const GAS f32x4*)p)[lane + 64 * j];
}
__device__ __forceinline__ void row_store_f32(const Row& r, float* p, int lane) {
#pragma unroll
    for (int j = 0; j < 4; ++j) ((GAS f32x4*)p)[lane + 64 * j] = r.v[j];
}
__device__ __forceinline__ void row_load_bf16(Row& r, const bf16* p, int lane) {
#pragma unroll
    for (int j = 0; j < 4; ++j) { const v2u w = ((const GAS v2u*)p)[lane + 64 * j]; r.v[j] = (f32x4){bflo(w.x), bfhi(w.x), bflo(w.y), bfhi(w.y)}; }
}
__device__ __forceinline__ void row_store_bf16(const Row& r, bf16* p, int lane) {
#pragma unroll
    for (int j = 0; j < 4; ++j) { v2u w; w.x = pk2(r.v[j][0], r.v[j][1]); w.y = pk2(r.v[j][2], r.v[j][3]); ((GAS v2u*)p)[lane + 64 * j] = w; }
}
__device__ __forceinline__ void row_store_fp8(const Row& r, unsigned char* p, int lane) {
#pragma unroll
    for (int j = 0; j < 4; ++j) ((GAS unsigned*)p)[lane + 64 * j] = pg8::cvt4_fp8(r.v[j][0], r.v[j][1], r.v[j][2], r.v[j][3]);
}
__device__ __forceinline__ float row_rstd(const Row& r) {
    float s = 0.f;
#pragma unroll
    for (int j = 0; j < 4; ++j) s += (r.v[j][0] * r.v[j][0] + r.v[j][1] * r.v[j][1]) + (r.v[j][2] * r.v[j][2] + r.v[j][3] * r.v[j][3]);
    return 1.0f / sqrtf(wave_sum(s) * (1.0f / D) + EPS);
}
__device__ __forceinline__ void row_modulate(Row& h, const Row& x, float rstd, const float* g, const float* sc, const float* sh, int lane) {
#pragma unroll
    for (int j = 0; j < 4; ++j) { const f32x4 gg = ((const GAS f32x4*)g)[lane + 64 * j], s1 = ((const GAS f32x4*)sc)[lane + 64 * j], s0 = ((const GAS f32x4*)sh)[lane + 64 * j];
        h.v[j] = x.v[j] * rstd * gg * (s1 + 1.0f) + s0; }
}

__device__ __forceinline__ void transpose_item(const float* W, int K, int N, bf16* WT, int k0, int n0, int dest_row0, LAS float* scr, int lane) {
    float tv[32];
#pragma unroll
    for (int i = 0; i < 32; ++i) { const int kk = 2 * i + (lane >> 5); tv[i] = W[(size_t)(k0 + kk) * N + n0 + (lane & 31)]; }
#pragma unroll
    for (int i = 0; i < 32; ++i) { const int kk = 2 * i + (lane >> 5); scr[kk * 33 + (lane & 31)] = tv[i]; }
    LDS_WAIT(); asm volatile("" ::: "memory");
    const int c = lane & 7;
#pragma unroll
    for (int j = 0; j < 4; ++j) { const int n = (lane >> 3) + 8 * j; const LAS float* s = scr + (8 * c) * 33 + n;
        v4u o; o.x = pk2(s[0 * 33], s[1 * 33]); o.y = pk2(s[2 * 33], s[3 * 33]); o.z = pk2(s[4 * 33], s[5 * 33]); o.w = pk2(s[6 * 33], s[7 * 33]);
        *(v4u*)(WT + (size_t)(dest_row0 + n) * K + k0 + 8 * c) = o; }
    LDS_WAIT(); asm volatile("" ::: "memory");
}
__device__ __forceinline__ void transpose_item8(const float* W, int K, int N, unsigned char* W8, int k0, int n0, int dest_row0, float scale, LAS float* scr, int lane) {
    float tv[32];
#pragma unroll
    for (int i = 0; i < 32; ++i) { const int kk = 2 * i + (lane >> 5); tv[i] = W[(size_t)(k0 + kk) * N + n0 + (lane & 31)]; }
#pragma unroll
    for (int i = 0; i < 32; ++i) { const int kk = 2 * i + (lane >> 5); scr[kk * 33 + (lane & 31)] = tv[i]; }
    LDS_WAIT(); asm volatile("" ::: "memory");
    const int n = lane >> 1, hf = lane & 1; const LAS float* sp = scr + (32 * hf) * 33 + n;
    v4u o0, o1;
    o0.x = pg8::cvt4_fp8(sp[0 * 33] * scale, sp[1 * 33] * scale, sp[2 * 33] * scale, sp[3 * 33] * scale); o0.y = pg8::cvt4_fp8(sp[4 * 33] * scale, sp[5 * 33] * scale, sp[6 * 33] * scale, sp[7 * 33] * scale);
    o0.z = pg8::cvt4_fp8(sp[8 * 33] * scale, sp[9 * 33] * scale, sp[10 * 33] * scale, sp[11 * 33] * scale); o0.w = pg8::cvt4_fp8(sp[12 * 33] * scale, sp[13 * 33] * scale, sp[14 * 33] * scale, sp[15 * 33] * scale);
    o1.x = pg8::cvt4_fp8(sp[16 * 33] * scale, sp[17 * 33] * scale, sp[18 * 33] * scale, sp[19 * 33] * scale); o1.y = pg8::cvt4_fp8(sp[20 * 33] * scale, sp[21 * 33] * scale, sp[22 * 33] * scale, sp[23 * 33] * scale);
    o1.z = pg8::cvt4_fp8(sp[24 * 33] * scale, sp[25 * 33] * scale, sp[26 * 33] * scale, sp[27 * 33] * scale); o1.w = pg8::cvt4_fp8(sp[28 * 33] * scale, sp[29 * 33] * scale, sp[30 * 33] * scale, sp[31 * 33] * scale);
    v4u* dst = (v4u*)(W8 + (size_t)(dest_row0 + n) * K + k0 + 32 * hf);
    dst[0] = o0; dst[1] = o1;
    LDS_WAIT(); asm volatile("" ::: "memory");
}
template <bool FP8>
__device__ __forceinline__ void convert_item64(const float* W, int K, int N, void* dst, int k0, int n0, int dest_row0, float scale, int lane) {
    float v[64];
    const GAS float* wp = (const GAS float*)W + (size_t)k0 * N + n0 + lane;
#pragma unroll
    for (int k = 0; k < 64; ++k) v[k] = wp[(size_t)k * N];
    if (FP8) { GAS v4u* o = (GAS v4u*)((unsigned char*)dst + (size_t)(dest_row0 + lane) * K + k0);
#pragma unroll
        for (int q = 0; q < 4; ++q) { v4u w; w.x = pg8::cvt4_fp8(v[16 * q] * scale, v[16 * q + 1] * scale, v[16 * q + 2] * scale, v[16 * q + 3] * scale); w.y = pg8::cvt4_fp8(v[16 * q + 4] * scale, v[16 * q + 5] * scale, v[16 * q + 6] * scale, v[16 * q + 7] * scale);
            w.z = pg8::cvt4_fp8(v[16 * q + 8] * scale, v[16 * q + 9] * scale, v[16 * q + 10] * scale, v[16 * q + 11] * scale); w.w = pg8::cvt4_fp8(v[16 * q + 12] * scale, v[16 * q + 13] * scale, v[16 * q + 14] * scale, v[16 * q + 15] * scale); o[q] = w; }
    } else { GAS v4u* o = (GAS v4u*)((bf16*)dst + (size_t)(dest_row0 + lane) * K + k0);
#pragma unroll
        for (int q = 0; q < 8; ++q) { v4u w; w.x = pk2(v[8 * q], v[8 * q + 1]); w.y = pk2(v[8 * q + 2], v[8 * q + 3]); w.z = pk2(v[8 * q + 4], v[8 * q + 5]); w.w = pk2(v[8 * q + 6], v[8 * q + 7]); o[q] = w; } }
}
constexpr int IT_IN = 16 * 40, IT_OUT = 16 * 16, IT_GU = 16 * 32, IT_DN = 16 * 16;
constexpr int IT_LAYER = IT_IN + IT_OUT + NE * IT_GU + NE * IT_DN;
constexpr int CONV_UNITS = IT_LAYER / 16;
struct ConvItem { const float* src; unsigned char* dst; int K, N; };
__device__ __forceinline__ ConvItem conv_decode(const Args& A, Frame& F, int l, int r) {
    ConvItem c;
    if (r < IT_IN) { const int kb = r / 40, nb = r % 40; c.K = D; c.N = INW; c.src = A.in[I_WIN] + (size_t)l * D * INW + (size_t)(64 * kb) * INW + 64 * nb; c.dst = WSP(unsigned char, WS_WIN) + (size_t)l * INW * D + (size_t)(64 * nb) * D + 64 * kb; return c; } r -= IT_IN;
    if (r < IT_OUT) { const int kb = r / 16, nb = r % 16; c.K = D; c.N = D; c.src = A.in[I_WOUT] + (size_t)l * D * D + (size_t)(64 * kb) * D + 64 * nb; c.dst = WSP(unsigned char, WS_WOUT) + (size_t)l * D * D + (size_t)(64 * nb) * D + 64 * kb; return c; } r -= IT_OUT;
    if (r < NE * IT_GU) { const int e = r / IT_GU, q = r % IT_GU, kb = q / 32, nb = q % 32, n0 = 64 * nb;
        const int dest = n0 < FF ? (n0 >> 7) * 256 + (n0 & 127) : ((n0 - FF) >> 7) * 256 + 128 + ((n0 - FF) & 127);
        c.K = D; c.N = GU; c.src = A.in[I_WGU] + (size_t)(l * NE + e) * D * GU + (size_t)(64 * kb) * GU + n0; c.dst = WSP(unsigned char, WS_WGU) + (size_t)(l * NE + e) * GU * D + (size_t)dest * D + 64 * kb; return c; } r -= NE * IT_GU;
    { const int e = r / IT_DN, q = r % IT_DN, kb = q / 16, nb = q % 16;
        c.K = FF; c.N = D; c.src = A.in[I_WDN] + (size_t)(l * NE + e) * FF * D + (size_t)(64 * kb) * D + 64 * nb; c.dst = WSP(unsigned char, WS_WDN) + (size_t)(l * NE + e) * D * FF + (size_t)(64 * nb) * FF + 64 * kb; return c; }
}
__device__ __forceinline__ void conv_load(const ConvItem& c, int lane, float (&v)[64]) { const GAS float* wp = (const GAS float*)c.src + lane;
#pragma unroll
    for (int k = 0; k < 64; ++k) v[k] = wp[(size_t)k * c.N]; }
__device__ __forceinline__ void conv_store(const ConvItem& c, int lane, const float (&v)[64]) { GAS v4u* o = (GAS v4u*)(c.dst + (size_t)lane * c.K);
#pragma unroll
    for (int q = 0; q < 4; ++q) { v4u w; w.x = pg8::cvt4_fp8(v[16 * q] * 64.0f, v[16 * q + 1] * 64.0f, v[16 * q + 2] * 64.0f, v[16 * q + 3] * 64.0f); w.y = pg8::cvt4_fp8(v[16 * q + 4] * 64.0f, v[16 * q + 5] * 64.0f, v[16 * q + 6] * 64.0f, v[16 * q + 7] * 64.0f);
        w.z = pg8::cvt4_fp8(v[16 * q + 8] * 64.0f, v[16 * q + 9] * 64.0f, v[16 * q + 10] * 64.0f, v[16 * q + 11] * 64.0f); w.w = pg8::cvt4_fp8(v[16 * q + 12] * 64.0f, v[16 * q + 13] * 64.0f, v[16 * q + 14] * 64.0f, v[16 * q + 15] * 64.0f); o[q] = w; } }
__device__ __forceinline__ void phase_proA(const Args& A, Frame& F) {
    const int wave = F.wave, lane = lane_id(), tid = wave * 64 + lane; (void)tid;
    LAS float* sl = (LAS float*)F.lds;
    LAS float* scr = (LAS float*)(F.lds + 40960 + wave * 8704);
    LAS float* red = (LAS float*)(F.lds + 110592);
    for (int i = tid; i < 9 * D; i += NWAVES * 64) { const int r = i >> 10, k = i & 1023; const float v = r < 8 ? A.in[I_C][r * D + k] : A.in[I_CCTX][k]; sl[i] = v / (1.0f + __expf(-v)); }
    __syncthreads();
    const bool ada = F.vcu < 192;
    const int item = F.vcu * 2 + (wave >> 2), al = item / 96, an = (item % 96) * 64 + lane, kq = wave & 3;
    if (ada) {
        const float* w = A.in[I_WADA] + (size_t)al * D * 6144 + (size_t)(kq * 256) * 6144 + an;
        float acc[9];
#pragma unroll
        for (int r = 0; r < 9; ++r) acc[r] = 0.f;
#pragma unroll 1
        for (int k0 = 0; k0 < 256; k0 += 16) { float wv[16];
#pragma unroll
            for (int kk = 0; kk < 16; ++kk) wv[kk] = w[(size_t)(k0 + kk) * 6144];
#pragma unroll
            for (int kk = 0; kk < 16; ++kk)
#pragma unroll
                for (int r = 0; r < 9; ++r) acc[r] += sl[r * D + kq * 256 + k0 + kk] * wv[kk]; }
#pragma unroll
        for (int r = 0; r < 9; ++r) red[(wave * 9 + r) * 64 + lane] = acc[r];
    }
    __syncthreads();
    if (ada && kq == 0) {
        const float bb = A.in[I_BADA][al * 6144 + an];
        float* mod = WSP(float, WS_MOD);
#pragma unroll
        for (int r = 0; r < 9; ++r) mod[(size_t)(al * 9 + r) * 6144 + an] = ((red[((wave + 0) * 9 + r) * 64 + lane] + red[((wave + 1) * 9 + r) * 64 + lane]) + (red[((wave + 2) * 9 + r) * 64 + lane] + red[((wave + 3) * 9 + r) * 64 + lane])) + bb;
    }
    const int gw = F.vcu * NWAVES + wave, NGW = F.G * NWAVES;
    for (int it = gw; it < IT_LAYER; it += NGW) { const ConvItem c = conv_decode(A, F, 0, it); float v[64]; conv_load(c, lane, v); conv_store(c, lane, v); }
}

__device__ __forceinline__ void phase_proB(const Args& A, Frame& F) {
    const int wave = F.wave, lane = lane_id();
    const int gw = F.vcu * NWAVES + wave, NGW = F.G * NWAVES;
    const float* mod = WSP(float, WS_MOD);
    for (int pr = gw; pr < M / 2; pr += NGW) {
        const int m0 = 2 * pr, b = m0 / T, t = m0 % T; const int r = t < CTX ? 8 : b;
        const float* src = t < CTX ? A.in[I_CTX] + ((size_t)b * CTX + t) * D : A.in[I_X] + ((size_t)b * SEQ + (t - CTX)) * D;
        Row x0, x1, h; row_load_f32(x0, src, lane); row_load_f32(x1, src + D, lane);
        row_store_bf16(x0, WSP(bf16, WS_X) + (size_t)m0 * D, lane); row_store_bf16(x1, WSP(bf16, WS_X) + (size_t)(m0 + 1) * D, lane);
        const float* md = mod + (size_t)(0 * 9 + r) * 6144;
        const float r0 = row_rstd(x0), r1 = row_rstd(x1);
        row_modulate(h, x0, r0, A.in[I_N1G], md + 1024, md, lane); row_store_fp8(h, WSP(unsigned char, WS_H) + (size_t)m0 * D, lane);
        row_modulate(h, x1, r1, A.in[I_N1G], md + 1024, md, lane); row_store_fp8(h, WSP(unsigned char, WS_H) + (size_t)(m0 + 1) * D, lane);
    }
}

constexpr float LOG2E = 1.4426950408889634f;
constexpr float QS32 = 0.17677669529663687f * LOG2E, QS64 = 0.125f * LOG2E;
__device__ __forceinline__ float rnd_bf(float x) { return __builtin_bit_cast(float, f2bf(x) << 16); }
__device__ __forceinline__ void unpack8(const v4u w, float (&x)[8]) { x[0] = bflo(w.x); x[1] = bfhi(w.x); x[2] = bflo(w.y); x[3] = bfhi(w.y); x[4] = bflo(w.z); x[5] = bfhi(w.z); x[6] = bflo(w.w); x[7] = bfhi(w.w); }
__device__ __forceinline__ v4u pack8f(const float (&x)[8]) { v4u w; w.x = pk2(x[0], x[1]); w.y = pk2(x[2], x[3]); w.z = pk2(x[4], x[5]); w.w = pk2(x[6], x[7]); return w; }
__device__ __forceinline__ float sumsq_rounded(const v4u w) { return bflo(w.x) * bflo(w.x) + bfhi(w.x) * bfhi(w.x) + bflo(w.y) * bflo(w.y) + bfhi(w.y) * bfhi(w.y) + bflo(w.z) * bflo(w.z) + bfhi(w.z) * bfhi(w.z) + bflo(w.w) * bflo(w.w) + bfhi(w.w) * bfhi(w.w); }
__device__ __forceinline__ void pp_token(bf16* prow, bool lat, int grow, int gcol, int lane, int tl, const LAS float* t64, const LAS float* t32, LAS bf16* vt,
                                         const float (&g0)[8], const float (&g1)[8], float& km0, float& km2, float& km3, float& km4) {
    const int sub = lane & 7, sg = lane >> 3;
    v4u w[5];
#pragma unroll
    for (int ld = 0; ld < 5; ++ld) { const bool isq = (ld == 0 || ld == 4) ? sg < 4 : ((ld == 1 || ld == 2) ? sg >= 4 : false);
        w[ld] = (v4u){0u, 0u, 0u, 0u}; if (!isq) w[ld] = ((const GAS v4u*)prow)[ld * 64 + lane]; }
    { float x[8], cs[8], sn[8]; unpack8(w[0], x);
      const int pos = (sub & 2) ? gcol : grow;
#pragma unroll
      for (int q = 0; q < 4; ++q) { const f32x4 tv = lat ? *(const LAS f32x4*)(t32 + pos * 16 + 4 * q) : (f32x4){1.f, 0.f, 1.f, 0.f}; cs[2 * q] = tv[0]; sn[2 * q] = tv[1]; cs[2 * q + 1] = tv[2]; sn[2 * q + 1] = tv[3]; }
      const float sc = sg < 4 ? QS32 : 1.0f; const bool second = sub & 1;
#pragma unroll
      for (int e = 0; e < 8; ++e) { const float pr = sx<1>(x[e]); x[e] = (second ? x[e] * cs[e] + pr * sn[e] : x[e] * cs[e] - pr * sn[e]) * sc; }
      const v4u o = pack8f(x); if (sg >= 4) ((GAS v4u*)prow)[lane] = o;
      float ss = sumsq_rounded(o); ss += sx<1>(ss); ss += sx<2>(ss); if (sg >= 4) km0 = fmaxf(km0, ss); }
    float c64[8], s64[8];
    { const int pos = (sub & 4) ? gcol : grow;
#pragma unroll
      for (int q = 0; q < 4; ++q) { const f32x4 tv = lat ? *(const LAS f32x4*)(t64 + (pos * 16 + 8 * (sub & 1)) * 2 + 4 * q) : (f32x4){1.f, 0.f, 1.f, 0.f}; c64[2 * q] = tv[0]; s64[2 * q] = tv[1]; c64[2 * q + 1] = tv[2]; s64[2 * q + 1] = tv[3]; } }
    const bool second64 = sub & 2;
    { float x[8]; unpack8(w[1], x);
      float ss = 0.f;
#pragma unroll
      for (int e = 0; e < 8; ++e) ss += x[e] * x[e];
      ss += sx<1>(ss); ss += sx<2>(ss); ss += sx<4>(ss);
      const float rs = 1.0f / sqrtf(ss * (1.0f / 64.0f) + EPS);
      if (sg >= 4) {
#pragma unroll
          for (int e = 0; e < 8; ++e) x[e] *= rs * g0[e]; }
#pragma unroll
      for (int e = 0; e < 8; ++e) { const float pr = sx<2>(x[e]); x[e] = (second64 ? x[e] * c64[e] + pr * s64[e] : x[e] * c64[e] - pr * s64[e]) * QS64; }
      if (sg < 4) { const int vh = sg; const unsigned short* hv = (const unsigned short*)&w[1];
#pragma unroll
          for (int e = 0; e < 8; ++e) vt[(vh * 64 + 8 * sub + e) * 66 + tl] = hv[e]; } }
    { float x[8]; unpack8(w[2], x);
      float ss = 0.f;
#pragma unroll
      for (int e = 0; e < 8; ++e) ss += x[e] * x[e];
      ss += sx<1>(ss); ss += sx<2>(ss); ss += sx<4>(ss);
      const float rs = 1.0f / sqrtf(ss * (1.0f / 64.0f) + EPS);
      if (sg < 2) {
#pragma unroll
          for (int e = 0; e < 8; ++e) x[e] *= rs * g1[e]; }
      const bool rope = sg < 2; const float sc = sg >= 4 ? QS64 : 1.0f;
#pragma unroll
      for (int e = 0; e < 8; ++e) { const float pr = sx<2>(x[e]); const float cc = rope ? c64[e] : 1.f, sv = rope ? s64[e] : 0.f; x[e] = (second64 ? x[e] * cc + pr * sv : x[e] * cc - pr * sv) * sc; }
      const v4u o = pack8f(x);
      if (sg < 2) ((GAS v4u*)prow)[128 + lane] = o;
      else if (sg < 4) { const int vh = 4 + (sg - 2); const unsigned short* hv = (const unsigned short*)&w[2];
#pragma unroll
          for (int e = 0; e < 8; ++e) vt[(vh * 64 + 8 * sub + e) * 66 + tl] = hv[e]; }
      float s2 = sumsq_rounded(o); s2 += sx<1>(s2); s2 += sx<2>(s2); s2 += sx<4>(s2); if (sg < 2) km2 = fmaxf(km2, s2); }
    { float s2 = sumsq_rounded(w[3]); s2 += sx<1>(s2); s2 += sx<2>(s2); s2 += sx<4>(s2); if (sg < 4) km3 = fmaxf(km3, s2);
      if (sg >= 4) { const int vh = 6 + (sg - 4); const unsigned short* hv = (const unsigned short*)&w[3];
#pragma unroll
          for (int e = 0; e < 8; ++e) vt[(vh * 64 + 8 * sub + e) * 66 + tl] = hv[e]; } }
    { float x[8]; unpack8(w[4], x);
      const float sc = sg < 4 ? QS64 : 1.0f;
#pragma unroll
      for (int e = 0; e < 8; ++e) { const float pr = sx<2>(x[e]); x[e] = (second64 ? x[e] * c64[e] + pr * s64[e] : x[e] * c64[e] - pr * s64[e]) * sc; }
      const v4u o = pack8f(x);
      if (sg == 4 || sg == 5) ((GAS v4u*)prow)[256 + lane] = o;
      else if (sg >= 6) { const int vh = 10 + (sg - 6); const unsigned short* hv = (const unsigned short*)&w[4];
#pragma unroll
          for (int e = 0; e < 8; ++e) vt[(vh * 64 + 8 * sub + e) * 66 + tl] = hv[e]; }
      float s2 = sumsq_rounded(o); s2 += sx<1>(s2); s2 += sx<2>(s2); s2 += sx<4>(s2); if (sg == 4 || sg == 5) km4 = fmaxf(km4, s2); }
}
__device__ __forceinline__ void phase_post_proj(const Args& A, Frame& F, int l) {
    const int wave = F.wave, lane0 = lane_id(), tid = wave * 64 + lane0;
    LAS bf16* vt = (LAS bf16*)F.lds;
    LAS float* t64 = (LAS float*)(F.lds + 102400);
    LAS float* t32 = (LAS float*)(F.lds + 102400 + 8192);
    LAS unsigned* kmx = (LAS unsigned*)(F.lds + 102400 + 8192 + 4096);
    for (int i = tid; i < 64 * 16; i += NWAVES * 64) { const int pos = i >> 4, f = i & 15; const float inv = exp2f(-(float)f * (13.287712379549449f / 16.0f)); const float a = (float)pos * inv; t64[2 * i] = cosf(a); t64[2 * i + 1] = sinf(a); }
    for (int i = tid; i < 64 * 8; i += NWAVES * 64) { const int pos = i >> 3, f = i & 7; const float inv = exp2f(-(float)f * (13.287712379549449f / 8.0f)); const float a = (float)pos * inv; t32[2 * i] = cosf(a); t32[2 * i + 1] = sinf(a); }
    if (tid < 16) kmx[tid] = 0u;
    __syncthreads();
    bf16* P = WSP(bf16, WS_P); bf16* VT = WSP(bf16, WS_VT);
    for (int tile = F.vcu; tile < M / 64; tile += F.G) {
        const int lane = lane_id(), sub = lane & 7, sg = lane >> 3;
        float g0[8], g1[8];
#pragma unroll
        for (int e = 0; e < 8; ++e) { g0[e] = A.in[I_QKG][l * 128 + 8 * sub + e]; g1[e] = A.in[I_QKG][l * 128 + 64 + 8 * sub + e]; }
        float km0 = 0.f, km2 = 0.f, km3 = 0.f, km4 = 0.f;
#pragma unroll 2
        for (int tk = 0; tk < 8; ++tk) {
            const int tl = wave * 8 + tk, m = tile * 64 + tl, t = m % T;
            const bool lat = t >= CTX; const int sp = t - CTX;
            pp_token(P + (size_t)m * INW, lat, sp >> 6, sp & 63, lane, tl, t64, t32, vt, g0, g1, km0, km2, km3, km4);
        }
        if (sg >= 4 && (sub & 3) == 0) __hip_atomic_fetch_max(kmx + 2 * (sg - 4) + (sub >> 2), __builtin_bit_cast(unsigned, km0), __ATOMIC_RELAXED, __HIP_MEMORY_SCOPE_WORKGROUP);
        if (sub == 0) { if (sg < 2) __hip_atomic_fetch_max(kmx + 8 + sg, __builtin_bit_cast(unsigned, km2), __ATOMIC_RELAXED, __HIP_MEMORY_SCOPE_WORKGROUP);
                        if (sg < 4) __hip_atomic_fetch_max(kmx + 10 + sg, __builtin_bit_cast(unsigned, km3), __ATOMIC_RELAXED, __HIP_MEMORY_SCOPE_WORKGROUP);
                        if (sg == 4 || sg == 5) __hip_atomic_fetch_max(kmx + 14 + (sg - 4), __builtin_bit_cast(unsigned, km4), __ATOMIC_RELAXED, __HIP_MEMORY_SCOPE_WORKGROUP); }
        const int b = (tile * 64) / T, t0 = (tile * 64) % T;
        __syncthreads();
        if (tid < 16) { __hip_atomic_fetch_max(F.ctl + CW_KMAX + (l * NB + b) * 16 + tid, kmx[tid], RLX_AGENT); kmx[tid] = 0u; }
        for (int idx = tid; idx < 768 * 8; idx += NWAVES * 64) { const int row = idx >> 3, ch = idx & 7;
            const LAS unsigned* sp = (const LAS unsigned*)((const LAS unsigned char*)vt + row * 132 + ch * 16);
            v4u w; w.x = sp[0]; w.y = sp[1]; w.z = sp[2]; w.w = sp[3];
            *(GAS v4u*)(VT + ((size_t)b * 768 + row) * T + t0 + ch * 8) = w; }
        __syncthreads();
    }
}

namespace att {
typedef float f32x16 __attribute__((ext_vector_type(16)));
constexpr float CAT_SCALE = 8.0f;
constexpr int NSLOT = 6, K_RING = 0, V_RING = NSLOT * 8192, RPB_OFF = 2 * NSLOT * 8192, UW_OFF = RPB_OFF + 2048, ZB_OFF = RPB_OFF + 2304;
__device__ __forceinline__ int swap23(int r) { return (r & ~12) | ((r & 4) << 1) | ((r & 8) >> 1); }
__device__ __forceinline__ bf16x8 pack8(const f32x16& p, int base) {
    v4u w; w.x = pg8::cvt_pk_bf16(p[base + 0], p[base + 1]); w.y = pg8::cvt_pk_bf16(p[base + 2], p[base + 3]); w.z = pg8::cvt_pk_bf16(p[base + 4], p[base + 5]); w.w = pg8::cvt_pk_bf16(p[base + 6], p[base + 7]);
    return __builtin_bit_cast(bf16x8, w);
}
__device__ __forceinline__ float sumsq8(bf16x8 q) { const v4u w = __builtin_bit_cast(v4u, q); float s = 0.f;
    s += bflo(w.x) * bflo(w.x) + bfhi(w.x) * bfhi(w.x) + bflo(w.y) * bflo(w.y) + bfhi(w.y) * bfhi(w.y) + bflo(w.z) * bflo(w.z) + bfhi(w.z) * bfhi(w.z) + bflo(w.w) * bflo(w.w) + bfhi(w.w) * bfhi(w.w); return s; }

template <bool SHIFT>
__device__ __forceinline__ void sm_chunk(f32x16& pc, int c, float negm, float& ps, bf16x8 (&pq)[2]) {
#pragma unroll
    for (int j = 4 * c; j < 4 * c + 4; ++j) { float x = pc[j]; if (SHIFT) x += negm; pc[j] = __builtin_amdgcn_exp2f(x); }
    ps += (pc[4 * c] + pc[4 * c + 1]) + (pc[4 * c + 2] + pc[4 * c + 3]); asm volatile("" : "+v"(ps));
    if (c == 1) pq[0] = pack8(pc, 0);
    if (c == 3) pq[1] = pack8(pc, 8);
}
template <bool SHIFT>
__device__ __forceinline__ void sm_half(f32x16& pc, int c2, float negm, float& ps, bf16x8 (&pq)[2]) {
#pragma unroll
    for (int j = 2 * c2; j < 2 * c2 + 2; ++j) { float x = pc[j]; if (SHIFT) x += negm; pc[j] = __builtin_amdgcn_exp2f(x); }
    ps += pc[2 * c2] + pc[2 * c2 + 1]; asm volatile("" : "+v"(ps));
    if (c2 == 3) pq[0] = pack8(pc, 0);
    if (c2 == 7) pq[1] = pack8(pc, 8);
}
template <int NK>
__device__ __forceinline__ void mf_qk(f32x16& pn, const bf16x8 (&kf)[NK], const bf16x8 (&qfq)[NK], int kk) {
    if (kk == 0) { f32x16 z;
#pragma unroll
        for (int j = 0; j < 16; ++j) z[j] = 0.f;
        pn = __builtin_amdgcn_mfma_f32_32x32x16_bf16(kf[0], qfq[0], z, 0, 0, 0); }
    else pn = __builtin_amdgcn_mfma_f32_32x32x16_bf16(kf[kk], qfq[kk], pn, 0, 0, 0);
}
__device__ __forceinline__ void mf_pv(f32x16 (&Oq)[2], const bf16x8 (&vf)[2][2], const bf16x8 (&pp)[2], int pv) { const int s2 = pv >> 1, dvb = pv & 1;
    Oq[dvb] = __builtin_amdgcn_mfma_f32_32x32x16_bf16(vf[dvb][s2], pp[s2], Oq[dvb], 0, 0, 0); }
template <int NK>
__device__ __forceinline__ void attn_pro(const LAS unsigned char* k0, const int (&kofs)[NK], const bf16x8 (&qf)[2][NK], f32x16& pn, bf16x8 (&pp)[2], bf16x8 (&kf)[NK], bf16x8 (&vf)[2][2]) {
#pragma unroll
    for (int kk = 0; kk < NK; ++kk) kf[kk] = *(const LAS bf16x8*)(k0 + kofs[kk]);
    const bf16x8 zb = __builtin_bit_cast(bf16x8, (v4u){0u, 0u, 0u, 0u});
    pp[0] = zb; pp[1] = zb; vf[0][0] = zb; vf[0][1] = zb; vf[1][0] = zb; vf[1][1] = zb;
    __builtin_amdgcn_sched_barrier(0);
#pragma unroll
    for (int kk = 0; kk < NK; ++kk) mf_qk<NK>(pn, kf, qf[0], kk);
    __builtin_amdgcn_sched_barrier(0);
}
template <int NK, bool SHIFT>
__device__ __forceinline__ void attn_r06(const LAS unsigned char* k0, const LAS unsigned char* v0, const int (&kofs)[NK], const int (&vofs)[4], const bf16x8 (&qf)[2][NK], const float (&negM)[2], f32x16 (&O)[2][2],
                                         f32x16& pn, bf16x8 (&pp)[2], bf16x8 (&kf)[NK], bf16x8 (&vf)[2][2], float (&ps)[2]) {
#pragma unroll
    for (int it = 0; it < 7; ++it) {
        const int q = it & 1, qn = (it + 1) & 1, qp = (it - 1) & 1;
        f32x16 pc = pn; bf16x8 pq[2];
        if (it & 1) {
            const LAS unsigned char* kn = k0 + 8192 * ((it + 1) >> 2) + 4096 * (((it + 1) >> 1) & 1);
#pragma unroll
            for (int kk = 0; kk < NK; ++kk) kf[kk] = *(const LAS bf16x8*)(kn + kofs[kk]);
            const LAS unsigned char* vp = v0 + 8192 * ((it - 1) >> 2); const int sp = 2 * (((it - 1) >> 1) & 1);
#pragma unroll
            for (int dvb = 0; dvb < 2; ++dvb)
#pragma unroll
                for (int s2 = 0; s2 < 2; ++s2) vf[dvb][s2] = *(const LAS bf16x8*)(vp + dvb * 4096 + vofs[sp + s2]);
        }
        __builtin_amdgcn_sched_barrier(0);
        constexpr int M = NK + 4;
#pragma unroll
        for (int c = 0; c < 8; ++c) {
            sm_half<SHIFT>(pc, c, negM[q], ps[q], pq);
            __builtin_amdgcn_sched_barrier(0);
#pragma unroll
            for (int m = (c * M) / 8; m < ((c + 1) * M) / 8; ++m) {
                int kq = -1, pv = -1;
                if (NK == 2) { if (m % 3 == 0) kq = m / 3; else pv = (m / 3) * 2 + (m % 3) - 1; } else { if ((m & 1) == 0) kq = m >> 1; else pv = m >> 1; }
                if (kq >= 0) mf_qk<NK>(pn, kf, qf[qn], kq); else mf_pv(O[qp], vf, pp, pv);
            }
            __builtin_amdgcn_sched_barrier(0);
        }
        pp[0] = pq[0]; pp[1] = pq[1];
    }
}
template <bool SHIFT>
__device__ __forceinline__ void attn_r7a(const LAS unsigned char* v0, const int (&vofs)[4], const float (&negM)[2], f32x16 (&O)[2][2],
                                         const f32x16& pn, f32x16& pc, const bf16x8 (&pp)[2], bf16x8 (&pq)[2], bf16x8 (&vf)[2][2], float (&ps)[2]) {
    pc = pn;
#pragma unroll
    for (int dvb = 0; dvb < 2; ++dvb)
#pragma unroll
        for (int s2 = 0; s2 < 2; ++s2) vf[dvb][s2] = *(const LAS bf16x8*)(v0 + 8192 + dvb * 4096 + vofs[2 + s2]);
    __builtin_amdgcn_sched_barrier(0);
    sm_chunk<SHIFT>(pc, 0, negM[1], ps[1], pq);
    __builtin_amdgcn_sched_barrier(0);
    mf_pv(O[0], vf, pp, 0);
    __builtin_amdgcn_sched_barrier(0);
    asm volatile("s_waitcnt lgkmcnt(0)" ::: "memory");
}
template <int NK, bool SHIFT>
__device__ __forceinline__ void attn_r7b(const LAS unsigned char* kn, const int (&kofs)[NK], const bf16x8 (&qf)[2][NK], const float (&negM)[2], f32x16 (&O)[2][2],
                                         f32x16& pn, f32x16& pc, bf16x8 (&pp)[2], bf16x8 (&pq)[2], bf16x8 (&kf)[NK], const bf16x8 (&vf)[2][2], float (&ps)[2]) {
#pragma unroll
    for (int kk = 0; kk < NK; ++kk) kf[kk] = *(const LAS bf16x8*)(kn + kofs[kk]);
    __builtin_amdgcn_sched_barrier(0);
    sm_chunk<SHIFT>(pc, 1, negM[1], ps[1], pq);
    __builtin_amdgcn_sched_barrier(0);
    mf_pv(O[0], vf, pp, 1); if (NK == 4) mf_qk<NK>(pn, kf, qf[0], 0);
    __builtin_amdgcn_sched_barrier(0);
    sm_chunk<SHIFT>(pc, 2, negM[1], ps[1], pq);
    __builtin_amdgcn_sched_barrier(0);
    if (NK == 4) { mf_qk<NK>(pn, kf, qf[0], 1); mf_qk<NK>(pn, kf, qf[0], 2); } else { mf_qk<NK>(pn, kf, qf[0], 0); mf_qk<NK>(pn, kf, qf[0], 1); }
    __builtin_amdgcn_sched_barrier(0);
    sm_chunk<SHIFT>(pc, 3, negM[1], ps[1], pq);
    __builtin_amdgcn_sched_barrier(0);
    if (NK == 4) mf_qk<NK>(pn, kf, qf[0], 3);
    mf_pv(O[0], vf, pp, 2); mf_pv(O[0], vf, pp, 3);
    __builtin_amdgcn_sched_barrier(0);
    pp[0] = pq[0]; pp[1] = pq[1];
}

template <int MSK>
__device__ __forceinline__ void sm_chunk_m(LAS unsigned char* lds, f32x16& pc, int c, int kbk, int q, float negm, float& ps, bf16x8 (&pq)[2], int ma, int mb, unsigned lim, bool nbr) {
    const bool dead = MSK != 0 && nbr && ((q == 0 && kbk == 1 && c >= 2) || (q == 1 && kbk == 0 && c < 2));
#pragma unroll
    for (int i = 0; i < 4; ++i) { const int j = 4 * c + i, C = 16 * (c >> 1) + 4 * (c & 1) + i + 32 * kbk;
        if (dead) pc[j] = 0.f;
        else if (MSK == 0) pc[j] = __builtin_amdgcn_exp2f(pc[j] + negm);
        else { const float x = pc[j] + negm + *(const LAS float*)(lds + mb + 4 * C);
            const float e = __builtin_amdgcn_exp2f(x);
            pc[j] = ((unsigned)(ma + C) <= lim) ? e : 0.f; } }
    if (!dead) ps += (pc[4 * c] + pc[4 * c + 1]) + (pc[4 * c + 2] + pc[4 * c + 3]); asm volatile("" : "+v"(ps));
    if (c == 1) pq[0] = pack8(pc, 0);
    if (c == 3) pq[1] = pack8(pc, 8);
}
template <int MSK>
__device__ __forceinline__ void attn_tile_m(LAS unsigned char* lds, const LAS unsigned char* kb, const LAS unsigned char* vb, const int (&kofs)[4], const int (&vofs)[4], const bf16x8 (&qf)[2][4], const float (&negM)[2],
                                            f32x16 (&O)[2][2], float (&lsum)[2], const int (&ma)[2], const int (&mb)[2], unsigned lim, bool nbr) {
    f32x16 pn; bf16x8 pp[2], kf[4], vf[2][2];
#pragma unroll
    for (int kk = 0; kk < 4; ++kk) kf[kk] = *(const LAS bf16x8*)(kb + kofs[kk]);
    __builtin_amdgcn_sched_barrier(0);
#pragma unroll
    for (int kk = 0; kk < 4; ++kk) mf_qk<4>(pn, kf, qf[0], kk);
    __builtin_amdgcn_sched_barrier(0);
    float ps[2] = {0.f, 0.f};
#pragma unroll
    for (int it = 0; it < 4; ++it) {
        const int kbk = it >> 1, q = it & 1, qn = (it + 1) & 1, qp = (it - 1) & 1;
        f32x16 pc = pn; bf16x8 pq[2];
        if (it == 1) {
#pragma unroll
            for (int kk = 0; kk < 4; ++kk) kf[kk] = *(const LAS bf16x8*)(kb + 4096 + kofs[kk]); }
        if (it & 1) {
#pragma unroll
            for (int dvb = 0; dvb < 2; ++dvb)
#pragma unroll
                for (int s2 = 0; s2 < 2; ++s2) vf[dvb][s2] = *(const LAS bf16x8*)(vb + dvb * 4096 + vofs[(it == 3 ? 2 : 0) + s2]); }
        __builtin_amdgcn_sched_barrier(0);
        const bool hasq = it < 3, hasp = it >= 1; const int M = (hasq ? 4 : 0) + (hasp ? 4 : 0);
#pragma unroll
        for (int c = 0; c < 4; ++c) {
            sm_chunk_m<MSK>(lds, pc, c, kbk, q, negM[q], ps[q], pq, ma[q], mb[q], lim, nbr);
            __builtin_amdgcn_sched_barrier(0);
#pragma unroll
            for (int m = (c * M) / 4; m < ((c + 1) * M) / 4; ++m) {
                int kq = -1, pv = -1;
                if (hasq && hasp) { if ((m & 1) == 0) kq = m >> 1; else pv = m >> 1; } else if (hasq) kq = m; else pv = m;
                if (kq >= 0) mf_qk<4>(pn, kf, qf[qn], kq); else mf_pv(O[qp], vf, pp, pv);
            }
            __builtin_amdgcn_sched_barrier(0);
        }
        pp[0] = pq[0]; pp[1] = pq[1];
    }
#pragma unroll
    for (int pv = 0; pv < 4; ++pv) mf_pv(O[1], vf, pp, pv);
    __builtin_amdgcn_sched_barrier(0);
    lsum[0] += ps[0]; lsum[1] += ps[1];
}

template <bool DIFF>
__device__ __forceinline__ void unit(const Args& A, Frame& F, int l, int mode, int b, int hk, int qblk, bool is_ctx, float lam, float lam_init) {
    const int wave = F.wave, lane = lane_id(), r = lane & 31, h = lane >> 5;
    LAS unsigned char* lds = F.lds;
    const bf16* P = WSP(bf16, WS_P); const bf16* VT = WSP(bf16, WS_VT);
    const bool gqa = (mode & 1) != 0;
    const int mp = DIFF ? (wave >> 2) : 0;
    const int head = gqa ? 2 * hk + (wave >> 2) : hk;
    const bool wave_on = !(mode == 2 && is_ctx && wave >= 4);
    const int pos0w = (mode == 2 && !is_ctx) ? qblk * 512 + 64 * wave : qblk * 256 + 64 * (wave & 3);
    const int qcol = mode == 0 ? 64 * head + 32 * mp : (mode == 1 ? 768 + 64 * head : (mode == 2 ? 1280 + 64 * head : 2048 + 64 * head));
    const int kcol = mode == 0 ? 256 + 64 * hk : (mode == 1 ? 1024 + 64 * hk : (mode == 2 ? 1536 + 64 * hk : 2304 + 64 * hk));
    const int vh = mode == 0 ? hk : (mode == 1 ? 4 + hk : (mode == 2 ? 6 + hk : 10 + hk));
    const int kid = mode == 0 ? 2 * hk + mp : (mode == 1 ? 8 + hk : (mode == 2 ? 10 + hk : 14 + hk));
    const int ocol = mode * 256 + 64 * head;
    constexpr int NK = DIFF ? 2 : 4;
    size_t mq[2];
    bf16x8 qf[2][NK];
#pragma unroll
    for (int qb = 0; qb < 2; ++qb) { const int pos = pos0w + 32 * qb + r; mq[qb] = (size_t)b * T + (is_ctx ? pos : CTX + pos);
#pragma unroll
        for (int kk = 0; kk < NK; ++kk) qf[qb][kk] = *(const bf16x8*)(P + mq[qb] * INW + qcol + 16 * kk + 8 * h); }
#pragma unroll
    for (int qb = 0; qb < 2; ++qb) {
        const int pos = pos0w + 32 * qb + r, grow = pos >> 6, gcol = pos & 63;
        float x[NK][8];
#pragma unroll
        for (int kk = 0; kk < NK; ++kk) unpack8(__builtin_bit_cast(v4u, qf[qb][kk]), x[kk]);
        if (!DIFF && mode == 1) {
            float ss = 0.f;
#pragma unroll
            for (int kk = 0; kk < NK; ++kk)
#pragma unroll
                for (int e = 0; e < 8; ++e) ss += x[kk][e] * x[kk][e];
            ss = sum32(ss);
            const float rs = 1.0f / sqrtf(ss * (1.0f / 64.0f) + EPS);
#pragma unroll
            for (int kk = 0; kk < NK; ++kk)
#pragma unroll
                for (int e = 0; e < 8; ++e) x[kk][e] *= rs * A.in[I_QKG][l * 128 + 16 * kk + 8 * h + e];
        }
        if (!is_ctx && mode != 2) {
            if (DIFF) {
#pragma unroll
                for (int kk = 0; kk < 2; ++kk) { const float pv = (float)(kk ? gcol : grow);
#pragma unroll
                    for (int e = 0; e < 8; ++e) { const float a = pv * exp2f(-(float)e * (13.287712379549449f / 8.0f)); const float c = __cosf(a), sn = __sinf(a);
                        const float pr = other32(x[kk][e], false); x[kk][e] = h ? x[kk][e] * c + pr * sn : x[kk][e] * c - pr * sn; } }
            } else {
#pragma unroll
                for (int hf = 0; hf < 2; ++hf) { const float pv = (float)(hf ? gcol : grow);
#pragma unroll
                    for (int e = 0; e < 8; ++e) { const float a = pv * exp2f(-(float)(8 * h + e) * (13.287712379549449f / 16.0f)); const float c = __cosf(a), sn = __sinf(a);
                        const float x1 = x[(2 * hf) % NK][e], x2 = x[(2 * hf + 1) % NK][e]; x[(2 * hf) % NK][e] = x1 * c - x2 * sn; x[(2 * hf + 1) % NK][e] = x2 * c + x1 * sn; } }
            }
        }
        const float qsc = DIFF ? QS32 : QS64;
#pragma unroll
        for (int kk = 0; kk < NK; ++kk) {
#pragma unroll
            for (int e = 0; e < 8; ++e) x[kk][e] *= qsc;
            qf[qb][kk] = __builtin_bit_cast(bf16x8, pack8f(x[kk])); }
    }
    const unsigned* km = F.ctl + CW_KMAX + (l * NB + b) * 16;
    float bias_max = 0.f;
    LAS float* rpbL = (LAS float*)(lds + RPB_OFF);
    if (!DIFF && wave == 0) ((LAS float*)(lds + ZB_OFF))[lane] = 0.f;
    if (mode == 2 && !is_ctx) {
        const float* rp = A.in[I_RPB] + (size_t)(l * 4 + hk) * 465;
        for (int i = wave * 64 + lane; i < 465; i += NWAVES * 64) { const float v = rp[i] * LOG2E; rpbL[(i / 31) * 32 + (i % 31)] = v; }
        float mx = 0.f; for (int i = lane; i < 465; i += 64) mx = fmaxf(mx, fabsf(rp[i]) * LOG2E);
        mx = fmaxf(mx, sx<1>(mx)); mx = fmaxf(mx, sx<2>(mx)); mx = fmaxf(mx, sx<4>(mx)); mx = fmaxf(mx, sx<8>(mx)); mx = fmaxf(mx, sx<16>(mx)); mx = max32(mx);
        bias_max = mx;
    }
    const float kmx = __builtin_bit_cast(float, __hip_atomic_load(km + kid, RLX_AGENT));
    float negM[2];
#pragma unroll
    for (int qb = 0; qb < 2; ++qb) { float s0 = 0.f;
#pragma unroll
        for (int kk = 0; kk < NK; ++kk) s0 += sumsq8(qf[qb][kk]);
        s0 = sum32(s0); negM[qb] = -(sqrtf(s0 * kmx) * 1.0001f + bias_max); }
    const bool shift = __any((negM[0] < -96.f) || (negM[1] < -96.f)) != 0;
    if (!shift) { negM[0] = 0.f; negM[1] = 0.f; }
    int lt0 = 0, lt1 = 0;
    if (!is_ctx) {
        if (mode <= 1) { lt0 = 4; lt1 = 68; }
        else if (mode == 2) { const int R = 8 * qblk; lt0 = 4 + min(max(R - 4, 0), 56); lt1 = 4 + min(max(R + 7 - 4, 0), 56) + 8; }
        else { const int s0 = qblk * 256; lt0 = 4 + max(0, (s0 - 128) >> 6); lt1 = 4 + min(63, (s0 + 255 + 128) >> 6) + 1; }
    }
    const int ntiles = 4 + (lt1 - lt0);
    const int pidx = wave * 64 + lane, rho = pidx >> 3, cch = (pidx & 7) ^ ((rho >> 1) & 7);
    const char* kbase = (const char*)(P + (size_t)b * T * INW + kcol);
    const char* vbase = (const char*)(VT + ((size_t)b * 12 + vh) * 64 * T);
    const unsigned koff = (unsigned)(rho * INW + cch * 8) * 2u, voff = (unsigned)(rho * T + cch * 8) * 2u;
#define ATT_ISSUE(ti_) ATT_ISSUE_AT(min((int)(ti_), ntiles - 1), (ti_) % NSLOT)
#define ATT_ISSUE_AT(ti_, bufi_) do { const int kt_ = (ti_) < 4 ? (ti_) : lt0 + (ti_) - 4; const int bf_ = (bufi_); \
        pg8::glds16s(kbase + (size_t)kt_ * (64 * INW * 2), koff, (unsigned)(size_t)(lds + K_RING + bf_ * 8192 + wave * 1024)); \
        pg8::glds16s(vbase + (size_t)kt_ * 128, voff, (unsigned)(size_t)(lds + V_RING + bf_ * 8192 + wave * 1024)); } while (0)
    const int xk = swap23(r), gk = (xk >> 1) & 7, gv = (r >> 1) & 7;
    int kofs[NK], vofs[4];
#pragma unroll
    for (int i = 0; i < NK; ++i) kofs[i] = xk * 128 + (((2 * (i + NK * mp) + h) ^ gk) << 4);
#pragma unroll
    for (int i = 0; i < 4; ++i) vofs[i] = r * 128 + (((2 * i + h) ^ gv) << 4);
    const int rw = pos0w >> 6, r0w = min(max(rw - 4, 0), 56);
    f32x16 O[2][2];
#pragma unroll
    for (int qb = 0; qb < 2; ++qb)
#pragma unroll
        for (int i = 0; i < 2; ++i)
#pragma unroll
            for (int j = 0; j < 16; ++j) O[qb][i][j] = 0.f;
    float lsum[2] = {0.f, 0.f};
    ATT_ISSUE(0); ATT_ISSUE(1); ATT_ISSUE(2); ATT_ISSUE(3);
    const int npairs = (ntiles + 1) >> 1;
    if (DIFF || mode == 1) {
#define PIPE_LOOP(SH_) { f32x16 pn_; bf16x8 pp_[2], kf_[NK], vf_[2][2]; float ps_[2] = {0.f, 0.f}; \
        asm volatile("s_waitcnt vmcnt(4)" ::: "memory"); __builtin_amdgcn_s_barrier(); asm volatile("" ::: "memory"); \
        ATT_ISSUE(4); ATT_ISSUE(5); \
        attn_pro<NK>(lds + K_RING, kofs, qf, pn_, pp_, kf_, vf_); \
        _Pragma("clang loop unroll(disable)") for (int tp = 0; tp < npairs; ++tp) { \
            const int b0_ = (2 * tp) % NSLOT; const LAS unsigned char* k0_ = lds + K_RING + b0_ * 8192; const LAS unsigned char* v0_ = lds + V_RING + b0_ * 8192; \
            f32x16 pc_; bf16x8 pq_[2]; \
            attn_r06<NK, SH_>(k0_, v0_, kofs, vofs, qf, negM, O, pn_, pp_, kf_, vf_, ps_); \
            attn_r7a<SH_>(v0_, vofs, negM, O, pn_, pc_, pp_, pq_, vf_, ps_); \
            asm volatile("s_waitcnt vmcnt(4)" ::: "memory"); __builtin_amdgcn_s_barrier(); asm volatile("" ::: "memory");     \
            ATT_ISSUE(2 * tp + 6); ATT_ISSUE(2 * tp + 7); \
            attn_r7b<NK, SH_>(lds + K_RING + ((2 * tp + 2) % NSLOT) * 8192, kofs, qf, negM, O, pn_, pc_, pp_, pq_, kf_, vf_, ps_); } \
        _Pragma("unroll") for (int pv_ = 0; pv_ < 4; ++pv_) mf_pv(O[1], vf_, pp_, pv_);     \
        __builtin_amdgcn_sched_barrier(0); lsum[0] += ps_[0]; lsum[1] += ps_[1]; }
        if (shift) PIPE_LOOP(true) else PIPE_LOOP(false)
#undef PIPE_LOOP
    } else if constexpr (!DIFF) {
#define MASK_LOOP(TP0_, TP1_, MT_) _Pragma("clang loop unroll(disable)") for (int tp = (TP0_); tp < (TP1_); ++tp) { \
        asm volatile("s_waitcnt vmcnt(4)" ::: "memory"); __builtin_amdgcn_s_barrier(); asm volatile("" ::: "memory"); \
        ATT_ISSUE(2 * tp + 4); ATT_ISSUE(2 * tp + 5); \
        _Pragma("clang loop unroll(disable)") for (int sub = 0; sub < 2; ++sub) { \
            const int ti = 2 * tp + sub; if (ti >= ntiles) break; \
            const int kt = ti < 4 ? ti : lt0 + ti - 4, bf = ti % NSLOT; const bool latt = ti >= 4; \
            bool active = wave_on; int msk = 0; \
            if (latt && mode == 2) { const int kr = kt - 4; active = active && (kr >= r0w) && (kr < r0w + 8); msk = 2; } \
            if (latt && mode == 3) { const int k0 = 64 * (kt - 4); active = (k0 + 63 >= pos0w - 128) && (k0 <= pos0w + 63 + 128); msk = ((k0 >= pos0w + 63 - 128) && (k0 + 63 <= pos0w + 128)) ? 0 : 3; } \
            if (!active) continue; \
            const LAS unsigned char* kb = lds + K_RING + bf * 8192; const LAS unsigned char* vb = lds + V_RING + bf * 8192; \
            int r_ = r, h_ = h; asm volatile("" : "+v"(r_), "+v"(h_)); \
            int ma[2] = {0, 0}, mb[2] = {ZB_OFF, ZB_OFF}; unsigned lim = 0xffffffffu; \
            if (msk == 2) { lim = 15u; const int brow_i = (kt - 4 - rw + 7) * 32; \
                _Pragma("unroll") for (int qb = 0; qb < 2; ++qb) { const int cq = 32 * qb + r_, c0 = min(max(cq - 8, 0), 48); ma[qb] = 8 * h_ - c0; mb[qb] = RPB_OFF + (brow_i + 8 * h_ - cq + 15) * 4; } } \
            else if (msk == 3) { lim = 256u; \
                _Pragma("unroll") for (int qb = 0; qb < 2; ++qb) ma[qb] = 64 * (kt - 4) - (pos0w + 32 * qb + r_) + 8 * h_ + 128; } \
            attn_tile_m<MT_>(lds, kb, vb, kofs, vofs, qf, negM, O, lsum, ma, mb, lim, msk == 2); } }
        MASK_LOOP(0, min(2, npairs), 0)
        MASK_LOOP(2, npairs, 1)
#undef MASK_LOOP
    }
#undef ATT_ISSUE
#undef ATT_ISSUE_AT
    asm volatile("s_waitcnt vmcnt(0)" ::: "memory");
    float linv[2];
#pragma unroll
    for (int qb = 0; qb < 2; ++qb) { float lq = sum32(lsum[qb]);
        if (mode == 3) lq += __builtin_amdgcn_exp2f(A.in[I_SINK][l * 4 + head] * LOG2E + negM[qb]);
        linv[qb] = 1.0f / lq; }
    if (DIFF) {
        LAS float* xch = (LAS float*)lds + (wave & 3) * 4096;
        __syncthreads();
        if (wave >= 4) {
#pragma unroll
            for (int qb = 0; qb < 2; ++qb)
#pragma unroll
                for (int dvb = 0; dvb < 2; ++dvb)
#pragma unroll
                    for (int j = 0; j < 16; ++j) xch[((qb * 2 + dvb) * 16 + j) * 64 + lane] = O[qb][dvb][j] * (lam * linv[qb]);
        }
        __syncthreads();
        if (wave < 4) {
            const float* dg = A.in[I_DG] + l * 64;
#pragma unroll
            for (int qb = 0; qb < 2; ++qb) { float ss = 0.f;
#pragma unroll
                for (int dvb = 0; dvb < 2; ++dvb)
#pragma unroll
                    for (int j = 0; j < 16; ++j) { const float v = O[qb][dvb][j] * linv[qb] - xch[((qb * 2 + dvb) * 16 + j) * 64 + lane]; O[qb][dvb][j] = v; ss += v * v; }
                ss = sum32(ss);
                const float rs = (1.0f - lam_init) / sqrtf(ss * (1.0f / 64.0f) + EPS);
                unsigned char* orow = WSP(unsigned char, WS_CAT) + mq[qb] * D + ocol; const float rs8 = rs * CAT_SCALE;
#pragma unroll
                for (int dvb = 0; dvb < 2; ++dvb)
#pragma unroll
                    for (int g = 0; g < 4; ++g) { const int dv = 32 * dvb + 8 * g + 4 * h; const f32x4 gg = *(const f32x4*)(dg + dv);
                        *(unsigned*)(orow + dv) = pg8::cvt4_fp8(O[qb][dvb][4 * g] * rs8 * gg[0], O[qb][dvb][4 * g + 1] * rs8 * gg[1], O[qb][dvb][4 * g + 2] * rs8 * gg[2], O[qb][dvb][4 * g + 3] * rs8 * gg[3]); } }
        }
    } else if (wave_on) {
#pragma unroll
        for (int qb = 0; qb < 2; ++qb) { unsigned char* orow = WSP(unsigned char, WS_CAT) + mq[qb] * D + ocol; const float inv0 = linv[qb] * CAT_SCALE;
#pragma unroll
            for (int dvb = 0; dvb < 2; ++dvb)
#pragma unroll
                for (int g = 0; g < 4; ++g) { const int dv = 32 * dvb + 8 * g + 4 * h;
                    *(unsigned*)(orow + dv) = pg8::cvt4_fp8(O[qb][dvb][4 * g] * inv0, O[qb][dvb][4 * g + 1] * inv0, O[qb][dvb][4 * g + 2] * inv0, O[qb][dvb][4 * g + 3] * inv0); } }
    }
}
}

__device__ __forceinline__ void phase_attn(const Args& A, Frame& F, int l, int ctr_off = 0) {
    const int wave = F.wave, lane0 = lane_id();
    float lam_init = 0.8f - 0.6f * expf(-0.3f * (float)l);
    float lam;
    { const float* lf = A.in[I_DLAM] + l * 128; float a = 0.f, bq = 0.f; if (lane0 < 32) { a = lf[lane0] * lf[32 + lane0]; bq = lf[64 + lane0] * lf[96 + lane0]; }
      a = wave_sum(a); bq = wave_sum(bq); lam = expf(a) - expf(bq) + lam_init; }
    lam = __builtin_bit_cast(float, __builtin_amdgcn_readfirstlane(__builtin_bit_cast(int, lam))); lam_init = __builtin_bit_cast(float, __builtin_amdgcn_readfirstlane(__builtin_bit_cast(int, lam_init)));
    const bool conv = l < NL - 1;
    constexpr int NMIX = 608 + (CONV_UNITS - 128);
    const int NA = conv ? 1280 + 96 : 1280, NQ = conv ? 768 + 608 + CONV_UNITS : NA;
    unsigned* ctr = F.ctl + CW_WORK + 64 * l + ctr_off;
    volatile LAS int* uw = (volatile LAS int*)(F.lds + att::UW_OFF);
    for (;;) {
        if (wave == 0 && lane0 == 0) uw[0] = (int)__hip_atomic_fetch_add(ctr, 1u, RLX_AGENT);
        __syncthreads();
        const int uq = __builtin_amdgcn_readfirstlane(uw[0]);
        if (uq >= NQ) break;
        int u = uq;
        if (conv && uq >= 768) { const int v = uq - 768;
            const int a0 = v < NMIX ? (v * 608) / NMIX : 608, a1 = v < NMIX ? ((v + 1) * 608) / NMIX : 608;
            if (a1 == a0) {
                const int cu = v - a0; const int ln = lane_id(); const int r0 = 16 * cu + 2 * wave;
                const ConvItem c0 = conv_decode(A, F, l + 1, r0), c1 = conv_decode(A, F, l + 1, r0 + 1);
                float v0[64], v1[64]; conv_load(c0, ln, v0); conv_load(c1, ln, v1); conv_store(c0, ln, v0); conv_store(c1, ln, v1);
                continue; }
            u = 768 + a0; }
        int mode, b, hk, qblk; bool is_ctx = false;
        if (u < 512) { mode = 0; b = u >> 6; hk = (u >> 4) & 3; qblk = u & 15; }
        else if (u < 1280) { const int v = (u - 512) & 255; mode = 1 + ((u - 512) >> 8); b = v >> 5;
            if (mode == 2) { hk = (v >> 3) & 3; qblk = v & 7; } else { hk = (v >> 4) & 1; qblk = v & 15; } }
        else { int v = u - 1280; is_ctx = true; qblk = 0;
            if (v < 32) { mode = 0; b = v >> 2; hk = v & 3; } else if (v < 48) { v -= 32; mode = 1; b = v >> 1; hk = v & 1; }
            else if (v < 80) { v -= 48; mode = 2; b = v >> 2; hk = v & 3; } else { v -= 80; mode = 3; b = v >> 1; hk = v & 1; } }
        if (mode == 0) att::unit<true>(A, F, l, 0, b, hk, qblk, is_ctx, lam, lam_init);
        else att::unit<false>(A, F, l, mode, b, hk, qblk, is_ctx, lam, lam_init);
    }
}

__device__ __forceinline__ void router_pick(float (&acc)[32], int lane, const float* rb, LAS unsigned* lc, LAS int* ent, int m, float* rgate) {
#pragma unroll
    for (int i = 0; i < 16; ++i) { const bool hi = lane & 32; const float send = hi ? acc[i] : acc[i + 16], keep = hi ? acc[i + 16] : acc[i]; acc[i] = keep + other32(send, hi); }
#pragma unroll
    for (int i = 0; i < 8; ++i) { const bool hi = lane & 16; const float send = hi ? acc[i] : acc[i + 8], keep = hi ? acc[i + 8] : acc[i]; acc[i] = keep + other16(send); }
#pragma unroll
    for (int i = 0; i < 4; ++i) { const bool hi = lane & 8; const float send = hi ? acc[i] : acc[i + 4], keep = hi ? acc[i + 4] : acc[i]; acc[i] = keep + dppf<DPP_MIRROR>(send); }
#pragma unroll
    for (int i = 0; i < 2; ++i) { const bool hi = lane & 4; const float send = hi ? acc[i] : acc[i + 2], keep = hi ? acc[i + 2] : acc[i]; acc[i] = keep + dppf<DPP_HMIRROR>(send); }
    { const bool hi = lane & 2; const float send = hi ? acc[0] : acc[1], keep = hi ? acc[1] : acc[0]; acc[0] = keep + dppf<DPP_XOR2>(send); }
    const int my_e = lane >> 1;
    float logit = acc[0] + dppf<DPP_XOR1>(acc[0]) + rb[my_e];
    float tv[4]; int te[4];
#pragma unroll
    for (int k = 0; k < 4; ++k) {
        float bv = logit; int be = my_e;
#define AMX(ov_, oe_) do { const float ov = (ov_); const int oe = (oe_); const bool take = (ov > bv) || (ov == bv && oe < be); bv = take ? ov : bv; be = take ? oe : be; } while (0)
        AMX(dppf<DPP_XOR2>(bv), dppi<DPP_XOR2>(be)); AMX(dppf<DPP_HMIRROR>(bv), dppi<DPP_HMIRROR>(be)); AMX(dppf<DPP_MIRROR>(bv), dppi<DPP_MIRROR>(be));
        AMX(other16(bv), other16i(be)); AMX(other32(bv, false), other32i(be, false));
#undef AMX
        tv[k] = bv; te[k] = be; if (my_e == be) logit = -INFINITY;
    }
    const float e1 = __expf(tv[1] - tv[0]), e2 = __expf(tv[2] - tv[0]), e3 = __expf(tv[3] - tv[0]); const float inv = 1.0f / (1.0f + e1 + e2 + e3);
    if (lane < 4) { const int ee = lane == 0 ? te[0] : (lane == 1 ? te[1] : (lane == 2 ? te[2] : te[3])); const float gg = (lane == 0 ? 1.0f : (lane == 1 ? e1 : (lane == 2 ? e2 : e3))) * inv;
        const unsigned lp = __hip_atomic_fetch_add(lc + ee, 1u, __ATOMIC_RELAXED, __HIP_MEMORY_SCOPE_WORKGROUP);
        ent[2 * lane] = m * 4 + lane; ent[2 * lane + 1] = (int)((lp << 5) | (unsigned)ee); rgate[(size_t)m * 4 + lane] = gg; }
}
__device__ __forceinline__ void phase_post_out(const Args& A, Frame& F, int l) {
    const int wave = F.wave, lane0 = lane_id(), tid = wave * 64 + lane0;
    LAS unsigned char* wl = F.lds;
    LAS float* mv = (LAS float*)(F.lds + LDSCTL_OFF + 8192);
    const int wg = F.vcu, bq = (wg * 136) / T;
    { const float* rw = A.in[I_RW] + (size_t)l * D * NE;
      for (int idx = tid; idx < D * 8; idx += NWAVES * 64) { const int k = idx >> 3, c = idx & 7, ln = (k & 255) >> 2, j = k >> 8, i = k & 3, kap = (j * 4 + i) * 64 + ln;
          *(LAS f32x4*)(wl + kap * 128 + ((c ^ ((kap >> 1) & 7)) << 4)) = *(const GAS f32x4*)(rw + (size_t)k * NE + 4 * c); }
      const float* mod = WSP(float, WS_MOD); const float* n2 = A.in[I_N2G] + l * D;
      for (int idx = tid; idx < 2 * D; idx += NWAVES * 64) { const int st = idx >> 10, k = idx & 1023; const float* md = mod + (size_t)(l * 9 + (st ? bq : 8)) * 6144;
          mv[(st * 3 + 0) * D + k] = md[2048 + k]; mv[(st * 3 + 1) * D + k] = n2[k] * (1.0f + md[4096 + k]); mv[(st * 3 + 2) * D + k] = md[3072 + k]; } }
    LAS unsigned* lc = (LAS unsigned*)(F.lds + MOE_TAB_OFF);
    LAS int* ent = (LAS int*)(F.lds + MOE_IDX_OFF) + wave * 160;
    if (tid < 64) lc[tid] = 0u;
    __syncthreads();
    const float* rb = A.in[I_RB] + l * NE;
    unsigned* cnt = F.ctl + CW_CNT + 64 * l;
    int nrow = 0;
    const int mbase = wg * 136;
    Row xn0, xn1; v2u on0[4], on1[4];
#define PO_LOAD(pp_) do { const size_t m_ = (size_t)(mbase + 2 * (pp_)); const int lane0 = lane_id(); row_load_bf16(xn0, WSP(bf16, WS_X) + m_ * D, lane0); row_load_bf16(xn1, WSP(bf16, WS_X) + (m_ + 1) * D, lane0); \
        _Pragma("unroll") for (int j_ = 0; j_ < 4; ++j_) { on0[j_] = ((const GAS v2u*)(WSP(bf16, WS_O) + m_ * D))[lane0 + 64 * j_]; on1[j_] = ((const GAS v2u*)(WSP(bf16, WS_O) + (m_ + 1) * D))[lane0 + 64 * j_]; } } while (0)
    if (wave < 68) PO_LOAD(wave);
    for (int pp = wave; pp < 68; pp += NWAVES) {
        const int m0 = mbase + 2 * pp, t = m0 % T;
        Row x0 = xn0, x1 = xn1, o0, o1;
#pragma unroll
        for (int j = 0; j < 4; ++j) { o0.v[j] = (f32x4){bflo(on0[j].x), bfhi(on0[j].x), bflo(on0[j].y), bfhi(on0[j].y)}; o1.v[j] = (f32x4){bflo(on1[j].x), bfhi(on1[j].x), bflo(on1[j].y), bfhi(on1[j].y)}; }
        if (pp + NWAVES < 68) PO_LOAD(pp + NWAVES);
        if (l == NL - 1 && t < CTX) continue;
        const int lane = lane_id(), sw = (lane >> 1) & 7;
        const LAS float* ms = mv + (t < CTX ? 0 : 3 * D);
        bf16* xp = WSP(bf16, WS_X) + (size_t)m0 * D;
#pragma unroll
        for (int j = 0; j < 4; ++j) { const f32x4 g1 = ((const LAS f32x4*)ms)[lane + 64 * j]; x0.v[j] += g1 * o0.v[j]; x1.v[j] += g1 * o1.v[j]; }
        row_store_bf16(x0, xp, lane); row_store_bf16(x1, xp + D, lane);
        const float r0 = row_rstd(x0), r1 = row_rstd(x1);
#pragma unroll
        for (int j = 0; j < 4; ++j) { const f32x4 a2 = ((const LAS f32x4*)(ms + D))[lane + 64 * j], s2 = ((const LAS f32x4*)(ms + 2 * D))[lane + 64 * j];
            o0.v[j] = x0.v[j] * r0 * a2 + s2; o1.v[j] = x1.v[j] * r1 * a2 + s2; }
        { GAS unsigned* h8 = (GAS unsigned*)(WSP(unsigned char, WS_H8) + (size_t)m0 * D);
#pragma unroll
          for (int j = 0; j < 4; ++j) { h8[lane + 64 * j] = pg8::cvt4_fp8(o0.v[j][0], o0.v[j][1], o0.v[j][2], o0.v[j][3]); h8[256 + lane + 64 * j] = pg8::cvt4_fp8(o1.v[j][0], o1.v[j][1], o1.v[j][2], o1.v[j][3]); } }
#pragma unroll
        for (int rr = 0; rr < 2; ++rr) {
            __builtin_amdgcn_sched_barrier(0);
            float a0[32];
#pragma unroll
            for (int e = 0; e < 32; ++e) a0[e] = 0.f;
            {
                f32x4 wa[4], wb[4];
                const LAS unsigned char* wp0 = wl + lane * 128;
#pragma unroll
                for (int c = 0; c < 4; ++c) wa[c] = *(const LAS f32x4*)(wp0 + ((c ^ sw) << 4));
#pragma unroll
                for (int hs = 0; hs < 32; ++hs) {
                    const int st = hs >> 1, hf = hs & 1;
                    const float xa = rr ? o1.v[st >> 2][st & 3] : o0.v[st >> 2][st & 3];
                    if (hs + 1 < 32) { const int st1 = (hs + 1) >> 1, hf1 = (hs + 1) & 1;
#pragma unroll
                        for (int c = 0; c < 4; ++c) { const f32x4 t = *(const LAS f32x4*)(wp0 + st1 * 8192 + (((4 * hf1 + c) ^ sw) << 4)); if (hs & 1) wa[c] = t; else wb[c] = t; } }
                    __builtin_amdgcn_sched_barrier(0);
#pragma unroll
                    for (int c = 0; c < 4; ++c) { const f32x4 w4 = (hs & 1) ? wb[c] : wa[c];
#pragma unroll
                        for (int q = 0; q < 4; ++q) a0[16 * hf + 4 * c + q] += xa * w4[q]; }
                    __builtin_amdgcn_sched_barrier(0);
                } }
            router_pick(a0, lane, rb, lc, ent + 8 * nrow, m0 + rr, WSP(float, WS_RGATE)); ++nrow;
        }
    }
#undef PO_LOAD
    __syncthreads();
    if (tid < NE) lc[32 + tid] = __hip_atomic_fetch_add(cnt + tid, lc[tid], RLX_AGENT);
    __syncthreads();
    { const int lane = lane_id(); int* rinfo = WSP(int, WS_RINFO);
      for (int i = lane; i < 4 * nrow; i += 64) { const int info = ent[2 * i], pe = ent[2 * i + 1], e = pe & 31, lp = pe >> 5; rinfo[(size_t)e * M + lc[32 + e] + lp] = info; } }
}

__device__ __forceinline__ int moe_setup(Frame& F, int l, int nN, bool xcd_rows) {
    const int wave = F.wave, lane = lane_id(), tid = wave * 64 + lane;
    LAS int* tb = (LAS int*)(F.lds + MOE_TAB_OFF); LAS int* ut = (LAS int*)(F.lds + MOE_UT_OFF); LAS int* idx = (LAS int*)(F.lds + MOE_IDX_OFF);
    if (tid < NE) tb[40 + tid] = (int)__hip_atomic_load(F.ctl + CW_CNT + 64 * l + tid, RLX_AGENT);
    __syncthreads();
    if (tid == 0) { int acc = 0; for (int e = 0; e < NE; ++e) { tb[e] = acc; acc += (tb[40 + e] + 255) >> 8; } tb[NE] = acc; }
    __syncthreads();
    const int nblk = tb[NE], c = (int)blockIdx.x, G = F.G;
    const int xq = c & 7, jq = c >> 3, nbx = (nblk - xq + 7) >> 3;
    int n = xcd_rows ? ((nbx * nN > jq) ? (nbx * nN - jq + 31) / 32 : 0) : ((nblk * nN > c) ? (nblk * nN - c + G - 1) / G : 0);
    n = n > MOE_MAX_UNITS ? MOE_MAX_UNITS : n;
    const int* rinfo = WSP(int, WS_RINFO);
    for (int i = wave; i < n; i += NWAVES) {
        int blk, pn;
        if (xcd_rows) { const int U = i * 32 + jq; blk = (U / nN) * 8 + xq; pn = U % nN; } else { const int L = i * G + c; blk = L / nN; pn = L % nN; }
        int e = 0;
#pragma unroll 1
        for (int j = 1; j < NE; ++j) e += (tb[j] <= blk) ? 1 : 0;
        const int jb = blk - tb[e], ce = tb[40 + e];
        if (lane == 0) { ut[4 * i] = blk; ut[4 * i + 1] = pn; ut[4 * i + 2] = e; }
#pragma unroll
        for (int q = 0; q < 4; ++q) { const int R = q * 64 + lane, pos = jb * 256 + R; idx[i * 256 + R] = pos < ce ? rinfo[(size_t)e * M + pos] : -1; }
    }
    __syncthreads();
    return __builtin_amdgcn_readfirstlane(n);
}

__device__ __forceinline__ void phase_combine(const Args& A, Frame& F, int l) {
    const int wave = F.wave, lane = lane_id(), tid = wave * 64 + lane;
    LAS float* mv = (LAS float*)F.lds;
    const int wg = F.vcu, bq = (wg * 136) / T, mbase = wg * 136;
    { const float* mod = WSP(float, WS_MOD);
      for (int idx = tid; idx < 2 * D; idx += NWAVES * 64) { const int st = idx >> 10, k = idx & 1023; const int r = st ? bq : 8; const float* md = mod + (size_t)(l * 9 + r) * 6144;
          mv[(st * 3 + 0) * D + k] = md[5120 + k];
          if (l < NL - 1) { const float* md2 = md + 9 * 6144; mv[(st * 3 + 1) * D + k] = A.in[I_N1G][(l + 1) * D + k] * (1.0f + md2[1024 + k]); mv[(st * 3 + 2) * D + k] = md2[k]; }
          else { mv[(st * 3 + 1) * D + k] = A.in[I_FG][k]; mv[(st * 3 + 2) * D + k] = 0.f; } } }
    __syncthreads();
    for (int pp = wave; pp < 68; pp += NWAVES) {
        const int m0 = mbase + 2 * pp, t = m0 % T; if (l == NL - 1 && t < CTX) continue;
        const LAS float* ms = mv + (t < CTX ? 0 : 3 * D);
        bf16* xp = WSP(bf16, WS_X) + (size_t)m0 * D;
        Row x0, x1; row_load_bf16(x0, xp, lane); row_load_bf16(x1, xp + D, lane);
        const f32x4 gt0 = *(const GAS f32x4*)(WSP(float, WS_RGATE) + (size_t)m0 * 4), gt1 = *(const GAS f32x4*)(WSP(float, WS_RGATE) + (size_t)(m0 + 1) * 4);
        const unsigned char* Y = WSP(unsigned char, WS_YT) + (size_t)m0 * 4 * D;
        unsigned yv[8][4];
#pragma unroll
        for (int k = 0; k < 8; ++k)
#pragma unroll
            for (int j = 0; j < 4; ++j) yv[k][j] = ((const GAS unsigned*)(Y + (size_t)k * D))[lane + 64 * j];
        Row y0, y1;
#pragma unroll
        for (int j = 0; j < 4; ++j) { y0.v[j] = (f32x4){0.f, 0.f, 0.f, 0.f}; y1.v[j] = (f32x4){0.f, 0.f, 0.f, 0.f}; }
#pragma unroll
        for (int k = 0; k < 4; ++k)
#pragma unroll
            for (int j = 0; j < 4; ++j) { typedef float f32x2 __attribute__((ext_vector_type(2)));
                const f32x2 a0 = __builtin_amdgcn_cvt_pk_f32_fp8((int)yv[k][j], false), a1 = __builtin_amdgcn_cvt_pk_f32_fp8((int)yv[k][j], true);
                const f32x2 c0 = __builtin_amdgcn_cvt_pk_f32_fp8((int)yv[4 + k][j], false), c1 = __builtin_amdgcn_cvt_pk_f32_fp8((int)yv[4 + k][j], true);
                y0.v[j] += (f32x4){a0.x, a0.y, a1.x, a1.y} * (gt0[k] * 0.125f); y1.v[j] += (f32x4){c0.x, c0.y, c1.x, c1.y} * (gt1[k] * 0.125f); }
#pragma unroll
        for (int j = 0; j < 4; ++j) { const f32x4 g2 = ((const LAS f32x4*)ms)[lane + 64 * j]; x0.v[j] += g2 * y0.v[j]; x1.v[j] += g2 * y1.v[j]; }
        const float r0 = row_rstd(x0), r1 = row_rstd(x1);
        if (l < NL - 1) {
            row_store_bf16(x0, xp, lane); row_store_bf16(x1, xp + D, lane);
#pragma unroll
            for (int j = 0; j < 4; ++j) { const f32x4 a1 = ((const LAS f32x4*)(ms + D))[lane + 64 * j], s1 = ((const LAS f32x4*)(ms + 2 * D))[lane + 64 * j];
                y0.v[j] = x0.v[j] * r0 * a1 + s1; y1.v[j] = x1.v[j] * r1 * a1 + s1; }
            row_store_fp8(y0, WSP(unsigned char, WS_H) + (size_t)m0 * D, lane); row_store_fp8(y1, WSP(unsigned char, WS_H) + (size_t)(m0 + 1) * D, lane);
        } else {
            const int b = m0 / T;
            float* op = A.out + ((size_t)b * SEQ + (t - CTX)) * D;
#pragma unroll
            for (int j = 0; j < 4; ++j) { const f32x4 fg = ((const LAS f32x4*)(ms + D))[lane + 64 * j];
                ((GAS f32x4*)op)[lane + 64 * j] = x0.v[j] * r0 * fg; ((GAS f32x4*)(op + D))[lane + 64 * j] = x1.v[j] * r1 * fg; }
        }
    }
}

constexpr int PH_PER_LAYER = 8, N_PHASES = 2 + NL * PH_PER_LAYER;
__global__ void __launch_bounds__(NWAVES * 64, 2) fwd(Args A) {
    extern __shared__ __attribute__((aligned(16))) unsigned char lds_raw[];
    Frame F;
    F.lds = (LAS unsigned char*)lds_raw; F.ws = A.ws; F.ctl = (unsigned*)(A.ws + WS_CTL);
    F.wave = __builtin_amdgcn_readfirstlane((int)threadIdx.x >> 6);
    F.G = gridDim.x; { const int bx = blockIdx.x; F.vcu = (F.G % 8 == 0) ? (bx % 8) * (F.G / 8) + bx / 8 : bx; }
    for (int u = threadIdx.x; u < (LDS_BYTES - LDSCTL_OFF) / 4; u += NWAVES * 64) ((LAS unsigned*)(F.lds + LDSCTL_OFF))[u] = 0u;
    __syncthreads();
    const int lo = A.ph_lo, hi = A.ph_hi;
    XcdBarrier bar; bar.bar = F.ctl + CW_BAR; bar.x = 0; bar.st = nullptr; bar.wave = F.wave;
    if (hi - lo > 1) bar = xcd_barrier_post(F.ctl + CW_BAR, (volatile LAS unsigned*)(F.lds + MISC_OFF) + 8, F.wave);
#define IN(k) (lo <= (k) && (k) < hi)
#define SEAM(k) do { if (IN(k) && IN((k) + 1)) xcd_barrier(bar); } while (0)
    unsigned long long tacc = 0ull, tp0 = 0ull;
#define TPB(id) do { if (TPROBE == (id)) tp0 = __builtin_amdgcn_s_memrealtime(); } while (0)
#define TPE(id) do { if (TPROBE == (id)) tacc += __builtin_amdgcn_s_memrealtime() - tp0; } while (0)
    TPB(10);
    if (IN(0)) { TPB(0); phase_proA(A, F);
#if REP_MASK & 8
        xcd_barrier(bar); phase_proA(A, F);
#endif
        SEAM(0); TPE(0); }
    if (IN(1)) { TPB(1); phase_proB(A, F); SEAM(1); TPE(1); }
    for (int l = 0; l < NL; ++l) {
        F.ws = opq(F.ws); F.ctl = opq(F.ctl); asm volatile("" : "+s"(F.wave), "+s"(F.vcu), "+s"(F.G));
        const int pb = 2 + PH_PER_LAYER * l;
        if (IN(pb + 0)) { TPB(2);
            pg8::Gemm g{(const bf16*)WSP(unsigned char, WS_H), (const bf16*)(WSP(unsigned char, WS_WIN) + (size_t)l * INW * D), D / 2}; pg8::StaticOrder S; S.init(M, INW, F.G, (int)blockIdx.x);
            pg8::EpiStore E{WSP(bf16, WS_P), INW, nullptr, 0, 1.0f / 64.0f};
            pg8::gemm_phase<pg8::EpiStore, pg8::StaticOrder, false, true>(F.lds, g, S, E, F.wave);
#if REP_MASK & 4
            xcd_barrier(bar); pg8::gemm_phase<pg8::EpiStore, pg8::StaticOrder, false, true>(F.lds, g, S, E, F.wave);
#endif
            SEAM(pb + 0); TPE(2);
        }
        if (IN(pb + 1)) { TPB(3); phase_post_proj(A, F, l); SEAM(pb + 1); TPE(3); }
        if (IN(pb + 2)) { TPB(4); phase_attn(A, F, l);
#if REP_MASK & 1
            xcd_barrier(bar); phase_attn(A, F, l, 16);
#endif
            SEAM(pb + 2); TPE(4); }
        if (IN(pb + 3)) { TPB(5);
            pg8::Gemm g{(const bf16*)WSP(unsigned char, WS_CAT), (const bf16*)(WSP(unsigned char, WS_WOUT) + (size_t)l * D * D), D / 2}; pg8::StaticOrder S;
            if (l == NL - 1) S.init(M - NB * CTX, D, F.G, (int)blockIdx.x, true); else S.init(M, D, F.G, (int)blockIdx.x);
            pg8::EpiStore E{WSP(bf16, WS_O), D, nullptr, 0, 1.0f / (64.0f * att::CAT_SCALE)};
            pg8::gemm_phase<pg8::EpiStore, pg8::StaticOrder, false, true>(F.lds, g, S, E, F.wave);
#if REP_MASK & 4
            xcd_barrier(bar); pg8::gemm_phase<pg8::EpiStore, pg8::StaticOrder, false, true>(F.lds, g, S, E, F.wave);
#endif
            SEAM(pb + 3); TPE(5);
        }
        if (IN(pb + 4)) { TPB(6); phase_post_out(A, F, l); SEAM(pb + 4); TPE(6); }
        if (IN(pb + 5)) { TPB(7);
            pg8::MoeOrder S; S.n = moe_setup(F, l, GU / 256, true); S.nN = GU / 256; S.ut = (const LAS int*)(F.lds + MOE_UT_OFF);
            pg8::Gemm g{(const bf16*)WSP(unsigned char, WS_H8), (const bf16*)(WSP(unsigned char, WS_WGU) + (size_t)l * NE * GU * D), D / 2};
            pg8::EpiSwiglu E{WSP(unsigned char, WS_ACT), A.in[I_BGU] + (size_t)l * NE * GU};
            pg8::gemm_phase<pg8::EpiSwiglu, pg8::MoeOrder, true, true>(F.lds, g, S, E, F.wave, (const LAS int*)(F.lds + MOE_IDX_OFF));
#if REP_MASK & 2
            xcd_barrier(bar); pg8::gemm_phase<pg8::EpiSwiglu, pg8::MoeOrder, true, true>(F.lds, g, S, E, F.wave, (const LAS int*)(F.lds + MOE_IDX_OFF));
#endif
            SEAM(pb + 5); TPE(7);
        }
        if (IN(pb + 6)) { TPB(8);
            pg8::MoeOrder S; S.n = moe_setup(F, l, D / 256, true); S.nN = D / 256; S.ut = (const LAS int*)(F.lds + MOE_UT_OFF);
            pg8::Gemm g{(const bf16*)WSP(unsigned char, WS_ACT), (const bf16*)(WSP(unsigned char, WS_WDN) + (size_t)l * NE * D * FF), FF / 2};
            pg8::EpiYT E{WSP(unsigned char, WS_YT), A.in[I_BDN] + (size_t)l * NE * D, (const LAS int*)(F.lds + MOE_IDX_OFF)};
            pg8::gemm_phase<pg8::EpiYT, pg8::MoeOrder, false, true>(F.lds, g, S, E, F.wave);
#if REP_MASK & 2
            xcd_barrier(bar); pg8::gemm_phase<pg8::EpiYT, pg8::MoeOrder, false, true>(F.lds, g, S, E, F.wave);
#endif
            SEAM(pb + 6); TPE(8);
        }
        if (IN(pb + 7)) { TPB(9); phase_combine(A, F, l); SEAM(pb + 7); TPE(9); }
    }
    TPE(10);
    if (TPROBE >= 0 && blockIdx.x == 0) { const unsigned long long te = __builtin_amdgcn_s_memrealtime(); while (__builtin_amdgcn_s_memrealtime() - te < 4ull * tacc) __builtin_amdgcn_s_sleep(20); }
#undef IN
#undef SEAM
}

extern "C" void kernel_launch(void* const* d_in, const int* in_sizes, int n_in, void* d_out, int out_size, void* d_ws, size_t ws_size, hipStream_t stream) {
    static int grid = 0;
    if (grid == 0) {
        if (n_in != 22 || out_size != NB * SEQ * D || ws_size < WS_END) { fprintf(stderr, "kernel_launch: unexpected shapes (n_in %d out %d ws %zu)\n", n_in, out_size, ws_size); grid = -1; return; }
        int dev = 0, cus = 0, per_cu = 0;
        if (hipGetDevice(&dev) != hipSuccess || hipDeviceGetAttribute(&cus, hipDeviceAttributeMultiprocessorCount, dev) != hipSuccess) { grid = -1; return; }
        if (hipFuncSetAttribute((const void*)fwd, hipFuncAttributeMaxDynamicSharedMemorySize, LDS_BYTES) != hipSuccess) { fprintf(stderr, "kernel_launch: hipFuncSetAttribute failed\n"); grid = -1; return; }
        if (hipOccupancyMaxActiveBlocksPerMultiprocessor(&per_cu, (const void*)fwd, NWAVES * 64, LDS_BYTES) != hipSuccess || per_cu < 1) fprintf(stderr, "kernel_launch: occupancy query reports %d\n", per_cu);
        (void)hipGetLastError();
        grid = 256;
        if (cus != 256) fprintf(stderr, "kernel_launch: built for 256 CUs, device reports %d\n", cus);
    }
    if (grid < 0) return;
    if (hipMemsetAsync((char*)d_ws + WS_CTL, 0, CTL_ZERO_BYTES, stream) != hipSuccess) return;
    Args a{};
    for (int i = 0; i < 22; ++i) a.in[i] = (const float*)d_in[i];
    a.out = (float*)d_out; a.ws = (unsigned char*)d_ws;
#if MK_PER_PHASE
    for (int p = 0; p < N_PHASES; ++p) { a.ph_lo = p; a.ph_hi = p + 1; hipLaunchKernelGGL(fwd, dim3(grid), dim3(NWAVES * 64), LDS_BYTES, stream, a); }
#else
    a.ph_lo = 0; a.ph_hi = N_PHASES;
    hipLaunchKernelGGL(fwd, dim3(grid), dim3(NWAVES * 64), LDS_BYTES, stream, a);
#endif
}
```
